# Optimizing an MI355X kernel written in HIP

```python
import math
import jax, jax.numpy as jnp
from jax import lax
import numpy as np

D_MODEL = 1024
BATCH = 4
SEQ = 8192
DEPTH = 1

N_META = 16
BLOCK_Q = 128
EPS = 1e-6

MLA_HEADS = 8
MLA_Q_RANK = 256
MLA_KV_RANK = 256
MLA_NOPE_DIM = 64
MLA_ROPE_DIM = 32
MLA_V_DIM = 64
MLA_QK_DIM = MLA_NOPE_DIM + MLA_ROPE_DIM
ROPE_THETA = 10000.0

DIFF_HEADS = 4
DIFF_HEAD_DIM = 64
DIFF_V_DIM = 2 * DIFF_HEAD_DIM
DIFF_QK_WIDTH = DIFF_HEADS * 2 * DIFF_HEAD_DIM
DIFF_V_WIDTH = DIFF_HEADS * DIFF_V_DIM

NUM_BUCKETS = 32
MAX_DISTANCE = 128

_S1 = MLA_Q_RANK
_S2 = _S1 + MLA_KV_RANK
_S3 = _S2 + MLA_ROPE_DIM
_S4 = _S3 + DIFF_QK_WIDTH
_S5 = _S4 + DIFF_QK_WIDTH
IN_WIDTH = _S5 + DIFF_V_WIDTH
IN_SPLITS = (_S1, _S2, _S3, _S4, _S5)
MIX_WIDTH = MLA_HEADS * MLA_V_DIM + DIFF_V_WIDTH

PEER_HEADS = 8
PEER_N_KEYS = 128
PEER_N_EXPERTS = PEER_N_KEYS * PEER_N_KEYS
PEER_TOPK = 16
PEER_QUERY_DIM = 256
PEER_SUBKEY_DIM = PEER_QUERY_DIM // 2
PEER_CHUNK = 128

kernel_name = "hymba_mla_diffattn_peer_layer"


def _rms_norm(x, gain):
    xf = x.astype(jnp.float32)
    y = xf * lax.rsqrt(jnp.mean(xf * xf, axis=-1, keepdims=True) + EPS)
    return (y * gain.astype(jnp.float32)).astype(x.dtype)


def _rope(t, pos):
    half = t.shape[-1] // 2
    inv_freq = ROPE_THETA ** (-jnp.arange(half, dtype=jnp.float32) / half)
    ang = pos.astype(jnp.float32)[:, None] * inv_freq[None, :]
    cos = jnp.cos(ang)[:, None, :].astype(t.dtype)
    sin = jnp.sin(ang)[:, None, :].astype(t.dtype)
    t1, t2 = t[..., :half], t[..., half:]
    return jnp.concatenate([t1 * cos - t2 * sin, t1 * sin + t2 * cos], axis=-1)


def _t5_bucket(dist):
    n = jnp.maximum(dist, 0)
    max_exact = NUM_BUCKETS // 2
    nf = jnp.maximum(n, 1).astype(jnp.float32)
    large = max_exact + (jnp.log(nf / max_exact) / math.log(MAX_DISTANCE / max_exact)
                         * (NUM_BUCKETS - max_exact)).astype(jnp.int32)
    large = jnp.minimum(large, NUM_BUCKETS - 1)
    return jnp.where(n < max_exact, n, large)


def _causal_softmax(logits, q_pos, k_pos):
    mask = k_pos[None, :] <= q_pos[:, None]
    logits = jnp.where(mask, logits.astype(jnp.float32), -1e30)
    return jax.nn.softmax(logits, axis=-1)


def _to_blocks(t):
    b, l = t.shape[0], t.shape[1]
    t = t.reshape((b, l // BLOCK_Q, BLOCK_Q) + t.shape[2:])
    return jnp.moveaxis(t, 1, 0)


def _from_blocks(t):
    t = jnp.moveaxis(t, 0, 1)
    return t.reshape((t.shape[0], t.shape[1] * t.shape[2]) + t.shape[3:])


def _mla(c_q, c_kv, k_rope, q_norm, w_uq, kv_norm, w_ukv, qk_norm_q, qk_norm_k, pos):
    b, l, _ = c_q.shape
    q = (_rms_norm(c_q, q_norm) @ w_uq).reshape(b, l, MLA_HEADS, MLA_QK_DIM)
    kv = (_rms_norm(c_kv, kv_norm) @ w_ukv).reshape(b, l, MLA_HEADS, MLA_NOPE_DIM + MLA_V_DIM)
    k_nope, v = kv[..., :MLA_NOPE_DIM], kv[..., MLA_NOPE_DIM:]
    k_r = jnp.broadcast_to(k_rope[:, :, None, :], (b, l, MLA_HEADS, MLA_ROPE_DIM))
    k = jnp.concatenate([k_nope, k_r], axis=-1)
    q = _rms_norm(q, qk_norm_q)
    k = _rms_norm(k, qk_norm_k)
    q = jnp.concatenate([q[..., :MLA_NOPE_DIM], _rope(q[..., MLA_NOPE_DIM:], pos)], axis=-1)
    k = jnp.concatenate([k[..., :MLA_NOPE_DIM], _rope(k[..., MLA_NOPE_DIM:], pos)], axis=-1)
    scale = MLA_QK_DIM ** -0.5

    def block(args):
        q_start, qb = args
        q_pos = q_start + jnp.arange(BLOCK_Q, dtype=jnp.int32)
        s = jnp.einsum('bqhd,bkhd->bhqk', qb, k) * scale
        p = _causal_softmax(s, q_pos, pos)
        return jnp.einsum('bhqk,bkhd->bqhd', p.astype(v.dtype), v)

    starts = jnp.arange(l // BLOCK_Q, dtype=jnp.int32) * BLOCK_Q
    out = _from_blocks(lax.map(block, (starts, _to_blocks(q))))
    return out.reshape(b, l, MLA_HEADS * MLA_V_DIM)


def _diff_attn(q, k, v, q_norm, k_norm, lam_q1, lam_k1, lam_q2, lam_k2, subln, rel_bias, pos, lambda_init):
    b, l, _ = q.shape
    q = _rms_norm(q.reshape(b, l, DIFF_HEADS, 2, DIFF_HEAD_DIM), q_norm)
    k = _rms_norm(k.reshape(b, l, DIFF_HEADS, 2, DIFF_HEAD_DIM), k_norm)
    v = v.reshape(b, l, DIFF_HEADS, DIFF_V_DIM)
    lam = (jnp.exp(jnp.sum(lam_q1.astype(jnp.float32) * lam_k1.astype(jnp.float32)))
           - jnp.exp(jnp.sum(lam_q2.astype(jnp.float32) * lam_k2.astype(jnp.float32)))
           + lambda_init)
    k1, k2 = k[..., 0, :], k[..., 1, :]
    bias_table = rel_bias.astype(jnp.float32)
    scale = DIFF_HEAD_DIM ** -0.5

    def block(args):
        q_start, qb = args
        q_pos = q_start + jnp.arange(BLOCK_Q, dtype=jnp.int32)
        bias = bias_table[_t5_bucket(q_pos[:, None] - pos[None, :])]
        bias = jnp.transpose(bias, (2, 0, 1))[None]
        s1 = jnp.einsum('bqhd,bkhd->bhqk', qb[..., 0, :], k1).astype(jnp.float32) * scale + bias
        s2 = jnp.einsum('bqhd,bkhd->bhqk', qb[..., 1, :], k2).astype(jnp.float32) * scale + bias
        a = _causal_softmax(s1, q_pos, pos) - lam * _causal_softmax(s2, q_pos, pos)
        return jnp.einsum('bhqk,bkhd->bqhd', a.astype(v.dtype), v)

    starts = jnp.arange(l // BLOCK_Q, dtype=jnp.int32) * BLOCK_Q
    out = _from_blocks(lax.map(block, (starts, _to_blocks(q))))
    out = _rms_norm(out, subln) * (1.0 - lambda_init)
    return out.reshape(b, l, DIFF_V_WIDTH)


def _peer(h, w_query, sub_keys, u, v):
    b, l, d = h.shape
    tokens = h.reshape(b * l // PEER_CHUNK, PEER_CHUNK, d)

    def chunk(xc):
        q = (xc @ w_query).reshape(PEER_CHUNK, PEER_HEADS, 2, PEER_SUBKEY_DIM)
        s = jnp.einsum('chpd,hpnd->chpn', q, sub_keys).astype(jnp.float32)
        s1, i1 = lax.top_k(s[:, :, 0], PEER_TOPK)
        s2, i2 = lax.top_k(s[:, :, 1], PEER_TOPK)
        cand = (s1[..., :, None] + s2[..., None, :]).reshape(PEER_CHUNK, PEER_HEADS, PEER_TOPK * PEER_TOPK)
        best, flat = lax.top_k(cand, PEER_TOPK)
        e1 = jnp.take_along_axis(i1, flat // PEER_TOPK, axis=-1)
        e2 = jnp.take_along_axis(i2, flat % PEER_TOPK, axis=-1)
        experts = e1 * PEER_N_KEYS + e2
        g = jax.nn.softmax(best, axis=-1)
        u_sel = jnp.take(u, experts, axis=0)
        act = jax.nn.gelu(jnp.einsum('cd,chkd->chk', xc, u_sel).astype(jnp.float32), approximate=False)
        v_sel = jnp.take(v, experts, axis=0)
        return jnp.einsum('chk,chkd->cd', (g * act).astype(v.dtype), v_sel)

    return lax.map(chunk, tokens).reshape(b, l, d)


def setup_inputs(seed: int = 0) -> dict:
    key = jax.random.key(seed)
    ks = jax.random.split(key, 24)
    f32 = jnp.float32

    def nrm(k, shape, scale):
        return jax.random.normal(k, shape, f32) * scale

    def gain(k, shape):
        return 1.0 + 0.02 * jax.random.normal(k, shape, f32)

    return {
        "x": nrm(ks[0], (BATCH, SEQ, D_MODEL), 1.0),
        "meta_tokens": nrm(ks[1], (N_META, D_MODEL), 1.0),
        "rel_bias": nrm(ks[2], (NUM_BUCKETS, DIFF_HEADS), 0.5),
        "attn_norm": gain(ks[3], (DEPTH, D_MODEL)),
        "w_in": nrm(ks[4], (DEPTH, D_MODEL, IN_WIDTH), D_MODEL ** -0.5),
        "mla_q_norm": gain(ks[5], (DEPTH, MLA_Q_RANK)),
        "mla_w_uq": nrm(ks[6], (DEPTH, MLA_Q_RANK, MLA_HEADS * MLA_QK_DIM), MLA_Q_RANK ** -0.5),
        "mla_kv_norm": gain(ks[7], (DEPTH, MLA_KV_RANK)),
        "mla_w_ukv": nrm(ks[8], (DEPTH, MLA_KV_RANK, MLA_HEADS * (MLA_NOPE_DIM + MLA_V_DIM)), MLA_KV_RANK ** -0.5),
        "mla_qk_norm_q": gain(ks[9], (DEPTH, MLA_QK_DIM)),
        "mla_qk_norm_k": gain(ks[10], (DEPTH, MLA_QK_DIM)),
        "diff_q_norm": gain(ks[11], (DEPTH, DIFF_HEAD_DIM)),
        "diff_k_norm": gain(ks[12], (DEPTH, DIFF_HEAD_DIM)),
        "diff_lambda_q1": nrm(ks[13], (DEPTH, DIFF_HEAD_DIM), 0.1),
        "diff_lambda_k1": nrm(ks[14], (DEPTH, DIFF_HEAD_DIM), 0.1),
        "diff_lambda_q2": nrm(ks[15], (DEPTH, DIFF_HEAD_DIM), 0.1),
        "diff_lambda_k2": nrm(ks[16], (DEPTH, DIFF_HEAD_DIM), 0.1),
        "diff_subln": gain(ks[17], (DEPTH, DIFF_V_DIM)),
        "w_out": nrm(ks[18], (DEPTH, MIX_WIDTH, D_MODEL), MIX_WIDTH ** -0.5),
        "ffn_norm": gain(ks[19], (DEPTH, D_MODEL)),
        "peer_w_query": nrm(ks[20], (DEPTH, D_MODEL, PEER_HEADS * PEER_QUERY_DIM), D_MODEL ** -0.5),
        "peer_sub_keys": nrm(ks[21], (DEPTH, PEER_HEADS, 2, PEER_N_KEYS, PEER_SUBKEY_DIM), PEER_SUBKEY_DIM ** -0.5),
        "peer_u": nrm(ks[22], (DEPTH, PEER_N_EXPERTS, D_MODEL), D_MODEL ** -0.5),
        "peer_v": nrm(ks[23], (DEPTH, PEER_N_EXPERTS, D_MODEL), PEER_HEADS ** -0.5),
    }


def reference(x, meta_tokens, rel_bias, attn_norm, w_in, mla_q_norm, mla_w_uq, mla_kv_norm, mla_w_ukv,
              mla_qk_norm_q, mla_qk_norm_k, diff_q_norm, diff_k_norm, diff_lambda_q1, diff_lambda_k1,
              diff_lambda_q2, diff_lambda_k2, diff_subln, w_out, ffn_norm, peer_w_query, peer_sub_keys,
              peer_u, peer_v):
    b, s, d = x.shape
    l_real = N_META + s
    l_pad = -(-l_real // BLOCK_Q) * BLOCK_Q
    meta = jnp.broadcast_to(meta_tokens[None].astype(x.dtype), (b, N_META, d))
    h = jnp.concatenate([meta, x, jnp.zeros((b, l_pad - l_real, d), x.dtype)], axis=1)
    pos = jnp.arange(l_pad, dtype=jnp.int32)
    for layer in range(DEPTH):
        lambda_init = 0.8 - 0.6 * math.exp(-0.3 * layer)
        n = _rms_norm(h, attn_norm[layer])
        proj = n @ w_in[layer]
        c_q, c_kv, k_rope, dq, dk, dv = jnp.split(proj, IN_SPLITS, axis=-1)
        y_mla = _mla(c_q, c_kv, k_rope, mla_q_norm[layer], mla_w_uq[layer], mla_kv_norm[layer],
                     mla_w_ukv[layer], mla_qk_norm_q[layer], mla_qk_norm_k[layer], pos)
        y_diff = _diff_attn(dq, dk, dv, diff_q_norm[layer], diff_k_norm[layer], diff_lambda_q1[layer],
                            diff_lambda_k1[layer], diff_lambda_q2[layer], diff_lambda_k2[layer],
                            diff_subln[layer], rel_bias, pos, lambda_init)
        h = h + jnp.concatenate([y_mla, y_diff], axis=-1) @ w_out[layer]
        h = h + _peer(_rms_norm(h, ffn_norm[layer]), peer_w_query[layer], peer_sub_keys[layer],
                      peer_u[layer], peer_v[layer])
    return h[:, N_META:l_real]
```

```cpp
#include <hip/hip_runtime.h>
#include <cstdio>
#include <cstdint>

#ifndef MK_PER_PHASE
#define MK_PER_PHASE 0
#endif

#ifndef REPEAT_MASK
#define REPEAT_MASK 0
#endif
#ifndef P2ON
#define P2ON 3
#endif
#ifndef PROBE_P8
#define PROBE_P8 0
#endif
#ifndef PROBE_ZERO_MLA
#define PROBE_ZERO_MLA 0
#endif
#define GAS __attribute__((address_space(1)))
#define LAS __attribute__((address_space(3)))
typedef unsigned short bf16_t;
typedef short bf16x8 __attribute__((ext_vector_type(8)));
typedef short s16x4 __attribute__((ext_vector_type(4)));
typedef short v4i16_t __attribute__((ext_vector_type(4)));
typedef float f32x2 __attribute__((ext_vector_type(2)));
typedef float f32x4 __attribute__((ext_vector_type(4)));
typedef float f32x16 __attribute__((ext_vector_type(16)));
typedef unsigned u32x2 __attribute__((ext_vector_type(2)));
typedef unsigned u32x4 __attribute__((ext_vector_type(4)));
typedef __bf16 bf16x2_t __attribute__((ext_vector_type(2)));
typedef LAS unsigned char* lds_ptr;
typedef LAS const char* lds_cptr;

#define MFMA32(a, b, c) __builtin_amdgcn_mfma_f32_32x32x16_bf16((a), (b), (c), 0, 0, 0)
#define LDS_WAIT() asm volatile("s_waitcnt lgkmcnt(0)" ::: "memory")
#define VM_WAIT() asm volatile("s_waitcnt vmcnt(0)" ::: "memory")

constexpr int BATCH = 4, SEQ = 8192, DMODEL = 1024, MTOK = BATCH * SEQ;
constexpr int NMETA = 16, LREAL = NMETA + SEQ, LP = 8256, MP = BATCH * LP;
constexpr int P1W = 2048;
constexpr int C_CQ = 0, C_CKV = 256, C_DQ = 512, C_DK = 1024, C_DV = 1536;
constexpr int XB_ROWS = MTOK + 256;
constexpr int XB_META = MTOK, XB_ZERO = MTOK + 16;
constexpr float EPS = 1e-6f;
constexpr float LOG2E = 1.4426950408889634f;
constexpr float QS_MLA = 0.10206207261596577f * LOG2E;
constexpr float QS_DIFF = 0.125f * LOG2E;
constexpr float LAMBDA_INIT = 0.2f;
constexpr float SM_THR = 8.0f;

__device__ const double ROPE_INVF[16] = {1.0, 0.5623413251903491, 0.31622776601683794, 0.1778279410038923, 0.1, 0.05623413251903491, 0.03162277660168379, 0.01778279410038923,
    0.01, 0.005623413251903491, 0.0031622776601683794, 0.0017782794100389228, 0.001, 0.0005623413251903491, 0.00031622776601683794, 0.00017782794100389227};
__device__ const unsigned char T5_BUCKET[128] = {0, 1, 2, 3, 4, 5, 6, 7, 8, 9, 10, 11, 12, 13, 14, 15, 16, 16, 16, 17, 17, 18, 18, 18, 19, 19, 19, 20, 20, 20, 20, 21, 21, 21, 21, 22, 22, 22, 22, 22,
    23, 23, 23, 23, 23, 23, 24, 24, 24, 24, 24, 24, 25, 25, 25, 25, 25, 25, 25, 26, 26, 26, 26, 26, 26, 26, 26, 27, 27, 27, 27, 27, 27, 27, 27, 27, 27, 28, 28, 28, 28, 28, 28, 28, 28, 28, 28,
    29, 29, 29, 29, 29, 29, 29, 29, 29, 29, 29, 29, 30, 30, 30, 30, 30, 30, 30, 30, 30, 30, 30, 30, 30, 30, 31, 31, 31, 31, 31, 31, 31, 31, 31, 31, 31, 31, 31, 31, 31};

constexpr size_t al256(size_t x) { return (x + 255) & ~(size_t)255; }
constexpr size_t WS_CTL = 0, CTL_ZERO_BYTES = 1u << 20;
constexpr size_t WS_W1T = CTL_ZERO_BYTES;
constexpr size_t WS_WKR = WS_W1T + (size_t)2048 * 1024 * 2;
constexpr size_t WS_WUQ = WS_WKR + (size_t)32 * 1024 * 2;
constexpr size_t WS_WUKV = WS_WUQ + (size_t)768 * 256 * 2;
constexpr size_t WS_SK = WS_WUKV + (size_t)1024 * 256 * 2;
constexpr size_t WS_WOUT = WS_SK + (size_t)16 * 128 * 128 * 2;
constexpr size_t WS_WPQ = WS_WOUT + (size_t)1024 * 1024 * 2;
constexpr size_t WS_RSTD1 = WS_WPQ + (size_t)2048 * 1024 * 2;
constexpr size_t WS_SU = al256(WS_RSTD1 + (size_t)XB_ROWS * 4);
constexpr size_t WS_SV = WS_SU + (size_t)16384 * 4;
constexpr size_t WS_SSQP = WS_SV + (size_t)16384 * 4;
constexpr size_t WS_U8 = al256(WS_SSQP + (size_t)MTOK * 16 * 4);
constexpr size_t WS_V8 = WS_U8 + (size_t)16384 * 1024;
constexpr size_t WS_XB = al256(WS_V8 + (size_t)16384 * 1024);
constexpr size_t WS_H2B = WS_XB;
constexpr size_t WS_P1 = al256(WS_XB + (size_t)XB_ROWS * 1024 * 2);
constexpr size_t WS_QP = WS_P1;
constexpr size_t WS_QM = al256(WS_P1 + (size_t)MP * P1W * 2);
constexpr size_t WS_EI = WS_QM, WS_EG = WS_QM + (size_t)MTOK * 128 * 4;
constexpr size_t WS_KM = al256(WS_QM + (size_t)MP * 768 * 2);
constexpr size_t WS_VM = al256(WS_KM + (size_t)MP * 768 * 2);
constexpr size_t WS_Y = al256(WS_VM + (size_t)MP * 512 * 2);
constexpr size_t WS_END = al256(WS_Y + (size_t)MTOK * 1024 * 2);
static_assert(WS_EG + (size_t)MTOK * 128 * 4 <= WS_KM, "EI/EG overlay fits in QM");
static_assert((size_t)MTOK * 2048 * 2 <= (size_t)MP * P1W * 2, "QP overlay fits in P1");
constexpr int CW_BAR = 4096;

constexpr int RING_BYTES = 131072;
constexpr int TAB_OFF = RING_BYTES;
constexpr int MISC_OFF = RING_BYTES + 12288;
constexpr int LDS_BYTES = 147456;
constexpr int NWAVES = 8, NTHREADS = 512;

__device__ __forceinline__ unsigned pk2(float lo, float hi) { f32x2 v = {lo, hi}; bf16x2_t b = __builtin_convertvector(v, bf16x2_t); return __builtin_bit_cast(unsigned, b); }
__device__ __forceinline__ float bf_lo(unsigned u) { return __uint_as_float(u << 16); }
__device__ __forceinline__ float bf_hi(unsigned u) { return __uint_as_float(u & 0xffff0000u); }
__device__ __forceinline__ int crow(int r, int hi) { return (r & 3) + 8 * (r >> 2) + 4 * hi; }
__device__ __forceinline__ float wave_sum(float v) {
#pragma unroll
    for (int o = 1; o < 64; o <<= 1) v += __shfl_xor(v, o);
    return v;
}
__device__ __forceinline__ float xhalf_sum(float v) { return v + __shfl_xor(v, 32); }
__device__ __forceinline__ float xhalf_max(float v) { return fmaxf(v, __shfl_xor(v, 32)); }
__device__ __forceinline__ float ssq8(u32x4 w) {
    float s = 0.f;
#pragma unroll
    for (int i = 0; i < 4; ++i) asm volatile("v_dot2c_f32_bf16 %0, %1, %2" : "+v"(s) : "v"(w[i]), "v"(w[i]));
    return s;
}
__device__ __forceinline__ bf16x8 ld_frag(const bf16_t* p) { return __builtin_bit_cast(bf16x8, *(const u32x4*)p); }
__device__ __forceinline__ f32x16 zero16() { f32x16 z;
#pragma unroll
    for (int i = 0; i < 16; ++i) z[i] = 0.f;
    return z; }
__device__ __forceinline__ s16x4 vtr(lds_cptr p) { return __builtin_bit_cast(s16x4, __builtin_amdgcn_ds_read_tr16_b64_v4i16((LAS v4i16_t*)p)); }

namespace pg8 {
#define PG8_LAS __attribute__((address_space(3)))
constexpr int BM = 256, BK = 64, HALF = 128, HTB = HALF * BK * 2, STAGE_BYTES = 8 * HTB, NXCD = 8, WGM = 8;
__host__ __device__ __forceinline__ int lds_byte(int r, int c) { const int st = (r >> 4) * 2 + (c >> 5), rr = r & 15, cc = c & 31, ob = rr * 64 + cc * 2; return st * 1024 + (ob ^ (((ob >> 9) & 1) << 5)); }
__host__ __device__ __forceinline__ void stage_rc(int b, int& R, int& C) { const int st = b / 1024, sb = b % 1024, swz = sb ^ (((sb >> 9) & 1) << 5); R = (st >> 1) * 16 + swz / 64; C = (st & 1) * 32 + (swz % 64) / 2; }
__host__ __device__ __forceinline__ int perm32(int rho) { const int n = rho >> 4, i = rho & 15; return 8 * (i >> 2) + 4 * n + (i & 3); }
struct Unit { int pm, pn; };
struct Gemm { const bf16_t* A; const bf16_t* Bt; int M, N, K; };
struct StaticOrder {
    int nM, nN, nwg, G, c;
    __host__ __device__ void init(int M, int N, int G_, int c_) { nM = M / BM; nN = N / BM; nwg = nM * nN; G = G_; c = c_; }
    __host__ __device__ bool next(int i, Unit& u) const {
        const long L = (long)i * G + c; if (L >= nwg) return false;
        int wgid = (int)L; { const int q = nwg / NXCD, r = nwg % NXCD, xcd = wgid % NXCD, off = wgid / NXCD; wgid = (xcd < r ? xcd * (q + 1) : r * (q + 1) + (xcd - r) * q) + off; }
        const int nig = WGM * nN, gid = wgid / nig, fm = gid * WGM, gsz = (nM - fm) < WGM ? (nM - fm) : WGM;
        u.pm = fm + ((wgid % nig) % gsz); u.pn = (wgid % nig) / gsz; return true;
    }
    __device__ __forceinline__ void a_ready(const Unit&) const {}
    __device__ __forceinline__ void done(const Unit&) const {}
};
template <class Epi, class Sched, bool ALIGN_EPI = false, bool SP2 = false>
__device__ __forceinline__ void gemm_phase(PG8_LAS unsigned char* lds, const Gemm g, const Sched& S, const Epi& E) {
    const int tid = threadIdx.x, wid = __builtin_amdgcn_readfirstlane(tid >> 6), lane = tid & 63, wr = wid >> 2, wc = wid & 3, fr = lane & 15, fq = lane >> 4;
    const int K = g.K, nt = K / BK;
    unsigned voffA[2], voffB[2];
#pragma unroll
    for (int i = 0; i < 2; ++i) { int R, C; stage_rc(tid * 16 + i * 8192, R, C); const int Rb = Epi::PERM ? ((R & ~31) + perm32(R & 31)) : R;
        voffA[i] = (unsigned)(R * K + C) * 2u; voffB[i] = (unsigned)(Rb * K + C) * 2u; }
    const size_t kstep = (size_t)(BK * 2);
    const size_t hstep = (size_t)HALF * K * 2;
    const size_t tstep = 2 * hstep;
    const unsigned ldsw = (unsigned)wid * 1024u;
    const int aoff = lds_byte(wr * 64 + fr, fq * 8), boff = lds_byte(wc * 32 + fr, fq * 8);
#define PG8_SA(b, h) (((b) * 2 + (h)) * HTB)
#define PG8_SB(b, h) ((4 + (b) * 2 + (h)) * HTB)
#define PG8_STAGE(bufoff, gbase, voff) do { _Pragma("unroll") for (int _i = 0; _i < 2; ++_i) \
        __builtin_amdgcn_global_load_lds((const unsigned*)((const char*)(gbase) + (voff)[_i]), (PG8_LAS unsigned*)(lds + (bufoff) + ldsw + _i * 8192), 16, 0, 0); } while (0)
#define PG8_LDA(dst, b, h) do { _Pragma("unroll") for (int m = 0; m < 4; ++m) _Pragma("unroll") for (int k = 0; k < 2; ++k) dst[m][k] = *(const PG8_LAS bf16x8*)(lds + PG8_SA(b, h) + aoff + m * 2048 + k * 1024); } while (0)
#define PG8_LDB(dst, b, h) do { _Pragma("unroll") for (int n = 0; n < 2; ++n) _Pragma("unroll") for (int k = 0; k < 2; ++k) dst[n][k] = *(const PG8_LAS bf16x8*)(lds + PG8_SB(b, h) + boff + n * 2048 + k * 1024); } while (0)
#define PG8_MMA(ai, bj, At, Bt) do { __builtin_amdgcn_s_setprio(1); _Pragma("unroll") for (int m = 0; m < 4; ++m) _Pragma("unroll") for (int n = 0; n < 2; ++n) _Pragma("unroll") for (int k = 0; k < 2; ++k) \
        acc[ai][bj][m][n] = __builtin_amdgcn_mfma_f32_16x16x32_bf16(Bt[n][k], At[m][k], acc[ai][bj][m][n], 0, 0, 0); __builtin_amdgcn_s_setprio(0); } while (0)
#define PG8_WAIT_V(n) asm volatile("s_waitcnt vmcnt(" #n ")" ::: "memory")
#define PG8_WAIT_L(n) asm volatile("s_waitcnt lgkmcnt(" #n ")" ::: "memory")
#define PG8_BAR __builtin_amdgcn_s_barrier()
#define PG8_SCHED __builtin_amdgcn_sched_barrier(0)
    Unit cur, nxt; int ui = 0;
    if (!S.next(0, cur)) return;
    f32x4 acc[2][2][4][2];
#pragma unroll
    for (int a = 0; a < 2; ++a)
#pragma unroll
        for (int b = 0; b < 2; ++b)
#pragma unroll
            for (int m = 0; m < 4; ++m)
#pragma unroll
                for (int n = 0; n < 2; ++n) acc[a][b][m][n] = (f32x4){0.f, 0.f, 0.f, 0.f};
    bf16x8 At[4][2], B0[2][2], B1[2][2];
    const char* cA = (const char*)g.A + (size_t)cur.pm * tstep; const char* cB = (const char*)g.Bt + (size_t)cur.pn * tstep;
    S.a_ready(cur);
    if constexpr (SP2) {
        PG8_STAGE(PG8_SB(0, 0), cB, voffB); PG8_STAGE(PG8_SB(0, 1), cB + hstep, voffB); PG8_STAGE(PG8_SA(0, 0), cA, voffA); PG8_STAGE(PG8_SA(0, 1), cA + hstep, voffA);
        if (wr == 1) PG8_BAR;
        PG8_WAIT_V(2); PG8_BAR;
        PG8_STAGE(PG8_SB(1, 0), cB + kstep, voffB); PG8_STAGE(PG8_SA(1, 0), cA + kstep, voffA); PG8_STAGE(PG8_SB(1, 1), cB + hstep + kstep, voffB);
        PG8_WAIT_V(6); PG8_BAR;
    } else {
        PG8_STAGE(PG8_SB(0, 0), cB, voffB); PG8_STAGE(PG8_SA(0, 0), cA, voffA); PG8_STAGE(PG8_SB(0, 1), cB + hstep, voffB); PG8_STAGE(PG8_SA(0, 1), cA + hstep, voffA);
        if (wr == 1) PG8_BAR;
        PG8_WAIT_V(4); PG8_BAR;
        PG8_STAGE(PG8_SB(1, 0), cB + kstep, voffB); PG8_STAGE(PG8_SA(1, 0), cA + kstep, voffA); PG8_STAGE(PG8_SB(1, 1), cB + hstep + kstep, voffB);
        PG8_WAIT_V(6); PG8_BAR;
    }
    for (;;) {
        const bool has_next = S.next(ui + 1, nxt);
        const char* nA = has_next ? (const char*)g.A + (size_t)nxt.pm * tstep : cA; const char* nB = has_next ? (const char*)g.Bt + (size_t)nxt.pn * tstep : cB;
        for (int t = 0; t < nt; t += 2) {
            const bool last = (t == nt - 2);
            const char* a1 = cA + (size_t)(t + 1) * kstep;
            const char* a2 = last ? nA : cA + (size_t)(t + 2) * kstep; const char* b2 = last ? nB : cB + (size_t)(t + 2) * kstep;
            const char* a3 = a2 + kstep; const char* b3 = b2 + kstep;
            if (last && has_next) S.a_ready(nxt);
            if constexpr (SP2) {
            PG8_LDB(B0, 0, 0); PG8_LDB(B1, 0, 1); PG8_SCHED; PG8_LDA(At, 0, 0); PG8_STAGE(PG8_SA(1, 1), a1 + hstep, voffA);
            PG8_WAIT_V(8); PG8_WAIT_L(0); PG8_BAR; PG8_MMA(0, 0, At, B0); PG8_MMA(0, 1, At, B1); PG8_BAR; PG8_SCHED;
            PG8_LDA(At, 0, 1); PG8_STAGE(PG8_SB(0, 0), b2, voffB); PG8_STAGE(PG8_SB(0, 1), b2 + hstep, voffB); PG8_STAGE(PG8_SA(0, 0), a2, voffA);
            PG8_WAIT_V(8); PG8_WAIT_L(0); PG8_BAR; PG8_MMA(1, 0, At, B0); PG8_MMA(1, 1, At, B1); PG8_BAR; PG8_SCHED;
            PG8_LDB(B0, 1, 0); PG8_LDB(B1, 1, 1); PG8_SCHED; PG8_LDA(At, 1, 0); PG8_STAGE(PG8_SA(0, 1), a2 + hstep, voffA);
            PG8_WAIT_V(8); PG8_WAIT_L(0); PG8_BAR; PG8_MMA(0, 0, At, B0); PG8_MMA(0, 1, At, B1); PG8_BAR; PG8_SCHED;
            PG8_LDA(At, 1, 1); PG8_STAGE(PG8_SB(1, 0), b3, voffB); PG8_STAGE(PG8_SB(1, 1), b3 + hstep, voffB); PG8_STAGE(PG8_SA(1, 0), a3, voffA);
            PG8_WAIT_V(8); PG8_WAIT_L(0); PG8_BAR; PG8_MMA(1, 0, At, B0); PG8_MMA(1, 1, At, B1); PG8_BAR; PG8_SCHED;
            } else {
            PG8_LDB(B0, 0, 0); PG8_SCHED; PG8_LDA(At, 0, 0); PG8_STAGE(PG8_SA(1, 1), a1 + hstep, voffA);
            PG8_WAIT_L(8); PG8_BAR; PG8_WAIT_L(0); PG8_MMA(0, 0, At, B0); PG8_BAR; PG8_SCHED;
            PG8_LDB(B1, 0, 1); PG8_STAGE(PG8_SB(0, 0), b2, voffB);
            PG8_BAR; PG8_WAIT_L(0); PG8_MMA(0, 1, At, B1); PG8_BAR;
            PG8_LDA(At, 0, 1); PG8_STAGE(PG8_SA(0, 0), a2, voffA);
            PG8_BAR; PG8_WAIT_L(0); PG8_MMA(1, 0, At, B0); PG8_BAR; PG8_SCHED;
            PG8_STAGE(PG8_SB(0, 1), b2 + hstep, voffB);
            PG8_WAIT_V(6); PG8_BAR; PG8_MMA(1, 1, At, B1); PG8_BAR;
            PG8_LDB(B0, 1, 0); PG8_SCHED; PG8_LDA(At, 1, 0); PG8_STAGE(PG8_SA(0, 1), a2 + hstep, voffA);
            PG8_WAIT_L(8); PG8_BAR; PG8_WAIT_L(0); PG8_MMA(0, 0, At, B0); PG8_BAR; PG8_SCHED;
            PG8_LDB(B1, 1, 1); PG8_STAGE(PG8_SB(1, 0), b3, voffB);
            PG8_BAR; PG8_WAIT_L(0); PG8_MMA(0, 1, At, B1); PG8_BAR;
            PG8_LDA(At, 1, 1); PG8_STAGE(PG8_SA(1, 0), a3, voffA);
            PG8_BAR; PG8_WAIT_L(0); PG8_MMA(1, 0, At, B0); PG8_BAR; PG8_SCHED;
            PG8_STAGE(PG8_SB(1, 1), b3 + hstep, voffB);
            PG8_WAIT_V(6); PG8_BAR; PG8_MMA(1, 1, At, B1); PG8_BAR;
            }
        }
        if constexpr (ALIGN_EPI) { if (wr == 0) PG8_BAR; }
        E(acc, cur, wr, wc, fr, fq); S.done(cur);
        if (!has_next) break;
#pragma unroll
        for (int a = 0; a < 2; ++a)
#pragma unroll
            for (int b = 0; b < 2; ++b)
#pragma unroll
                for (int m = 0; m < 4; ++m)
#pragma unroll
                    for (int n = 0; n < 2; ++n) acc[a][b][m][n] = (f32x4){0.f, 0.f, 0.f, 0.f};
        cur = nxt; cA = nA; cB = nB; ++ui;
        if constexpr (ALIGN_EPI) { if (wr == 1) PG8_BAR; }
    }
    PG8_WAIT_V(0);
    if constexpr (!ALIGN_EPI) { if (wr == 0) PG8_BAR; }
    PG8_BAR;
#undef PG8_SA
#undef PG8_SB
#undef PG8_STAGE
#undef PG8_LDA
#undef PG8_LDB
#undef PG8_MMA
#undef PG8_WAIT_V
#undef PG8_WAIT_L
#undef PG8_BAR
#undef PG8_SCHED
}
}

struct EpiP1 {
    static constexpr bool PERM = true, AFTER_DRAIN = false;
    bf16_t* P1; const float* rstd;
    __device__ __forceinline__ void operator()(const f32x4 (&acc)[2][2][4][2], const pg8::Unit& u, int wr, int wc, int fr, int fq) const {
#pragma unroll
        for (int ai = 0; ai < 2; ++ai)
#pragma unroll
            for (int m = 0; m < 4; ++m) {
                const int row = u.pm * 256 + ai * 128 + wr * 64 + m * 16 + fr;
                const float rs = rstd[row];
                const size_t prow = (size_t)(row >> 13) * LP + NMETA + (row & (SEQ - 1));
                bf16_t* rowp = P1 + prow * P1W + u.pn * 256 + wc * 32 + 8 * fq;
#pragma unroll
                for (int bj = 0; bj < 2; ++bj) { const f32x4 v0 = acc[ai][bj][m][0] * rs, v1 = acc[ai][bj][m][1] * rs;
                    u32x4 w; w.x = pk2(v0[0], v0[1]); w.y = pk2(v0[2], v0[3]); w.z = pk2(v1[0], v1[1]); w.w = pk2(v1[2], v1[3]);
                    *(u32x4*)(rowp + bj * 128) = w; } }
    }
};
struct EpiRes {
    static constexpr bool PERM = false, AFTER_DRAIN = false;
    const float* x; float* out; bf16_t* hb; float* ssqp;
    __device__ __forceinline__ void operator()(const f32x4 (&acc)[2][2][4][2], const pg8::Unit& u, int wr, int wc, int fr, int fq) const {
#pragma unroll
        for (int ai = 0; ai < 2; ++ai)
#pragma unroll
            for (int m = 0; m < 4; ++m) {
                const int row = u.pm * 256 + ai * 128 + wr * 64 + m * 16 + fr;
                const size_t off = (size_t)row * DMODEL + u.pn * 256 + wc * 32 + 4 * fq;
                float ss = 0.f;
#pragma unroll
                for (int bj = 0; bj < 2; ++bj)
#pragma unroll
                    for (int n = 0; n < 2; ++n) { const f32x4 hv = *(const f32x4*)(x + off + bj * 128 + n * 16) + acc[ai][bj][m][n];
                        u32x2 wv; wv.x = pk2(hv[0], hv[1]); wv.y = pk2(hv[2], hv[3]); *(u32x2*)(hb + off + bj * 128 + n * 16) = wv;
                        ss = __builtin_fmaf(hv[0], hv[0], ss); ss = __builtin_fmaf(hv[1], hv[1], ss); ss = __builtin_fmaf(hv[2], hv[2], ss); ss = __builtin_fmaf(hv[3], hv[3], ss); }
                ss += __shfl_xor(ss, 16); ss += __shfl_xor(ss, 32);
                if (fq == 0) ssqp[(size_t)row * 16 + u.pn * 4 + wc] = ss;
            }
    }
};
struct EpiPlain {
    static constexpr bool PERM = true, AFTER_DRAIN = false;
    bf16_t* O; int ldc;
    __device__ __forceinline__ void operator()(const f32x4 (&acc)[2][2][4][2], const pg8::Unit& u, int wr, int wc, int fr, int fq) const {
#pragma unroll
        for (int ai = 0; ai < 2; ++ai)
#pragma unroll
            for (int m = 0; m < 4; ++m) {
                bf16_t* rowp = O + (size_t)(u.pm * 256 + ai * 128 + wr * 64 + m * 16 + fr) * ldc + u.pn * 256 + wc * 32 + 8 * fq;
#pragma unroll
                for (int bj = 0; bj < 2; ++bj) { const f32x4 v0 = acc[ai][bj][m][0], v1 = acc[ai][bj][m][1];
                    u32x4 w; w.x = pk2(v0[0], v0[1]); w.y = pk2(v0[2], v0[3]); w.z = pk2(v1[0], v1[1]); w.w = pk2(v1[2], v1[3]);
                    *(u32x4*)(rowp + bj * 128) = w; } }
    }
};

#define XB_TMO      128
#define XB_XCNT(j)  (256  + 64 * (j))
#define XB_XSUB(j)  (1280 + 64 * (j))
#define XB_XGEN(j)  (2304 + 64 * (j))
#define XB_TOP      3328
#define XB_TOPGEN   3392
#define XCD_BAR_WORDS 3456
#define XB_SPIN_CAP (1u << 18)
__device__ __forceinline__ unsigned xb_ld(unsigned* p)              { return __hip_atomic_load(p, __ATOMIC_RELAXED, __HIP_MEMORY_SCOPE_AGENT); }
__device__ __forceinline__ unsigned xb_add(unsigned* p, unsigned v) { return __hip_atomic_fetch_add(p, v, __ATOMIC_RELAXED, __HIP_MEMORY_SCOPE_AGENT); }
__device__ __forceinline__ unsigned xb_xcc_id() { return (unsigned)__builtin_amdgcn_s_getreg((3 << 11) | 20) & 0xFu; }
#define XB_SPIN(cond, bar) do { unsigned _sp = 0; while (cond) { __builtin_amdgcn_s_sleep(1); \
    if ((++_sp & 255u) == 0u) { if (xb_ld(&(bar)[XB_TMO])) break; if (_sp > XB_SPIN_CAP) { atomicAdd(&(bar)[XB_TMO], 1u); break; } } } } while (0)
struct XcdBarrier { unsigned* bar; unsigned x; volatile LAS unsigned* st; };
__device__ __forceinline__ XcdBarrier xcd_barrier_post(unsigned* bar, volatile LAS unsigned* st) {
    XcdBarrier b; b.bar = bar; b.x = xb_xcc_id(); b.st = st;
    if (threadIdx.x == 0) (void)xb_add(&bar[XB_XCNT(b.x)], 1u);
    return b;
}
__device__ __forceinline__ void xcd_barrier_complete(unsigned* bar, unsigned x, unsigned& nloc, unsigned& nx) {
    const unsigned G = gridDim.x * gridDim.y * gridDim.z;
    unsigned sum, cnt, mine, sp = 0u;
    for (;;) {
        sum = 0u; cnt = 0u; mine = 0u;
#pragma unroll
        for (unsigned j = 0; j < 16; ++j) { const unsigned c = xb_ld(&bar[XB_XCNT(j)]); sum += c; cnt += (c > 0u) ? 1u : 0u; mine = (j == x) ? c : mine; }
        if (sum == G) break;
        __builtin_amdgcn_s_sleep(1);
        if ((++sp & 255u) == 0u) { if (xb_ld(&bar[XB_TMO])) break; if (sp > XB_SPIN_CAP) { atomicAdd(&bar[XB_TMO], 1u); break; } }
    }
    nloc = mine > 0u ? mine : 1u; nx = cnt > 0u ? cnt : 1u;
}
__device__ __forceinline__ void xcd_barrier(const XcdBarrier& b) {
    asm volatile("s_waitcnt vmcnt(0)" ::: "memory");
    __syncthreads();
    if (threadIdx.x == 0) {
        unsigned* bar = b.bar;
        __builtin_amdgcn_s_waitcnt(0);
        unsigned nloc = b.st[0], nx = b.st[1];
        if (nloc == 0u) { xcd_barrier_complete(bar, b.x, nloc, nx); b.st[0] = nloc; b.st[1] = nx; }
        const unsigned old = xb_add(&bar[XB_XSUB(b.x)], 1u);
        const unsigned gen = old / nloc;
        if (old + 1u == (gen + 1u) * nloc) {
            __builtin_amdgcn_fence(__ATOMIC_RELEASE, "agent");
            asm volatile("s_waitcnt vmcnt(0)" ::: "memory");
            const unsigned og = xb_add(&bar[XB_TOP], 1u);
            const unsigned tg = og / nx;
            if (og + 1u == (tg + 1u) * nx) xb_add(&bar[XB_TOPGEN], 1u);
            else XB_SPIN(xb_ld(&bar[XB_TOPGEN]) == tg, bar);
            __builtin_amdgcn_fence(__ATOMIC_ACQUIRE, "agent");
            xb_add(&bar[XB_XGEN(b.x)], 1u);
            asm volatile("s_waitcnt vmcnt(0)" ::: "memory");
        } else {
            XB_SPIN(xb_ld(&bar[XB_XGEN(b.x)]) == gen, bar);
            __builtin_amdgcn_fence(__ATOMIC_ACQUIRE, "agent");
            asm volatile("s_waitcnt vmcnt(0)" ::: "memory");
        }
    }
    __syncthreads();
}

struct Args { const float* in[24]; float* out; unsigned char* ws; int ph_lo, ph_hi; };
struct Frame {
    lds_ptr lds; int tid, lane, wave, G, gw, ngw;
    float* out; unsigned char* ws;
};
enum { I_X = 0, I_META, I_RELB, I_ANORM, I_WIN, I_QNORM, I_WUQ, I_KVNORM, I_WUKV, I_QKNQ, I_QKNK, I_DQN, I_DKN, I_LQ1, I_LK1, I_LQ2, I_LK2, I_SUBLN, I_WOUT, I_FNORM, I_WPQ, I_SUBK, I_PU, I_PV };

__device__ __forceinline__ void transpose_item(const float* W, int ldw, int c0, int K, int N, const float* gain, bf16_t* WT, int row_off, LAS float* scr, int item, int lane) {
    const int nblk = N / 32, kb = item / nblk, nb = item % nblk, k0 = 64 * kb, n0 = 32 * nb;
#pragma unroll 8
    for (int i = 0; i < 32; ++i) { const int kk = 2 * i + (lane >> 5); float v = W[(size_t)(k0 + kk) * ldw + c0 + n0 + (lane & 31)]; if (gain) v *= gain[k0 + kk]; scr[kk * 33 + (lane & 31)] = v; }
    LDS_WAIT(); asm volatile("" ::: "memory");
    const int c = lane & 7;
#pragma unroll
    for (int j = 0; j < 4; ++j) { const int n = (lane >> 3) + 8 * j; const LAS float* s = scr + (8 * c) * 33 + n;
        u32x4 o; o.x = pk2(s[0 * 33], s[1 * 33]); o.y = pk2(s[2 * 33], s[3 * 33]); o.z = pk2(s[4 * 33], s[5 * 33]); o.w = pk2(s[6 * 33], s[7 * 33]);
        *(u32x4*)(WT + (size_t)(row_off + n0 + n) * K + k0 + 8 * c) = o; }
    LDS_WAIT(); asm volatile("" ::: "memory");
}
__device__ __forceinline__ void cvt_row_1024(const float* src, bf16_t* dst, int lane) {
    const f32x4* xr = (const f32x4*)src + lane; f32x4 v[4];
#pragma unroll
    for (int j = 0; j < 4; ++j) v[j] = xr[64 * j];
    u32x2* o8 = (u32x2*)dst + lane;
#pragma unroll
    for (int j = 0; j < 4; ++j) { u32x2 w; w.x = pk2(v[j][0], v[j][1]); w.y = pk2(v[j][2], v[j][3]); o8[64 * j] = w; }
}
__device__ __forceinline__ float cvt_row_1024_ssq(const float* src, bf16_t* dst, int lane) {
    const f32x4* xr = (const f32x4*)src + lane; f32x4 v[4]; float s = 0.f;
#pragma unroll
    for (int j = 0; j < 4; ++j) { v[j] = xr[64 * j]; s += (v[j][0] * v[j][0] + v[j][1] * v[j][1]) + (v[j][2] * v[j][2] + v[j][3] * v[j][3]); }
    u32x2* o8 = (u32x2*)dst + lane;
#pragma unroll
    for (int j = 0; j < 4; ++j) { u32x2 w; w.x = pk2(v[j][0], v[j][1]); w.y = pk2(v[j][2], v[j][3]); o8[64 * j] = w; }
    return wave_sum(s);
}
__device__ __forceinline__ float quant_f32x4x4(const f32x4 (&v)[4], unsigned* dst, int off, int lane) {
    float am = 0.f;
#pragma unroll
    for (int j = 0; j < 4; ++j) am = fmaxf(fmaxf(am, fmaxf(fabsf(v[j][0]), fabsf(v[j][1]))), fmaxf(fabsf(v[j][2]), fabsf(v[j][3])));
#pragma unroll
    for (int o = 1; o < 64; o <<= 1) am = fmaxf(am, __shfl_xor(am, o));
    const float inv = am > 0.f ? 127.0f / am : 0.f;
#pragma unroll
    for (int j = 0; j < 4; ++j) { unsigned w = 0u;
#pragma unroll
        for (int i = 0; i < 4; ++i) { const int q = (int)__builtin_rintf(v[j][i] * inv) + off; w |= ((unsigned)q & 255u) << (8 * i); }
        dst[lane + 64 * j] = w; }
    return am * (1.0f / 127.0f);
}
__device__ __forceinline__ float quant_row_1024_fp8(const float* src, unsigned* dst, int lane) {
    const f32x4* xr = (const f32x4*)src + lane; f32x4 v[4]; float am = 0.f;
#pragma unroll
    for (int j = 0; j < 4; ++j) { v[j] = xr[64 * j]; am = fmaxf(fmaxf(am, fmaxf(fabsf(v[j][0]), fabsf(v[j][1]))), fmaxf(fabsf(v[j][2]), fabsf(v[j][3]))); }
#pragma unroll
    for (int o = 1; o < 64; o <<= 1) am = fmaxf(am, __shfl_xor(am, o));
    const float inv = am > 0.f ? 440.0f / am : 0.f;
#pragma unroll
    for (int j = 0; j < 4; ++j) { int w = __builtin_amdgcn_cvt_pk_fp8_f32(v[j][0] * inv, v[j][1] * inv, 0, false); w = __builtin_amdgcn_cvt_pk_fp8_f32(v[j][2] * inv, v[j][3] * inv, w, true); dst[lane + 64 * j] = (unsigned)w; }
    return am * (1.0f / 440.0f);
}
__device__ __forceinline__ float quant_row_1024(const float* src, unsigned* dst, int off, int lane) {
    const f32x4* xr = (const f32x4*)src + lane; f32x4 v[4];
#pragma unroll
    for (int j = 0; j < 4; ++j) v[j] = xr[64 * j];
    return quant_f32x4x4(v, dst, off, lane);
}
__device__ __forceinline__ void zero_bytes_wave(unsigned char* p, int nbytes, int lane) {
    for (int o = lane * 16; o < nbytes; o += 1024) *(u32x4*)(p + o) = (u32x4){0u, 0u, 0u, 0u};
}
__device__ __forceinline__ void quant_expert_tables(Frame& F, const Args& A) {
    unsigned char* ws = F.ws; const int gw = F.gw, NGW = F.ngw, lane = F.lane;
    { signed char* U8 = (signed char*)(ws + WS_U8); unsigned char* V8 = (unsigned char*)(ws + WS_V8); float* SU = (float*)(ws + WS_SU); float* SV = (float*)(ws + WS_SV);
      for (int it = gw; it < 32768; it += NGW) { const bool isv = it >= 16384; const int e = isv ? it - 16384 : it;
          const float* src = (isv ? A.in[I_PV] : A.in[I_PU]) + (size_t)e * 1024; unsigned* dst = (unsigned*)((isv ? (unsigned char*)V8 : (unsigned char*)U8) + (size_t)e * 1024);
          const float sc = isv ? quant_row_1024_fp8(src, dst, lane) : quant_row_1024(src, dst, 0, lane); if (lane == 0) (isv ? SV : SU)[e] = sc; } }
}
__device__ __forceinline__ void p0_prologue(Frame& F, const Args& A) {
    LAS float* scr = (LAS float*)(F.lds + F.wave * 16384);
    const int gw = F.gw, NGW = F.ngw, lane = F.lane;
    unsigned char* ws = F.ws;
    bf16_t* W1T = (bf16_t*)(ws + WS_W1T); bf16_t* WKR = (bf16_t*)(ws + WS_WKR); bf16_t* WUQ = (bf16_t*)(ws + WS_WUQ); bf16_t* WUKV = (bf16_t*)(ws + WS_WUKV);
    bf16_t* WOUT = (bf16_t*)(ws + WS_WOUT); bf16_t* WPQ = (bf16_t*)(ws + WS_WPQ); bf16_t* SK = (bf16_t*)(ws + WS_SK);
    constexpr int I_A = 16 * 16, I_B = 16 * 48, I_C = 16 * 1, I_D = 4 * 24, I_E = 4 * 32, I_F = 16 * 32, I_G = 16 * 64;
    constexpr int NITEMS = I_A + I_B + I_C + I_D + I_E + I_F + I_G;
    for (int it = gw; it < NITEMS; it += NGW) {
        int r = it;
        if (r < I_A) { transpose_item(A.in[I_WIN], 2080, 0, 1024, 512, A.in[I_ANORM], W1T, 0, scr, r, lane); continue; } r -= I_A;
        if (r < I_B) { transpose_item(A.in[I_WIN], 2080, 544, 1024, 1536, A.in[I_ANORM], W1T, 512, scr, r, lane); continue; } r -= I_B;
        if (r < I_C) { transpose_item(A.in[I_WIN], 2080, 512, 1024, 32, A.in[I_ANORM], WKR, 0, scr, r, lane); continue; } r -= I_C;
        if (r < I_D) { transpose_item(A.in[I_WUQ], 768, 0, 256, 768, A.in[I_QNORM], WUQ, 0, scr, r, lane); continue; } r -= I_D;
        if (r < I_E) { transpose_item(A.in[I_WUKV], 1024, 0, 256, 1024, A.in[I_KVNORM], WUKV, 0, scr, r, lane); continue; } r -= I_E;
        if (r < I_F) { transpose_item(A.in[I_WOUT], 1024, 0, 1024, 1024, nullptr, WOUT, 0, scr, r, lane); continue; } r -= I_F;
        transpose_item(A.in[I_WPQ], 2048, 0, 1024, 2048, A.in[I_FNORM], WPQ, 0, scr, r, lane);
    }
    for (int it = gw; it < 256; it += NGW) cvt_row_1024(A.in[I_SUBK] + (size_t)it * 1024, SK + (size_t)it * 1024, lane);
    { bf16_t* XB = (bf16_t*)(ws + WS_XB); float* RS = (float*)(ws + WS_RSTD1);
      for (int it = gw; it < XB_ROWS; it += NGW) {
          if (it < XB_ZERO) { const float* src = it < MTOK ? A.in[I_X] + (size_t)it * 1024 : A.in[I_META] + (size_t)(it - MTOK) * 1024;
              const float ss = cvt_row_1024_ssq(src, XB + (size_t)it * 1024, lane); if (lane == 0) RS[it] = 1.0f / sqrtf(ss * (1.0f / 1024.0f) + EPS); }
          else { zero_bytes_wave((unsigned char*)(XB + (size_t)it * 1024), 2048, lane); if (lane == 0) RS[it] = 0.f; } } }
    { bf16_t* P1 = (bf16_t*)(ws + WS_P1); bf16_t* KM = (bf16_t*)(ws + WS_KM); bf16_t* VM = (bf16_t*)(ws + WS_VM);
      for (int it = gw; it < BATCH * (LP - LREAL); it += NGW) { const size_t prow = (size_t)(it / (LP - LREAL)) * LP + LREAL + (it % (LP - LREAL));
          zero_bytes_wave((unsigned char*)(P1 + prow * P1W), P1W * 2, lane); zero_bytes_wave((unsigned char*)(KM + prow * 768), 768 * 2, lane);
          zero_bytes_wave((unsigned char*)(VM + prow * 512), 512 * 2, lane); } }
}

__device__ __forceinline__ void p1_meta_tile(Frame& F, int c) {
    const int lane = F.lane, r32 = lane & 31, hi = lane >> 5;
    const bf16_t* W1T = (const bf16_t*)(F.ws + WS_W1T); const bf16_t* XB = (const bf16_t*)(F.ws + WS_XB); const float* RS = (const float*)(F.ws + WS_RSTD1);
    const int xrow = r32 < NMETA ? XB_META + r32 : XB_ZERO;
    const bf16_t* ap = W1T + (size_t)(32 * c + r32) * 1024 + 8 * hi; const bf16_t* bp = XB + (size_t)xrow * 1024 + 8 * hi;
    f32x16 acc = zero16();
#pragma unroll 8
    for (int s = 0; s < 64; ++s) acc = MFMA32(ld_frag(ap + 16 * s), ld_frag(bp + 16 * s), acc);
    const float rs = RS[xrow];
    bf16_t* P1 = (bf16_t*)(F.ws + WS_P1);
    if (r32 < NMETA) {
#pragma unroll
        for (int g = 0; g < 4; ++g) { u32x2 w; w.x = pk2(acc[4 * g] * rs, acc[4 * g + 1] * rs); w.y = pk2(acc[4 * g + 2] * rs, acc[4 * g + 3] * rs);
#pragma unroll
            for (int b = 0; b < BATCH; ++b) *(u32x2*)(P1 + ((size_t)b * LP + r32) * P1W + 32 * c + 8 * g + 4 * hi) = w; }
    }
}

__device__ __forceinline__ void rope_tables(int pos, int hi, float (&cs)[8], float (&sn)[8]) {
#pragma unroll
    for (int r = 0; r < 8; ++r) { const int i = (r & 3) + 8 * (r >> 2) + 4 * hi;
        const double turns = (double)pos * ROPE_INVF[i] * 0.15915494309189535; const float fr = (float)(turns - __builtin_rint(turns));
        sn[r] = __builtin_amdgcn_sinf(fr); cs[r] = __builtin_amdgcn_cosf(fr); }
}
__device__ __forceinline__ void store4(bf16_t* p, float a, float b, float c, float d) { u32x2 w; w.x = pk2(a, b); w.y = pk2(c, d); *(u32x2*)p = w; }

__device__ __forceinline__ void glds16(const void* gsrc, unsigned lds_dst) { unsigned keep;
    asm volatile("s_mov_b32 %0, m0\n\ts_mov_b32 m0, %2\n\ts_nop 0\n\tglobal_load_lds_dwordx4 %1, off\n\ts_mov_b32 m0, %0" : "=&s"(keep) : "v"(gsrc), "s"(lds_dst) : "memory"); }

template <bool KV>
__device__ __forceinline__ void p2_block(Frame& F, int bj, LAS const float* tab) {
    constexpr int NR = KV ? 128 : 96, NCH = NR * 32 / NTHREADS;
    int tid_o = F.tid; asm volatile("" : "+v"(tid_o));
    const int tid = tid_o, lane = tid & 63, r32 = lane & 31, hi = lane >> 5, w = F.wave;
    const int pb = bj * 8 + w; const bool active = (pb < MP / 32) && ((pb % (LP / 32)) != (LP / 32) - 1);
    const size_t prow0 = (size_t)(active ? pb : 0) * 32, prow = prow0 + r32; const int b = (int)(prow / LP), pos = (int)(prow % LP);
    bf16_t* P1 = (bf16_t*)(F.ws + WS_P1);
    const bf16_t* W = (const bf16_t*)(F.ws + (KV ? WS_WUKV : WS_WUQ));
    const lds_ptr lds = F.lds;
    const unsigned lds0 = (unsigned)(size_t)F.lds;
    constexpr int NDI = NR / 2 / NWAVES;
#define P2_WDMA(h, buf) do { _Pragma("unroll") for (int i_ = 0; i_ < NDI; ++i_) { const int row_ = 2 * (w * NDI + i_) + (lane >> 5); \
        glds16(W + ((size_t)(h) * NR + row_) * 256 + (((lane & 31) ^ (row_ & 31)) * 8), (unsigned)__builtin_amdgcn_readfirstlane((int)(lds0 + (buf) * 65536 + (w * NDI + i_) * 1024))); } } while (0)
#define P2_WAIT_BAR() asm volatile("s_waitcnt vmcnt(0) lgkmcnt(0)\n\ts_barrier" ::: "memory")
#define P2_AFRAG(buf, t, s) (*(const LAS bf16x8*)(lds + (buf) * 65536 + ((t) * 32 + r32o) * 512 + (((2 * (s) + hio) ^ r32o) * 16)))
    __syncthreads();
    if (KV) { const bf16_t* WKR = (const bf16_t*)(F.ws + WS_WKR);
#pragma unroll
        for (int i = 0; i < 8; ++i) { const int hr = w * 8 + i, row = hr >> 1, slot = (hr & 1) * 64 + lane;
            glds16(WKR + (size_t)row * 1024 + ((slot ^ (row & 31)) * 8), (unsigned)__builtin_amdgcn_readfirstlane((int)(lds0 + 65536 + hr * 1024))); }
    }
    P2_WDMA(0, 0);
    bf16x8 cf[16]; float ss = 0.f;
#pragma unroll
    for (int s = 0; s < 16; ++s) { const u32x4 wv = *(const u32x4*)(P1 + prow * P1W + (KV ? C_CKV : C_CQ) + 16 * s + 8 * hi); ss += ssq8(wv); cf[s] = __builtin_bit_cast(bf16x8, wv); }
    const float rstd_c = 1.0f / sqrtf(xhalf_sum(ss) * (1.0f / 256.0f) + EPS);
    float cs[8], sn[8]; rope_tables(pos, hi, cs, sn);
    f32x16 kr = zero16(); float krss = 0.f;
    if (KV) {
        const bf16_t* WKR = (const bf16_t*)(F.ws + WS_WKR); const bf16_t* XB = (const bf16_t*)(F.ws + WS_XB); const float* RS = (const float*)(F.ws + WS_RSTD1);
        P2_WAIT_BAR();
        const int xrow = pos < NMETA ? XB_META + pos : (pos < LREAL ? b * SEQ + pos - NMETA : XB_ZERO);
        const bf16_t* bp = XB + (size_t)xrow * 1024 + 8 * hi;
#pragma unroll 8
        for (int s = 0; s < 64; ++s) kr = MFMA32(*(const LAS bf16x8*)(lds + 65536 + r32 * 2048 + (((2 * s + hi) ^ r32) * 16)), ld_frag(bp + 16 * s), kr);
        const float rs1 = RS[xrow];
#pragma unroll
        for (int r = 0; r < 16; ++r) { kr[r] *= rs1; krss = __builtin_fmaf(kr[r], kr[r], krss); }
        __syncthreads();
    } else {
        P2_WAIT_BAR();
    }
    bf16_t* QM = (bf16_t*)(F.ws + WS_QM); bf16_t* KM = (bf16_t*)(F.ws + WS_KM); bf16_t* VM = (bf16_t*)(F.ws + WS_VM);
#pragma unroll 1
    for (int h = 0; h < 8; ++h) {
        const int buf = h & 1;
        int r32o = r32, hio = hi; size_t prowo = prow; asm volatile("" : "+v"(r32o), "+v"(hio), "+v"(prowo));
        if (h + 1 < 8) P2_WDMA(h + 1, buf ^ 1);
        if (active) {
            if (!KV) {
                f32x16 acc[3];
#pragma unroll
                for (int t = 0; t < 3; ++t) { acc[t] = zero16();
#pragma unroll
                    for (int s = 0; s < 16; ++s) { acc[t] = MFMA32(P2_AFRAG(buf, t, s), cf[s], acc[t]); if ((s & 3) == 3) __builtin_amdgcn_sched_barrier(0); } }
                float s2 = 0.f;
#pragma unroll
                for (int t = 0; t < 3; ++t)
#pragma unroll
                    for (int r = 0; r < 16; ++r) { acc[t][r] *= rstd_c; s2 = __builtin_fmaf(acc[t][r], acc[t][r], s2); }
                const float rn = 1.0f / sqrtf(xhalf_sum(s2) * (1.0f / 96.0f) + EPS);
#pragma unroll
                for (int t = 0; t < 3; ++t)
#pragma unroll
                    for (int g = 0; g < 4; ++g) { const f32x4 gn = *(LAS const f32x4*)(tab + t * 32 + 8 * g + 4 * hio);
#pragma unroll
                        for (int j = 0; j < 4; ++j) acc[t][4 * g + j] *= rn * gn[j]; }
#pragma unroll
                for (int r = 0; r < 8; ++r) { const float x1 = acc[2][r], x2 = acc[2][r + 8]; acc[2][r] = x1 * cs[r] - x2 * sn[r]; acc[2][r + 8] = x1 * sn[r] + x2 * cs[r]; }
                bf16_t* qp = QM + prowo * 768 + h * 96 + 4 * hio;
#pragma unroll
                for (int t = 0; t < 3; ++t)
#pragma unroll
                    for (int g = 0; g < 4; ++g) store4(qp + t * 32 + 8 * g, acc[t][4 * g] * QS_MLA, acc[t][4 * g + 1] * QS_MLA, acc[t][4 * g + 2] * QS_MLA, acc[t][4 * g + 3] * QS_MLA);
            } else {
                {
                    f32x16 acc[2];
#pragma unroll
                    for (int t = 0; t < 2; ++t) { acc[t] = zero16();
#pragma unroll
                        for (int s = 0; s < 16; ++s) { acc[t] = MFMA32(P2_AFRAG(buf, t, s), cf[s], acc[t]); if ((s & 3) == 3) __builtin_amdgcn_sched_barrier(0); } }
                    float s2 = krss;
#pragma unroll
                    for (int t = 0; t < 2; ++t)
#pragma unroll
                        for (int r = 0; r < 16; ++r) { acc[t][r] *= rstd_c; s2 = __builtin_fmaf(acc[t][r], acc[t][r], s2); }
                    const float rn = 1.0f / sqrtf(xhalf_sum(s2) * (1.0f / 96.0f) + EPS);
                    bf16_t* kp = KM + prowo * 768 + h * 96 + 4 * hio;
#pragma unroll
                    for (int t = 0; t < 2; ++t)
#pragma unroll
                        for (int g = 0; g < 4; ++g) { const f32x4 gn = *(LAS const f32x4*)(tab + 96 + t * 32 + 8 * g + 4 * hio);
                            store4(kp + t * 32 + 8 * g, acc[t][4 * g] * rn * gn[0], acc[t][4 * g + 1] * rn * gn[1], acc[t][4 * g + 2] * rn * gn[2], acc[t][4 * g + 3] * rn * gn[3]); }
                    float kn[16];
#pragma unroll
                    for (int g = 0; g < 4; ++g) { const f32x4 gn = *(LAS const f32x4*)(tab + 96 + 64 + 8 * g + 4 * hio);
#pragma unroll
                        for (int j = 0; j < 4; ++j) kn[4 * g + j] = kr[4 * g + j] * rn * gn[j]; }
#pragma unroll
                    for (int r = 0; r < 8; ++r) { const float x1 = kn[r], x2 = kn[r + 8]; kn[r] = x1 * cs[r] - x2 * sn[r]; kn[r + 8] = x1 * sn[r] + x2 * cs[r]; }
#pragma unroll
                    for (int g = 0; g < 4; ++g) store4(kp + 64 + 8 * g, kn[4 * g], kn[4 * g + 1], kn[4 * g + 2], kn[4 * g + 3]);
                }
                {
                    f32x16 acc[2];
#pragma unroll
                    for (int t = 0; t < 2; ++t) { acc[t] = zero16();
#pragma unroll
                        for (int s = 0; s < 16; ++s) { acc[t] = MFMA32(P2_AFRAG(buf, 2 + t, s), cf[s], acc[t]); if ((s & 3) == 3) __builtin_amdgcn_sched_barrier(0); } }
                    bf16_t* vp = VM + prowo * 512 + h * 64 + 4 * hio;
#pragma unroll
                    for (int t = 0; t < 2; ++t)
#pragma unroll
                        for (int g = 0; g < 4; ++g) store4(vp + t * 32 + 8 * g, acc[t][4 * g] * rstd_c, acc[t][4 * g + 1] * rstd_c, acc[t][4 * g + 2] * rstd_c, acc[t][4 * g + 3] * rstd_c);
                }
            }
        }
        P2_WAIT_BAR();
    }
#undef P2_WDMA
#undef P2_WAIT_BAR
#undef P2_AFRAG
    if (!KV && active) {
        float gq[8], gk[8];
#pragma unroll
        for (int j = 0; j < 8; ++j) { gq[j] = tab[192 + (lane & 7) * 8 + j] * QS_DIFF; gk[j] = tab[256 + (lane & 7) * 8 + j]; }
#pragma unroll 4
        for (int rr = 0; rr < 32; ++rr) {
            bf16_t* qrow = P1 + (prow0 + rr) * P1W + C_DQ + lane * 8; bf16_t* krow = P1 + (prow0 + rr) * P1W + C_DK + lane * 8;
            const u32x4 wq = *(const u32x4*)qrow, wk = *(const u32x4*)krow;
            float sq = ssq8(wq), sk = ssq8(wk);
            sq += __shfl_xor(sq, 1); sk += __shfl_xor(sk, 1); sq += __shfl_xor(sq, 2); sk += __shfl_xor(sk, 2); sq += __shfl_xor(sq, 4); sk += __shfl_xor(sk, 4);
            const float rq = 1.0f / sqrtf(sq * (1.0f / 64.0f) + EPS), rk = 1.0f / sqrtf(sk * (1.0f / 64.0f) + EPS);
            u32x4 oq, ok;
#pragma unroll
            for (int i = 0; i < 4; ++i) { oq[i] = pk2(bf_lo(wq[i]) * rq * gq[2 * i], bf_hi(wq[i]) * rq * gq[2 * i + 1]); ok[i] = pk2(bf_lo(wk[i]) * rk * gk[2 * i], bf_hi(wk[i]) * rk * gk[2 * i + 1]); }
            *(u32x4*)qrow = oq; *(u32x4*)krow = ok;
        }
    }
}

template <bool DIFF, bool FIXED>
__device__ __forceinline__ void attn_unit(Frame& F, int b, int h, int qt, LAS const float* btab, float bref) {
    constexpr int NDS = DIFF ? 4 : 6;
    constexpr int NVB = DIFF ? 4 : 2;
    constexpr int QROWS = DIFF ? 128 : 256;
    constexpr int KCH = DIFF ? 16 : 12;
    constexpr int KBYTES = KCH * 1024, VBYTES = NVB * 4096, TILEB = KBYTES + VBYTES;
    int lane_o = F.lane; asm volatile("" : "+v"(lane_o));
    const int tid = F.tid, lane = lane_o, r32 = lane & 31, hi = lane >> 5, w = F.wave;
    const int map = DIFF ? (w >> 2) : 0, wq = DIFF ? (w & 3) : w;
    const bf16_t* Qg; const bf16_t* Kg; const bf16_t* Vg; int qpitch, kpitch, vpitch;
    if (DIFF) { const bf16_t* P1 = (const bf16_t*)(F.ws + WS_P1); Qg = P1 + C_DQ + h * 128 + map * 64; Kg = P1 + C_DK + h * 128; Vg = P1 + C_DV + h * 128; qpitch = kpitch = vpitch = P1W; }
    else { Qg = (const bf16_t*)(F.ws + WS_QM) + h * 96; Kg = (const bf16_t*)(F.ws + WS_KM) + h * 96; Vg = (const bf16_t*)(F.ws + WS_VM) + h * 64; qpitch = kpitch = 768; vpitch = 512; }
    const size_t brow = (size_t)b * LP;
    const int qpos0 = NMETA + qt * QROWS + wq * 32;
    const int qpos = qpos0 + r32;
    const int NT = (NMETA + qt * QROWS + QROWS + 63) >> 6;
    const int tlast = (qpos0 + 31) >> 6;
    bf16x8 qf[NDS];
#pragma unroll
    for (int d0 = 0; d0 < NDS; ++d0) qf[d0] = ld_frag(Qg + (brow + qpos) * qpitch + 16 * d0 + 8 * hi);
    __builtin_amdgcn_s_waitcnt(0x0F70);
#pragma unroll
    for (int d0 = 0; d0 < NDS; ++d0) asm volatile("" : "+v"(qf[d0]));
    constexpr int NPW = DIFF ? 4 : 3;
    const int kc1 = DIFF ? (w + 8) : (8 + (w & 3));
    const bf16_t* ksrc0 = Kg + (brow + lane) * kpitch + w * 8;
    const bf16_t* ksrc1 = Kg + (brow + lane) * kpitch + kc1 * 8;
    const bf16_t* vsrc0 = Vg + (brow + 16 * (w & 3) + (lane >> 2)) * vpitch + (w >> 2) * 32 + (lane & 3) * 8;
    const bf16_t* vsrc1 = Vg + (brow + 16 * (w & 3) + (lane >> 2)) * vpitch + ((w + 8) >> 2) * 32 + (lane & 3) * 8;
    const lds_ptr lds = F.lds; const unsigned lds0 = (unsigned)(size_t)F.lds;
    const int kdst0 = w * 1024, kdst1 = kc1 * 1024, vdst0 = KBYTES + w * 1024, vdst1 = KBYTES + (w + 8) * 1024;
    const int kbase = (DIFF ? map * 8192 : 0) + hi * 1024 + r32 * 16;
    const int vbase = KBYTES + ((lane >> 4) & 1) * 32 + (lane & 3) * 8 + (4 * hi + ((lane & 15) >> 2)) * 64;
#define ATT_GLDS(src, dst) glds16((src), (unsigned)__builtin_amdgcn_readfirstlane((int)(lds0 + (unsigned)(dst))))
#define ATT_DMA(t, so) do { const size_t to_ = (size_t)(t) * 64; ATT_GLDS(ksrc0 + to_ * kpitch, (so) + kdst0); ATT_GLDS(ksrc1 + to_ * kpitch, (so) + kdst1); \
        ATT_GLDS(vsrc0 + to_ * vpitch, (so) + vdst0); if (DIFF) ATT_GLDS(vsrc1 + to_ * vpitch, (so) + vdst1); } while (0)
#define ATT_WAIT_BAR(n) asm volatile("s_waitcnt vmcnt(" #n ") lgkmcnt(0)\n\ts_barrier" ::: "memory")
    float m_run = FIXED ? bref : 0.f, l_run = 0.f; f32x16 o[NVB];
#pragma unroll
    for (int v = 0; v < NVB; ++v) o[v] = zero16();
    const float bfar = DIFF ? btab[512 + h] : 0.f;
    f32x16 cini;
#pragma unroll
    for (int r = 0; r < 16; ++r) cini[r] = bfar - m_run;
    const bool grpB = (w >= 4);
    __syncthreads();
    ATT_DMA(0, 0); ATT_DMA(1, TILEB);
    if (DIFF) ATT_WAIT_BAR(4); else ATT_WAIT_BAR(3);
    int so_cur = 0, so_nn = 2 * TILEB;
    for (int t = 0; t < NT; ++t) {
        if (t + 2 < NT) ATT_DMA(t + 2, so_nn);
        const bool act = (t <= tlast);
        bf16x8 pa[4]; s16x4 vlo[2][NVB], vhi[2][NVB];
        if (act) {
            const lds_cptr kp = (lds_cptr)lds + so_cur + kbase;
            f32x16 p0, p1;
            bf16x8 kf0[NDS], kf1[NDS];
#pragma unroll
            for (int d0 = 0; d0 < NDS; ++d0) { kf0[d0] = *(const LAS bf16x8*)(kp + d0 * 2048); kf1[d0] = *(const LAS bf16x8*)(kp + d0 * 2048 + 512); }
            __builtin_amdgcn_sched_barrier(0);
            const int kpos0 = 64 * t + 4 * hi;
            if (DIFF && !(qpos0 - (64 * t + 63) >= 113)) {
                LAS const float* bt = btab + h * 128;
#pragma unroll
                for (int r = 0; r < 16; ++r) { const int d0_ = qpos - (kpos0 + (r & 3) + 8 * (r >> 2)); const int d1_ = d0_ - 32;
                    p0[r] = bt[min(max(d0_, 0), 127)] - m_run; p1[r] = bt[min(max(d1_, 0), 127)] - m_run; }
            } else { p0 = cini; p1 = cini; }
#pragma unroll
            for (int d0 = 0; d0 < NDS; ++d0) { p0 = MFMA32(kf0[d0], qf[d0], p0); p1 = MFMA32(kf1[d0], qf[d0], p1); }
            if (64 * t + 63 > qpos0) {
#pragma unroll
                for (int r = 0; r < 16; ++r) { const int kv = kpos0 + (r & 3) + 8 * (r >> 2); if (kv > qpos) p0[r] = -INFINITY; if (kv + 32 > qpos) p1[r] = -INFINITY; }
            }
            if (!FIXED) {
            float mx;
            { float a_ = fmaxf(fmaxf(p0[0], p0[1]), p1[0]), b_ = fmaxf(fmaxf(p0[2], p0[3]), p1[1]); a_ = fmaxf(fmaxf(a_, p1[2]), p1[3]);
#pragma unroll
              for (int r = 4; r < 16; r += 4) { a_ = fmaxf(fmaxf(a_, p0[r]), p0[r + 1]); b_ = fmaxf(fmaxf(b_, p0[r + 2]), p0[r + 3]); a_ = fmaxf(fmaxf(a_, p1[r]), p1[r + 1]); b_ = fmaxf(fmaxf(b_, p1[r + 2]), p1[r + 3]); }
              const float m_ = fmaxf(a_, b_); auto rr = __builtin_amdgcn_permlane32_swap(__float_as_uint(m_), __float_as_uint(m_), false, false);
              mx = fmaxf(__uint_as_float(rr[0]), __uint_as_float(rr[1])); }
            if (t == 0 || __any(mx > SM_THR)) {
                const float dl = (t == 0) ? mx : fmaxf(mx, 0.f); const float al = (t == 0) ? 0.f : __builtin_amdgcn_exp2f(-dl);
                m_run += dl; l_run *= al;
#pragma unroll
                for (int v = 0; v < NVB; ++v)
#pragma unroll
                    for (int r = 0; r < 16; ++r) o[v][r] *= al;
#pragma unroll
                for (int r = 0; r < 16; ++r) { p0[r] -= dl; p1[r] -= dl; cini[r] = bfar - m_run; }
            }
            }
            { const lds_cptr vp = (lds_cptr)lds + so_cur + vbase;
#pragma unroll
              for (int v = 0; v < NVB; ++v) { vlo[0][v] = vtr(vp + v * 4096); vhi[0][v] = vtr(vp + v * 4096 + 512); } }
            __builtin_amdgcn_sched_barrier(0);
            float ls = 0.f;
#pragma unroll
            for (int r = 0; r < 16; ++r) { p0[r] = __builtin_amdgcn_exp2f(p0[r]); p1[r] = __builtin_amdgcn_exp2f(p1[r]); ls += p0[r] + p1[r]; }
            l_run += ls;
            { u32x4 a0, a1, a2, a3;
#pragma unroll
              for (int i = 0; i < 4; ++i) { a0[i] = pk2(p0[2 * i], p0[2 * i + 1]); a1[i] = pk2(p0[8 + 2 * i], p0[9 + 2 * i]); a2[i] = pk2(p1[2 * i], p1[2 * i + 1]); a3[i] = pk2(p1[8 + 2 * i], p1[9 + 2 * i]); }
              pa[0] = __builtin_bit_cast(bf16x8, a0); pa[1] = __builtin_bit_cast(bf16x8, a1); pa[2] = __builtin_bit_cast(bf16x8, a2); pa[3] = __builtin_bit_cast(bf16x8, a3); }
        }
        if (grpB) { if (t + 2 < NT) { if (DIFF) ATT_WAIT_BAR(4); else ATT_WAIT_BAR(3); } else ATT_WAIT_BAR(0); }
        if (act) {
            const lds_cptr vp = (lds_cptr)lds + so_cur + vbase;
#pragma unroll
            for (int s = 0; s < 4; ++s) {
                if (s < 3) {
#pragma unroll
                    for (int v = 0; v < NVB; ++v) { vlo[(s + 1) & 1][v] = vtr(vp + v * 4096 + (s + 1) * 1024); vhi[(s + 1) & 1][v] = vtr(vp + v * 4096 + (s + 1) * 1024 + 512); }
                }
                __builtin_amdgcn_sched_barrier(0);
#pragma unroll
                for (int v = 0; v < NVB; ++v) { const s16x4 lo = vlo[s & 1][v], hi4 = vhi[s & 1][v];
                    const bf16x8 vf = (bf16x8){lo[0], lo[1], lo[2], lo[3], hi4[0], hi4[1], hi4[2], hi4[3]};
                    o[v] = MFMA32(vf, pa[s], o[v]); }
                __builtin_amdgcn_sched_barrier(0);
            }
        }
        if (!grpB) { if (t + 2 < NT) { if (DIFF) ATT_WAIT_BAR(4); else ATT_WAIT_BAR(3); } else ATT_WAIT_BAR(0); }
        so_nn = (so_nn == 3 * TILEB) ? 0 : so_nn + TILEB; so_cur = (so_cur == 3 * TILEB) ? 0 : so_cur + TILEB;
    }
    __syncthreads();
#undef ATT_GLDS
#undef ATT_DMA
#undef ATT_WAIT_BAR
    const float inv = 1.0f / xhalf_sum(l_run);
    const int tok = b * SEQ + (qpos - NMETA);
    bf16_t* Y = (bf16_t*)(F.ws + WS_Y);
    if (!DIFF) {
        bf16_t* yp = Y + (size_t)tok * 1024 + h * 64 + 4 * hi;
#pragma unroll
        for (int v = 0; v < NVB; ++v)
#pragma unroll
            for (int g = 0; g < 4; ++g) { const float z_ = PROBE_ZERO_MLA ? 0.f : inv; store4(yp + v * 32 + 8 * g, o[v][4 * g] * z_, o[v][4 * g + 1] * z_, o[v][4 * g + 2] * z_, o[v][4 * g + 3] * z_); }
    } else {
        LAS float* xch = (LAS float*)lds + (size_t)wq * 4096 + lane;
        if (map == 1) {
#pragma unroll
            for (int v = 0; v < NVB; ++v)
#pragma unroll
                for (int r = 0; r < 16; ++r) xch[(v * 16 + r) * 64] = o[v][r] * inv;
        }
        __syncthreads();
        if (map == 0) {
            const float lam = btab[516]; float s2 = 0.f;
#pragma unroll
            for (int v = 0; v < NVB; ++v)
#pragma unroll
                for (int r = 0; r < 16; ++r) { const float d = o[v][r] * inv - lam * xch[(v * 16 + r) * 64]; o[v][r] = d; s2 += d * d; }
            const float rn = (1.0f - LAMBDA_INIT) / sqrtf(xhalf_sum(s2) * (1.0f / 128.0f) + EPS);
            bf16_t* yp = Y + (size_t)tok * 1024 + 512 + h * 128 + 4 * hi;
#pragma unroll
            for (int v = 0; v < NVB; ++v)
#pragma unroll
                for (int g = 0; g < 4; ++g) { const f32x4 gn = *(LAS const f32x4*)(btab + 520 + v * 32 + 8 * g + 4 * hi);
                    store4(yp + v * 32 + 8 * g, o[v][4 * g] * rn * gn[0], o[v][4 * g + 1] * rn * gn[1], o[v][4 * g + 2] * rn * gn[2], o[v][4 * g + 3] * rn * gn[3]); }
        }
    }
}

__device__ __forceinline__ void attn_unit_mla2(Frame& F, int b, int h, int qt, float bref) {
    constexpr int NDS = 6, NVB = 2, QROWS = 512, KBYTES = 12 * 1024, VBYTES = NVB * 4096, TILEB = KBYTES + VBYTES;
    int lane_o = F.lane; asm volatile("" : "+v"(lane_o));
    const int lane = lane_o, r32 = lane & 31, hi = lane >> 5, w = F.wave;
    const bf16_t* Qg = (const bf16_t*)(F.ws + WS_QM) + h * 96; const bf16_t* Kg = (const bf16_t*)(F.ws + WS_KM) + h * 96; const bf16_t* Vg = (const bf16_t*)(F.ws + WS_VM) + h * 64;
    constexpr int qpitch = 768, kpitch = 768, vpitch = 512;
    const size_t brow = (size_t)b * LP;
    const int qposA0 = NMETA + qt * QROWS + w * 64, qposB0 = qposA0 + 32, qposA = qposA0 + r32, qposB = qposB0 + r32;
    const int NT = (NMETA + qt * QROWS + QROWS + 63) >> 6, tlast = (qposB0 + 31) >> 6;
    bf16x8 qa[NDS], qb[NDS];
#pragma unroll
    for (int d0 = 0; d0 < NDS; ++d0) { qa[d0] = ld_frag(Qg + (brow + qposA) * qpitch + 16 * d0 + 8 * hi); qb[d0] = ld_frag(Qg + (brow + qposB) * qpitch + 16 * d0 + 8 * hi); }
    __builtin_amdgcn_s_waitcnt(0x0F70);
#pragma unroll
    for (int d0 = 0; d0 < NDS; ++d0) asm volatile("" : "+v"(qa[d0]), "+v"(qb[d0]));
    const int kc1 = 8 + (w & 3);
    const bf16_t* ksrc0 = Kg + (brow + lane) * kpitch + w * 8;
    const bf16_t* ksrc1 = Kg + (brow + lane) * kpitch + kc1 * 8;
    const bf16_t* vsrc0 = Vg + (brow + 16 * (w & 3) + (lane >> 2)) * vpitch + (w >> 2) * 32 + (lane & 3) * 8;
    const lds_ptr lds = F.lds; const unsigned lds0 = (unsigned)(size_t)F.lds;
    const int kdst0 = w * 1024, kdst1 = kc1 * 1024, vdst0 = KBYTES + w * 1024;
    const int kbase = hi * 1024 + r32 * 16;
    const int vbase = KBYTES + ((lane >> 4) & 1) * 32 + (lane & 3) * 8 + (4 * hi + ((lane & 15) >> 2)) * 64;
#define AM2_GLDS(src, dst) glds16((src), (unsigned)__builtin_amdgcn_readfirstlane((int)(lds0 + (unsigned)(dst))))
#define AM2_DMA(t, so) do { const size_t to_ = (size_t)(t) * 64; AM2_GLDS(ksrc0 + to_ * kpitch, (so) + kdst0); AM2_GLDS(ksrc1 + to_ * kpitch, (so) + kdst1); AM2_GLDS(vsrc0 + to_ * vpitch, (so) + vdst0); } while (0)
#define AM2_WAIT_BAR(n) asm volatile("s_waitcnt vmcnt(" #n ") lgkmcnt(0)\n\ts_barrier" ::: "memory")
    float la = 0.f, lb = 0.f; f32x16 oa[NVB], ob[NVB];
#pragma unroll
    for (int v = 0; v < NVB; ++v) { oa[v] = zero16(); ob[v] = zero16(); }
    (void)bref;
    const bool grpB = (w >= 4);
    __syncthreads();
    AM2_DMA(0, 0); AM2_DMA(1, TILEB);
    AM2_WAIT_BAR(3);
    int so_cur = 0, so_nn = 2 * TILEB;
    for (int t = 0; t < NT; ++t) {
        if (t + 2 < NT) AM2_DMA(t + 2, so_nn);
        const bool act = (t <= tlast);
        bf16x8 pa[4], pb[4];
        if (act) {
            const lds_cptr kp = (lds_cptr)lds + so_cur + kbase;
            f32x16 a0 = zero16(), a1 = zero16(), b0 = zero16(), b1 = zero16();
#pragma unroll
            for (int d0 = 0; d0 < NDS; ++d0) { const bf16x8 k0 = *(const LAS bf16x8*)(kp + d0 * 2048), k1 = *(const LAS bf16x8*)(kp + d0 * 2048 + 512);
                a0 = MFMA32(k0, qa[d0], a0); b0 = MFMA32(k0, qb[d0], b0); a1 = MFMA32(k1, qa[d0], a1); b1 = MFMA32(k1, qb[d0], b1);
                if (d0 & 1) __builtin_amdgcn_sched_barrier(0); }
            if (64 * t + 63 > qposA0) {
                const int kpos0 = 64 * t + 4 * hi;
#pragma unroll
                for (int r = 0; r < 16; ++r) { const int kv = kpos0 + (r & 3) + 8 * (r >> 2);
                    if (kv > qposA) a0[r] = -INFINITY; if (kv + 32 > qposA) a1[r] = -INFINITY; if (kv > qposB) b0[r] = -INFINITY; if (kv + 32 > qposB) b1[r] = -INFINITY; }
            }
            { float ls = 0.f;
#pragma unroll
              for (int r = 0; r < 16; ++r) { a0[r] = __builtin_amdgcn_exp2f(a0[r]); a1[r] = __builtin_amdgcn_exp2f(a1[r]); ls += a0[r] + a1[r]; }
              la += ls; u32x4 x0, x1, x2, x3;
#pragma unroll
              for (int i = 0; i < 4; ++i) { x0[i] = pk2(a0[2 * i], a0[2 * i + 1]); x1[i] = pk2(a0[8 + 2 * i], a0[9 + 2 * i]); x2[i] = pk2(a1[2 * i], a1[2 * i + 1]); x3[i] = pk2(a1[8 + 2 * i], a1[9 + 2 * i]); }
              pa[0] = __builtin_bit_cast(bf16x8, x0); pa[1] = __builtin_bit_cast(bf16x8, x1); pa[2] = __builtin_bit_cast(bf16x8, x2); pa[3] = __builtin_bit_cast(bf16x8, x3); }
            __builtin_amdgcn_sched_barrier(0);
            { float ls = 0.f;
#pragma unroll
              for (int r = 0; r < 16; ++r) { b0[r] = __builtin_amdgcn_exp2f(b0[r]); b1[r] = __builtin_amdgcn_exp2f(b1[r]); ls += b0[r] + b1[r]; }
              lb += ls; u32x4 x0, x1, x2, x3;
#pragma unroll
              for (int i = 0; i < 4; ++i) { x0[i] = pk2(b0[2 * i], b0[2 * i + 1]); x1[i] = pk2(b0[8 + 2 * i], b0[9 + 2 * i]); x2[i] = pk2(b1[2 * i], b1[2 * i + 1]); x3[i] = pk2(b1[8 + 2 * i], b1[9 + 2 * i]); }
              pb[0] = __builtin_bit_cast(bf16x8, x0); pb[1] = __builtin_bit_cast(bf16x8, x1); pb[2] = __builtin_bit_cast(bf16x8, x2); pb[3] = __builtin_bit_cast(bf16x8, x3); }
        }
        if (grpB) { if (t + 2 < NT) AM2_WAIT_BAR(3); else AM2_WAIT_BAR(0); }
        if (act) {
            const lds_cptr vp = (lds_cptr)lds + so_cur + vbase;
#pragma unroll
            for (int ks = 0; ks < 4; ++ks)
#pragma unroll
                for (int v = 0; v < NVB; ++v) { const s16x4 lo = vtr(vp + v * 4096 + ks * 1024), hi4 = vtr(vp + v * 4096 + ks * 1024 + 512);
                    const bf16x8 vf = (bf16x8){lo[0], lo[1], lo[2], lo[3], hi4[0], hi4[1], hi4[2], hi4[3]};
                    oa[v] = MFMA32(vf, pa[ks], oa[v]); ob[v] = MFMA32(vf, pb[ks], ob[v]); }
        }
        if (!grpB) { if (t + 2 < NT) AM2_WAIT_BAR(3); else AM2_WAIT_BAR(0); }
        so_nn = (so_nn == 3 * TILEB) ? 0 : so_nn + TILEB; so_cur = (so_cur == 3 * TILEB) ? 0 : so_cur + TILEB;
    }
    __syncthreads();
#undef AM2_GLDS
#undef AM2_DMA
#undef AM2_WAIT_BAR
    const float inva = 1.0f / xhalf_sum(la), invb = 1.0f / xhalf_sum(lb);
    bf16_t* Y = (bf16_t*)(F.ws + WS_Y);
    bf16_t* ya = Y + (size_t)(b * SEQ + (qposA - NMETA)) * 1024 + h * 64 + 4 * hi; bf16_t* yb = Y + (size_t)(b * SEQ + (qposB - NMETA)) * 1024 + h * 64 + 4 * hi;
#pragma unroll
    for (int v = 0; v < NVB; ++v)
#pragma unroll
        for (int g = 0; g < 4; ++g) { store4(ya + v * 32 + 8 * g, oa[v][4 * g] * inva, oa[v][4 * g + 1] * inva, oa[v][4 * g + 2] * inva, oa[v][4 * g + 3] * inva);
                                      store4(yb + v * 32 + 8 * g, ob[v][4 * g] * invb, ob[v][4 * g + 1] * invb, ob[v][4 * g + 2] * invb, ob[v][4 * g + 3] * invb); }
}

__device__ __forceinline__ int f2key(float f) { const int b = __float_as_int(f); return b ^ ((b >> 31) & 0x7fffffff); }
__device__ __forceinline__ float key2f(int k) { return __int_as_float(k ^ ((k >> 31) & 0x7fffffff)); }
#define TOPK_INS(top, x) do { int x_ = (x); _Pragma("unroll") for (int i_ = 0; i_ < 16; ++i_) { const int hi_ = max(top[i_], x_); x_ = min(top[i_], x_); top[i_] = hi_; } } while (0)
#define CE_DESC(a, b) do { const int hi_ = max((a), (b)); const int lo_ = min((a), (b)); (a) = hi_; (b) = lo_; } while (0)
__device__ __forceinline__ void sort16_desc(int (&x)[16]) {
#pragma unroll
    for (int k = 2; k <= 16; k <<= 1)
#pragma unroll
        for (int j = k >> 1; j > 0; j >>= 1)
#pragma unroll
            for (int i = 0; i < 16; ++i) { const int l = i ^ j; if (l > i) { if ((i & k) == 0) CE_DESC(x[i], x[l]); else CE_DESC(x[l], x[i]); } }
}
__device__ __forceinline__ void merge16_desc(int (&top)[16], const int (&x)[16]) {
#pragma unroll
    for (int i = 0; i < 16; ++i) top[i] = max(top[i], x[15 - i]);
#pragma unroll
    for (int j = 8; j > 0; j >>= 1)
#pragma unroll
        for (int i = 0; i < 16; ++i) { const int l = i ^ j; if (l > i) CE_DESC(top[i], top[l]); }
}
__device__ __forceinline__ void p7_job(Frame& F, int tb, int h) {
    const int lane = F.lane, r32 = lane & 31, hi = lane >> 5;
    const bf16_t* QP = (const bf16_t*)(F.ws + WS_QP);
    const int tok = tb * 32 + r32;
    int s1[16], s2[16];
#pragma unroll 1
    for (int p = 0; p < 2; ++p) {
        bf16x8 qf[8];
#pragma unroll
        for (int s = 0; s < 8; ++s) qf[s] = ld_frag(QP + (size_t)tok * 2048 + h * 256 + p * 128 + 16 * s + 8 * hi);
        int top[16];
#pragma unroll
        for (int i = 0; i < 16; ++i) top[i] = (int)0x80000000;
#pragma unroll 1
        for (int kt = 0; kt < 4; ++kt) {
            f32x16 sc = zero16(); const lds_cptr ap = (lds_cptr)F.lds + (p * 128 + kt * 32 + r32) * 256;
#pragma unroll
            for (int s = 0; s < 8; ++s) sc = MFMA32(*(const LAS bf16x8*)(ap + (((2 * s + hi) ^ (r32 & 15)) * 16)), qf[s], sc);
            int x[16];
#pragma unroll
            for (int r = 0; r < 16; ++r) x[r] = (f2key(sc[r]) & ~127) | (kt * 32 + (r & 3) + 8 * (r >> 2) + 4 * hi);
            sort16_desc(x); merge16_desc(top, x);
        }
        int oth[16];
#pragma unroll
        for (int i = 0; i < 16; ++i) oth[i] = __shfl_xor(top[i], 32);
        merge16_desc(top, oth);
#pragma unroll
        for (int i = 0; i < 16; ++i) { if (p == 0) s1[i] = top[i]; else s2[i] = top[i]; }
    }
    float a1[16], a2[16];
#pragma unroll
    for (int i = 0; i < 16; ++i) { a1[i] = key2f(s1[i] & ~127); a2[i] = key2f(s2[i] & ~127); }
#define CAND(i, j) ((f2key(a1[i] + a2[j]) & ~255) | ((i) << 4) | (j))
    int best[16], ca[16], cb[16];
#pragma unroll
    for (int j = 0; j < 16; ++j) best[j] = CAND(0, j);
    ca[0] = CAND(1, 0); ca[1] = CAND(1, 1); ca[2] = CAND(1, 2); ca[3] = CAND(1, 3); ca[4] = CAND(1, 4); ca[5] = CAND(1, 5); ca[6] = CAND(1, 6); ca[7] = CAND(1, 7);
    ca[8] = CAND(2, 0); ca[9] = CAND(2, 1); ca[10] = CAND(2, 2); ca[11] = CAND(2, 3); ca[12] = CAND(2, 4); ca[13] = CAND(3, 0); ca[14] = CAND(3, 1); ca[15] = CAND(3, 2);
    cb[0] = CAND(3, 3); cb[1] = CAND(4, 0); cb[2] = CAND(4, 1); cb[3] = CAND(4, 2); cb[4] = CAND(5, 0); cb[5] = CAND(5, 1); cb[6] = CAND(6, 0); cb[7] = CAND(6, 1);
    cb[8] = CAND(7, 0); cb[9] = CAND(7, 1); cb[10] = CAND(8, 0); cb[11] = CAND(9, 0); cb[12] = CAND(10, 0); cb[13] = CAND(11, 0); cb[14] = CAND(12, 0); cb[15] = CAND(13, 0);
    sort16_desc(ca); merge16_desc(best, ca); sort16_desc(cb); merge16_desc(best, cb);
    TOPK_INS(best, CAND(14, 0)); TOPK_INS(best, CAND(15, 0));
#undef CAND
    LAS int* st = (LAS int*)(F.lds + 65536 + F.wave * 8192) + lane;
#pragma unroll
    for (int i = 0; i < 16; ++i) { st[i * 64] = s1[i] & 127; st[(16 + i) * 64] = s2[i] & 127; }
    float bv[8]; int ex[8];
#pragma unroll
    for (int k = 0; k < 8; ++k) { const int bk = hi ? best[8 + k] : best[k]; const int ci = (bk >> 4) & 15, cj = bk & 15;
        ex[k] = st[ci * 64] * 128 + st[(16 + cj) * 64]; bv[k] = key2f(bk & ~255); }
    float rs2;
    { const f32x4* sp = (const f32x4*)((const float*)(F.ws + WS_SSQP) + (size_t)tok * 16); const f32x4 a = sp[0], b = sp[1], c = sp[2], d = sp[3];
      const float ssq = ((a[0] + a[1]) + (a[2] + a[3])) + ((b[0] + b[1]) + (b[2] + b[3])) + ((c[0] + c[1]) + (c[2] + c[3])) + ((d[0] + d[1]) + (d[2] + d[3])); rs2 = 1.0f / sqrtf(ssq * (1.0f / 1024.0f) + EPS); }
    const float bmax = key2f(best[0] & ~255); float sum = 0.f;
#pragma unroll
    for (int k = 0; k < 8; ++k) { bv[k] = __expf((bv[k] - bmax) * rs2); sum += bv[k]; }
    sum += __shfl_xor(sum, 32);
    const float inv = 1.0f / sum;
    int* EI = (int*)(F.ws + WS_EI); float* EG = (float*)(F.ws + WS_EG);
    u32x4 i0, i1; f32x4 g0, g1;
#pragma unroll
    for (int k = 0; k < 4; ++k) { i0[k] = (unsigned)ex[k]; i1[k] = (unsigned)ex[4 + k]; g0[k] = bv[k] * inv; g1[k] = bv[4 + k] * inv; }
    int* ip = EI + (size_t)tok * 128 + h * 16 + hi * 8; float* gp = EG + (size_t)tok * 128 + h * 16 + hi * 8;
    *(u32x4*)ip = i0; *(u32x4*)(ip + 4) = i1; *(f32x4*)gp = g0; *(f32x4*)(gp + 4) = g1;
}

__device__ __forceinline__ float gelu_exact(float v) {
    const float av = fabsf(v), t = __builtin_amdgcn_rcpf(av * 0.2316418882f + 1.0f);
    float q = t * 0.5307027145f + (-0.7265760135f); q = q * t + 0.7107068705f; q = q * t + (-0.142248368f); q = q * t + 0.127414796f; q = q * t;
    const float e = __builtin_amdgcn_exp2f((v * v) * (-0.72134752044f));
    const float m = v * (q * e);
    return v < 0.f ? m : v - m;
}
__device__ __forceinline__ int wave_sum_i(int v) {
#pragma unroll
    for (int o = 1; o < 64; o <<= 1) v += __shfl_xor(v, o);
    return v;
}
constexpr int P8_SYNC_MASK = 15;
constexpr int P8_LOG_NSL = 4, P8_NSL = 1 << P8_LOG_NSL;
constexpr int P8_TS = 8, P8_NSW = (16 + P8_TS - 1) / P8_TS;
constexpr int P8_WLDS = P8_TS * 2048;
__device__ __forceinline__ int dpp_xor1(int v) { return __builtin_amdgcn_update_dpp(0, v, 0xB1, 0xF, 0xF, false); }
__device__ __forceinline__ int dpp_xor2(int v) { return __builtin_amdgcn_update_dpp(0, v, 0x4E, 0xF, 0xF, false); }
__device__ __forceinline__ int dpp_hmir(int v) { return __builtin_amdgcn_update_dpp(0, v, 0x141, 0xF, 0xF, false); }
template <class BarT> __device__ __forceinline__ void p8_block16(Frame& F, int tb, int sw, const BarT& bar, int sync_mask, const float* FN) {
    const int lane = F.lane, g = lane >> 3, i8 = lane & 7;
    const unsigned char* U8 = F.ws + WS_U8; const unsigned char* V8 = F.ws + WS_V8;
    const int* EI = (const int*)(F.ws + WS_EI); const float* EG = (const float*)(F.ws + WS_EG);
    const float* SU = (const float*)(F.ws + WS_SU); const float* SV = (const float*)(F.ws + WS_SV);
    const lds_ptr wl = F.lds + F.wave * P8_WLDS;
    LAS unsigned short* ids = (LAS unsigned short*)wl; LAS float* gts = (LAS float*)(wl + P8_TS * 256); LAS unsigned short* ofs = (LAS unsigned short*)(wl + P8_TS * 768);
    const lds_ptr nql = wl + P8_TS * 1024;
    const int ntk = min(P8_TS, 16 - sw * P8_TS);
    const unsigned long long ltmask = (1ull << lane) - 1ull;
    {
        const int tok0 = tb * 16 + sw * P8_TS;
#pragma unroll
        for (int ti = 0; ti < P8_TS; ++ti) if (ti < ntk) {
            const int tok = tok0 + ti;
            {
              const u32x4* hr = (const u32x4*)((const bf16_t*)(F.ws + WS_H2B) + (size_t)tok * 1024 + lane * 16); const u32x4 hA = hr[0], hB = hr[1]; f32x4 y[4];
              const f32x4* sp = (const f32x4*)((const float*)(F.ws + WS_SSQP) + (size_t)tok * 16); const f32x4 pa_ = sp[0], pb_ = sp[1], pc_ = sp[2], pd_ = sp[3];
              const float ssq = ((pa_[0] + pa_[1]) + (pa_[2] + pa_[3])) + ((pb_[0] + pb_[1]) + (pb_[2] + pb_[3])) + ((pc_[0] + pc_[1]) + (pc_[2] + pc_[3])) + ((pd_[0] + pd_[1]) + (pd_[2] + pd_[3]));
              const float rs2 = 1.0f / sqrtf(ssq * (1.0f / 1024.0f) + EPS); float am = 0.f;
#pragma unroll
              for (int i = 0; i < 4; ++i) { const unsigned w0 = (i < 2 ? hA : hB)[2 * (i & 1)], w1 = (i < 2 ? hA : hB)[2 * (i & 1) + 1];
                  const f32x4 hv = {__uint_as_float(w0 << 16), __uint_as_float(w0 & 0xffff0000u), __uint_as_float(w1 << 16), __uint_as_float(w1 & 0xffff0000u)};
                  y[i] = hv * rs2 * *(const f32x4*)(FN + lane * 16 + 4 * i);
                  am = fmaxf(fmaxf(am, fmaxf(fabsf(y[i][0]), fabsf(y[i][1]))), fmaxf(fabsf(y[i][2]), fabsf(y[i][3]))); }
#pragma unroll
              for (int o = 1; o < 64; o <<= 1) am = fmaxf(am, __shfl_xor(am, o));
              const float inv = am > 0.f ? 127.0f / am : 0.f; u32x4 qv;
#pragma unroll
              for (int i = 0; i < 4; ++i) { unsigned wv = 0u;
#pragma unroll
                  for (int k = 0; k < 4; ++k) wv |= ((unsigned)(int)__builtin_rintf(y[i][k] * inv) & 255u) << (8 * k);
                  qv[i] = wv; }
              *(LAS u32x4*)(nql + ti * 1024 + lane * 16) = qv; if (lane == 0) *(LAS float*)(wl + P8_TS * 896 + ti * 4) = am * (1.0f / 127.0f); }
            const int e0 = EI[(size_t)tok * 128 + lane], e1 = EI[(size_t)tok * 128 + 64 + lane];
            const float g0 = EG[(size_t)tok * 128 + lane], g1 = EG[(size_t)tok * 128 + 64 + lane];
            const int s0 = e0 >> (14 - P8_LOG_NSL), s1 = e1 >> (14 - P8_LOG_NSL);
            int run = 0, pos0 = 0, pos1 = 0, myoff = 0;
#pragma unroll 1
            for (int sl = 0; sl < P8_NSL; ++sl) {
                const unsigned long long m0 = __ballot(s0 == sl), m1 = __ballot(s1 == sl);
                const int c0 = __popcll(m0), c1 = __popcll(m1);
                if (s0 == sl) pos0 = run + __popcll(m0 & ltmask);
                if (s1 == sl) pos1 = run + c0 + __popcll(m1 & ltmask);
                if (lane == sl) myoff = run;
                run += c0 + c1;
            }
            if (lane == P8_NSL) myoff = 128;
            ids[ti * 128 + pos0] = (unsigned short)e0; ids[ti * 128 + pos1] = (unsigned short)e1; gts[ti * 128 + pos0] = g0; gts[ti * 128 + pos1] = g1;
            if (lane <= P8_NSL) ofs[ti * 64 + lane] = (unsigned short)myoff;
        }
        f32x2 acc[P8_TS][8];
#pragma unroll
        for (int ti = 0; ti < P8_TS; ++ti)
#pragma unroll
            for (int i = 0; i < 8; ++i) acc[ti][i] = (f32x2){0.f, 0.f};
#pragma unroll 1
        for (int sl = 0; sl < P8_NSL; ++sl) {
            if (sl && (sl & sync_mask) == 0) xcd_barrier(bar);
#pragma unroll
            for (int ti = 0; ti < P8_TS; ++ti) if (ti < ntk) {
                const int lo = __builtin_amdgcn_readfirstlane((int)ofs[ti * 64 + sl]), hi = __builtin_amdgcn_readfirstlane((int)ofs[ti * 64 + sl + 1]);
#pragma unroll 1
                for (int c0 = lo; c0 < hi; c0 += 8) {
                    const int n = min(8, hi - c0);
                    const int idx = ti * 128 + c0 + min(g, n - 1);
                    const int id = ids[idx]; const float gate = (g < n) ? gts[idx] : 0.f;
                    const float su = SU[id], sv = SV[id];
                    const unsigned char* up = U8 + (size_t)id * 1024 + i8 * 16;
                    u32x4 ur[8], vr[8];
#pragma unroll
                    for (int j = 0; j < 8; ++j) ur[j] = *(const u32x4*)(up + 128 * j);
#pragma unroll
                    for (int k = 0; k < 8; ++k) if (k < n) { const int e = __builtin_amdgcn_readlane(id, 8 * k); vr[k] = *(const u32x4*)(V8 + (size_t)e * 1024 + lane * 16); }
#if PROBE_P8 == 1
                    { u32x4 du[8], dv[8]; const unsigned char* up2 = U8 + (size_t)(id ^ 1) * 1024 + i8 * 16;
#pragma unroll
                      for (int j = 0; j < 8; ++j) du[j] = *(const u32x4*)(up2 + 128 * j);
#pragma unroll
                      for (int k = 0; k < 8; ++k) if (k < n) { const int e = __builtin_amdgcn_readlane(id, 8 * k) ^ 1; dv[k] = *(const u32x4*)(V8 + (size_t)e * 1024 + lane * 16); }
#pragma unroll
                      for (int j = 0; j < 8; ++j) asm volatile("" :: "v"(du[j]));
#pragma unroll
                      for (int k = 0; k < 8; ++k) if (k < n) asm volatile("" :: "v"(dv[k])); }
#endif
                    int d = 0; unsigned nqo = (unsigned)(ti * 1024 + i8 * 16); asm volatile("" : "+v"(nqo));
#pragma unroll
                    for (int j = 0; j < 8; ++j) { const u32x4 q = *(const LAS u32x4*)(nql + nqo + 128 * j);
#pragma unroll
                        for (int i = 0; i < 4; ++i) d = __builtin_amdgcn_sdot4((int)ur[j][i], (int)q[i], d, false); }
                    d += dpp_xor1(d); d += dpp_xor2(d); d += dpp_hmir(d);
                    const float coef = gate * gelu_exact((float)d * (*(const LAS float*)(wl + P8_TS * 896 + (nqo & 0x1c00u) / 256u) * su)) * sv;
#pragma unroll
                    for (int k = 0; k < 8; ++k) if (k < n) { const float c = __builtin_bit_cast(float, __builtin_amdgcn_readlane(__builtin_bit_cast(int, coef), 8 * k)); const f32x2 c2 = {c, c};
#pragma unroll
                        for (int i = 0; i < 4; ++i) { const f32x2 lo = __builtin_amdgcn_cvt_pk_f32_fp8((int)vr[k][i], false), hi2 = __builtin_amdgcn_cvt_pk_f32_fp8((int)vr[k][i], true);
                            acc[ti][2 * i] = c2 * lo + acc[ti][2 * i]; acc[ti][2 * i + 1] = c2 * hi2 + acc[ti][2 * i + 1]; } }
#if PROBE_P8 == 2
                    { f32x2 dacc[8];
#pragma unroll
                      for (int i = 0; i < 8; ++i) dacc[i] = (f32x2){0.f, 0.f};
#pragma unroll
                      for (int k = 0; k < 8; ++k) if (k < n) { const float c = __builtin_bit_cast(float, __builtin_amdgcn_readlane(__builtin_bit_cast(int, coef), 8 * k)) + 1.0f; const f32x2 c2 = {c, c};
#pragma unroll
                        for (int i = 0; i < 4; ++i) { const f32x2 lo = __builtin_amdgcn_cvt_pk_f32_fp8((int)(vr[k][i] ^ 0x01010101u), false), hi2 = __builtin_amdgcn_cvt_pk_f32_fp8((int)(vr[k][i] ^ 0x01010101u), true);
                            dacc[2 * i] = c2 * lo + dacc[2 * i]; dacc[2 * i + 1] = c2 * hi2 + dacc[2 * i + 1]; } }
#pragma unroll
                      for (int i = 0; i < 8; ++i) asm volatile("" :: "v"(dacc[i])); }
#endif
                }
            }
        }
#pragma unroll
        for (int ti = 0; ti < P8_TS; ++ti) if (ti < ntk) {
            int lane_f = lane; asm volatile("" : "+v"(lane_f));
            float* op = F.out + (size_t)(tok0 + ti) * 1024 + lane_f * 16;
            const u32x2* hr = (const u32x2*)((const bf16_t*)(F.ws + WS_H2B) + (size_t)(tok0 + ti) * 1024 + lane_f * 16);
#pragma unroll
            for (int i = 0; i < 4; ++i) { const u32x2 hw = hr[i]; const unsigned w0 = hw.x, w1 = hw.y;
                f32x4 hv = {__uint_as_float(w0 << 16), __uint_as_float(w0 & 0xffff0000u), __uint_as_float(w1 << 16), __uint_as_float(w1 & 0xffff0000u)};
                hv += (f32x4){acc[ti][2 * i][0], acc[ti][2 * i][1], acc[ti][2 * i + 1][0], acc[ti][2 * i + 1][1]}; *(f32x4*)(op + 4 * i) = hv; }
        }
    }
}

constexpr int N_PHASES = 8;
__global__ void __launch_bounds__(NTHREADS, 2) mega_fwd(Args args) {
    extern __shared__ __attribute__((aligned(16))) unsigned char lds_raw[];
    Frame F;
    F.lds = (lds_ptr)lds_raw; F.tid = threadIdx.x; F.lane = F.tid & 63; F.wave = __builtin_amdgcn_readfirstlane(F.tid >> 6);
    F.G = gridDim.x; F.gw = blockIdx.x * NWAVES + F.wave; F.ngw = F.G * NWAVES;
    F.out = args.out; F.ws = args.ws;
    volatile LAS unsigned* MISC = (volatile LAS unsigned*)(F.lds + MISC_OFF);
    LAS float* tab = (LAS float*)(F.lds + TAB_OFF);
    if (F.tid < 64) MISC[F.tid] = 0u;
    __syncthreads();
    const int lo = args.ph_lo, hi = args.ph_hi;
    XcdBarrier bar; bar.bar = (unsigned*)(F.ws + WS_CTL) + CW_BAR; bar.x = 0; bar.st = nullptr;
    if (hi - lo > 1) bar = xcd_barrier_post((unsigned*)(F.ws + WS_CTL) + CW_BAR, MISC + 8);
#ifndef PHASE_MASK
#define PHASE_MASK 0x0ff
#endif
#define IN(k) (((PHASE_MASK >> (k)) & 1) && lo <= (k) && (k) < hi)
#define SEAM(k) do { if (IN(k) && IN((k) + 1)) xcd_barrier(bar); } while (0)
#define REPS(k) ((((REPEAT_MASK) >> (k)) & 1) ? 2 : 1)
#define PHASE(k) if (IN(k)) _Pragma("unroll") for (int rep_ = 0; rep_ < REPS(k); ++rep_)
#define REP_BAR() do { if (rep_) xcd_barrier(bar); } while (0)

    PHASE(0) { REP_BAR(); p0_prologue(F, args); }
    SEAM(0);
    PHASE(1) { REP_BAR();
        if (F.wave == 0 && blockIdx.x < 64) p1_meta_tile(F, blockIdx.x);
        __syncthreads();
        pg8::Gemm g{(const bf16_t*)(F.ws + WS_XB), (const bf16_t*)(F.ws + WS_W1T), MTOK, 2048, 1024}; pg8::StaticOrder S; S.init(MTOK, 2048, F.G, (int)blockIdx.x);
        EpiP1 E{(bf16_t*)(F.ws + WS_P1), (const float*)(F.ws + WS_RSTD1)};
        pg8::gemm_phase<EpiP1, pg8::StaticOrder, true, true>(F.lds, g, S, E);
    }
    SEAM(1);
    if (IN(2)) {
        for (int i = F.tid; i < 320; i += NTHREADS) tab[i] = i < 96 ? args.in[I_QKNQ][i] : (i < 192 ? args.in[I_QKNK][i - 96] : (i < 256 ? args.in[I_DQN][i - 192] : args.in[I_DKN][i - 256]));
        __syncthreads();
        constexpr int NPB = MP / 32;
        constexpr int NBJ = (NPB + 7) / 8;
        for (int j = blockIdx.x; j < 2 * NBJ; j += F.G) { if (j < NBJ) { if (P2ON & 1) p2_block<false>(F, j, tab); } else { if (P2ON & 2) p2_block<true>(F, j - NBJ, tab); } }
    }
    SEAM(2);
    PHASE(3) { REP_BAR();
        for (int i = F.tid; i < 512; i += NTHREADS) { const int hh = i >> 7, n = i & 127; tab[i] = args.in[I_RELB][T5_BUCKET[n] * 4 + hh] * LOG2E; }
        if (F.tid < 4) tab[512 + F.tid] = args.in[I_RELB][31 * 4 + F.tid] * LOG2E;
        if (F.tid >= 64 && F.tid < 192) tab[520 + F.tid - 64] = args.in[I_SUBLN][F.tid - 64];
        if (F.wave == 4) { const float a = wave_sum(args.in[I_LQ1][F.lane] * args.in[I_LK1][F.lane]), c = wave_sum(args.in[I_LQ2][F.lane] * args.in[I_LK2][F.lane]);
            if (F.lane == 0) tab[516] = expf(a) - expf(c) + LAMBDA_INIT; }
        if (F.wave == 5) {
            const int l = F.lane;
            float gq = fmaxf(fabsf(args.in[I_QKNQ][l]), l < 32 ? fabsf(args.in[I_QKNQ][64 + l]) : 0.f), gk = fmaxf(fabsf(args.in[I_QKNK][l]), l < 32 ? fabsf(args.in[I_QKNK][64 + l]) : 0.f);
            float dq = fabsf(args.in[I_DQN][l]), dk = fabsf(args.in[I_DKN][l]), rb = fmaxf(fabsf(args.in[I_RELB][l]), fabsf(args.in[I_RELB][64 + l]));
#pragma unroll
            for (int o = 1; o < 64; o <<= 1) { gq = fmaxf(gq, __shfl_xor(gq, o)); gk = fmaxf(gk, __shfl_xor(gk, o)); dq = fmaxf(dq, __shfl_xor(dq, o)); dk = fmaxf(dk, __shfl_xor(dk, o)); rb = fmaxf(rb, __shfl_xor(rb, o)); }
            if (l == 0) { tab[517] = 9.79795897f * LOG2E * gq * gk * 1.02f + 0.5f; tab[518] = (8.0f * dq * dk * 1.02f + rb) * LOG2E + 0.5f; }
        }
        __syncthreads();
        quant_expert_tables(F, args);
        const float bnd_m = __builtin_bit_cast(float, __builtin_amdgcn_readfirstlane(__builtin_bit_cast(int, tab[517]))), bnd_d = __builtin_bit_cast(float, __builtin_amdgcn_readfirstlane(__builtin_bit_cast(int, tab[518]))); const bool fix_m = bnd_m <= 60.f, fix_d = bnd_d <= 60.f;
        const int x = blockIdx.x & 7, jj = blockIdx.x >> 3;
        const bool bal = (F.G == 256);
        const int nun = bal ? 4 : (1024 - (int)blockIdx.x + F.G - 1) / F.G;
        if (fix_m) {
            const int nun2 = bal ? 2 : (512 - (int)blockIdx.x + F.G - 1) / F.G;
            for (int i = 0; i < nun2; ++i) { int bb, hh, qt;
                if (bal) { const int bh = x + 8 * (jj >> 3), pr = jj & 7; bb = bh >> 3; hh = bh & 7; qt = (i & 1) ? 15 - pr : pr; }
                else { const int u = blockIdx.x + i * F.G; bb = u >> 7; hh = (u >> 4) & 7; qt = u & 15; }
                attn_unit_mla2(F, bb, hh, qt, bnd_m); }
        } else {
        for (int i = 0; i < nun; ++i) { int bb, hh, qt;
            if (bal) { const int pi = jj + 32 * (i >> 1), bh = x + 8 * (pi >> 4), pr = pi & 15; bb = bh >> 3; hh = bh & 7; qt = (i & 1) ? 31 - pr : pr; }
            else { const int u = blockIdx.x + i * F.G; bb = u >> 8; hh = (u >> 5) & 7; qt = u & 31; }
            attn_unit<false, false>(F, bb, hh, qt, tab, 0.f); }
        }
        for (int i = 0; i < nun; ++i) { int bb, hh, qt;
            if (bal) { const int bh = x + 8 * (i >> 1); bb = bh >> 2; hh = bh & 3; qt = (i & 1) ? 63 - jj : jj; }
            else { const int u = blockIdx.x + i * F.G; bb = u >> 8; hh = (u >> 6) & 3; qt = u & 63; }
            if (fix_d) attn_unit<true, true>(F, bb, hh, qt, tab, bnd_d); else attn_unit<true, false>(F, bb, hh, qt, tab, 0.f); }
    }
    SEAM(3);
    PHASE(4) { REP_BAR();
        pg8::Gemm g{(const bf16_t*)(F.ws + WS_Y), (const bf16_t*)(F.ws + WS_WOUT), MTOK, 1024, 1024}; pg8::StaticOrder S; S.init(MTOK, 1024, F.G, (int)blockIdx.x);
        EpiRes E{args.in[I_X], F.out, (bf16_t*)(F.ws + WS_H2B), (float*)(F.ws + WS_SSQP)};
        pg8::gemm_phase<EpiRes, pg8::StaticOrder, true, true>(F.lds, g, S, E);
    }
    SEAM(4);
    PHASE(5) { REP_BAR();
        pg8::Gemm g{(const bf16_t*)(F.ws + WS_H2B), (const bf16_t*)(F.ws + WS_WPQ), MTOK, 2048, 1024}; pg8::StaticOrder S; S.init(MTOK, 2048, F.G, (int)blockIdx.x);
        EpiPlain E{(bf16_t*)(F.ws + WS_QP), 2048};
        pg8::gemm_phase<EpiPlain, pg8::StaticOrder, true, true>(F.lds, g, S, E);
    }
    SEAM(5);
    PHASE(6) { REP_BAR();
        const unsigned lds0 = (unsigned)(size_t)F.lds; const bf16_t* SK = (const bf16_t*)(F.ws + WS_SK);
        int cur_h = -1;
        for (int j = blockIdx.x; j < (MTOK / 256) * 8; j += F.G) {
            const int h = j & 7;
            if (h != cur_h) {
                __syncthreads();
#pragma unroll
                for (int i = 0; i < 8; ++i) { const int pc = F.wave * 8 + i, row = 4 * pc + (F.lane >> 4);
                    glds16(SK + ((size_t)h * 256 + row) * 128 + (((F.lane & 15) ^ (row & 15)) * 8), (unsigned)__builtin_amdgcn_readfirstlane((int)(lds0 + pc * 1024))); }
                asm volatile("s_waitcnt vmcnt(0)\n\ts_barrier" ::: "memory");
                cur_h = h;
            }
            p7_job(F, (j >> 3) * 8 + F.wave, h);
        }
    }
    SEAM(6);
    if (IN(7)) {
#pragma unroll 1
        for (int sw = 0; sw < P8_NSW; ++sw) {
            if (sw > 0 && hi - lo > 1) xcd_barrier(bar);
            const int smask = (hi - lo > 1 && F.ngw * 16 == MTOK) ? P8_SYNC_MASK : -1;
            for (int tb = F.gw; tb < MTOK / 16; tb += F.ngw) p8_block16(F, tb, sw, bar, smask, args.in[I_FNORM]);
        }
    }
#undef IN
#undef SEAM
}

extern "C" void kernel_launch(void* const* d_in, const int* in_sizes, int n_in, void* d_out, int out_size, void* d_ws, size_t ws_size, hipStream_t stream) {
    static int grid = 0;
    if (grid == 0) {
        if (n_in != 24 || out_size != MTOK * DMODEL || ws_size < WS_END) { fprintf(stderr, "kernel_launch: unexpected shapes (n_in %d, out %d, ws %zu < %zu)\n", n_in, out_size, ws_size, (size_t)WS_END); grid = -1; return; }
        int dev = 0, cus = 0, per_cu = 0;
        if (hipGetDevice(&dev) != hipSuccess || hipDeviceGetAttribute(&cus, hipDeviceAttributeMultiprocessorCount, dev) != hipSuccess) { grid = -1; return; }
        if (hipFuncSetAttribute((const void*)mega_fwd, hipFuncAttributeMaxDynamicSharedMemorySize, LDS_BYTES) != hipSuccess) { fprintf(stderr, "kernel_launch: hipFuncSetAttribute failed\n"); grid = -1; return; }
        if (hipOccupancyMaxActiveBlocksPerMultiprocessor(&per_cu, (const void*)mega_fwd, NTHREADS, LDS_BYTES) != hipSuccess || per_cu < 1) fprintf(stderr, "kernel_launch: occupancy query reports %d\n", per_cu);
        (void)hipGetLastError();
        grid = cus;
    }
    if (grid < 0) return;
    (void)hipMemsetAsync((char*)d_ws + WS_CTL, 0, CTL_ZERO_BYTES, stream);
    Args a{};
    for (int i = 0; i < 24; ++i) a.in[i] = (const float*)d_in[i];
    a.out = (float*)d_out; a.ws = (unsigned char*)d_ws;
#if MK_PER_PHASE
    for (int ph = 0; ph < N_PHASES; ++ph) { a.ph_lo = ph; a.ph_hi = ph + 1; hipLaunchKernelGGL(mega_fwd, dim3(grid), dim3(NTHREADS), LDS_BYTES, stream, a); }
#else
    a.ph_lo = 0; a.ph_hi = N_PHASES; hipLaunchKernelGGL(mega_fwd, dim3(grid), dim3(NTHREADS), LDS_BYTES, stream, a);
#endif
}
```

```cpp
#include <hip/hip_runtime.h>
#include <cstdio>
#include <cstdint>

#ifndef MK_PER_PHASE
#define MK_PER_PHASE 0
#endif

#ifndef REPEAT_MASK
#define REPEAT_MASK 0
#endif
#ifndef P2ON
#define P2ON 3
#endif
#ifndef PROBE_P8
#define PROBE_P8 0
#endif
#ifndef PROBE_ZERO_MLA
#define PROBE_ZERO_MLA 0
#endif
#define GAS __attribute__((address_space(1)))
#define LAS __attribute__((address_space(3)))
typedef unsigned short bf16_t;
typedef short bf16x8 __attribute__((ext_vector_type(8)));
typedef short s16x4 __attribute__((ext_vector_type(4)));
typedef short v4i16_t __attribute__((ext_vector_type(4)));
typedef float f32x2 __attribute__((ext_vector_type(2)));
typedef float f32x4 __attribute__((ext_vector_type(4)));
typedef float f32x16 __attribute__((ext_vector_type(16)));
typedef unsigned u32x2 __attribute__((ext_vector_type(2)));
typedef unsigned u32x4 __attribute__((ext_vector_type(4)));
typedef __bf16 bf16x2_t __attribute__((ext_vector_type(2)));
typedef LAS unsigned char* lds_ptr;
typedef LAS const char* lds_cptr;

#define MFMA32(a, b, c) __builtin_amdgcn_mfma_f32_32x32x16_bf16((a), (b), (c), 0, 0, 0)
#define LDS_WAIT() asm volatile("s_waitcnt lgkmcnt(0)" ::: "memory")
#define VM_WAIT() asm volatile("s_waitcnt vmcnt(0)" ::: "memory")

constexpr int BATCH = 4, SEQ = 8192, DMODEL = 1024, MTOK = BATCH * SEQ;
constexpr int NMETA = 16, LREAL = NMETA + SEQ, LP = 8256, MP = BATCH * LP;
constexpr int P1W = 2048;
constexpr int C_CQ = 0, C_CKV = 256, C_DQ = 512, C_DK = 1024, C_DV = 1536;
constexpr int XB_ROWS = MTOK + 256;
constexpr int XB_META = MTOK, XB_ZERO = MTOK + 16;
constexpr float EPS = 1e-6f;
constexpr float LOG2E = 1.4426950408889634f;
constexpr float QS_MLA = 0.10206207261596577f * LOG2E;
constexpr float QS_DIFF = 0.125f * LOG2E;
constexpr float LAMBDA_INIT = 0.2f;
constexpr float SM_THR = 8.0f;

__device__ const double ROPE_INVF[16] = {1.0, 0.5623413251903491, 0.31622776601683794, 0.1778279410038923, 0.1, 0.05623413251903491, 0.03162277660168379, 0.01778279410038923,
    0.01, 0.005623413251903491, 0.0031622776601683794, 0.0017782794100389228, 0.001, 0.0005623413251903491, 0.00031622776601683794, 0.00017782794100389227};
__device__ const unsigned char T5_BUCKET[128] = {0, 1, 2, 3, 4, 5, 6, 7, 8, 9, 10, 11, 12, 13, 14, 15, 16, 16, 16, 17, 17, 18, 18, 18, 19, 19, 19, 20, 20, 20, 20, 21, 21, 21, 21, 22, 22, 22, 22, 22,
    23, 23, 23, 23, 23, 23, 24, 24, 24, 24, 24, 24, 25, 25, 25, 25, 25, 25, 25, 26, 26, 26, 26, 26, 26, 26, 26, 27, 27, 27, 27, 27, 27, 27, 27, 27, 27, 28, 28, 28, 28, 28, 28, 28, 28, 28, 28,
    29, 29, 29, 29, 29, 29, 29, 29, 29, 29, 29, 29, 30, 30, 30, 30, 30, 30, 30, 30, 30, 30, 30, 30, 30, 30, 31, 31, 31, 31, 31, 31, 31, 31, 31, 31, 31, 31, 31, 31, 31};

constexpr size_t al256(size_t x) { return (x + 255) & ~(size_t)255; }
constexpr size_t WS_CTL = 0, CTL_ZERO_BYTES = 1u << 20;
constexpr size_t WS_W1T = CTL_ZERO_BYTES;
constexpr size_t WS_WKR = WS_W1T + (size_t)2048 * 1024 * 2;
constexpr size_t WS_WUQ = WS_WKR + (size_t)32 * 1024 * 2;
constexpr size_t WS_WUKV = WS_WUQ + (size_t)768 * 256 * 2;
constexpr size_t WS_SK = WS_WUKV + (size_t)1024 * 256 * 2;
constexpr size_t WS_WOUT = WS_SK + (size_t)16 * 128 * 128 * 2;
constexpr size_t WS_WPQ = WS_WOUT + (size_t)1024 * 1024 * 2;
constexpr size_t WS_RSTD1 = WS_WPQ + (size_t)2048 * 1024 * 2;
constexpr size_t WS_SU = al256(WS_RSTD1 + (size_t)XB_ROWS * 4);
constexpr size_t WS_SV = WS_SU + (size_t)16384 * 4;
constexpr size_t WS_SSQP = WS_SV + (size_t)16384 * 4;
constexpr size_t WS_U8 = al256(WS_SSQP + (size_t)MTOK * 16 * 4);
constexpr size_t WS_V8 = WS_U8 + (size_t)16384 * 1024;
constexpr size_t WS_XB = al256(WS_V8 + (size_t)16384 * 1024);
constexpr size_t WS_H2B = WS_XB;
constexpr size_t WS_P1 = al256(WS_XB + (size_t)XB_ROWS * 1024 * 2);
constexpr size_t WS_QP = WS_P1;
constexpr size_t WS_QM = al256(WS_P1 + (size_t)MP * P1W * 2);
constexpr size_t WS_EI = WS_QM, WS_EG = WS_QM + (size_t)MTOK * 128 * 4;
constexpr size_t WS_KM = al256(WS_QM + (size_t)MP * 768 * 2);
constexpr size_t WS_VM = al256(WS_KM + (size_t)MP * 768 * 2);
constexpr size_t WS_Y = al256(WS_VM + (size_t)MP * 512 * 2);
constexpr size_t WS_END = al256(WS_Y + (size_t)MTOK * 1024 * 2);
static_assert(WS_EG + (size_t)MTOK * 128 * 4 <= WS_KM, "EI/EG overlay fits in QM");
static_assert((size_t)MTOK * 2048 * 2 <= (size_t)MP * P1W * 2, "QP overlay fits in P1");
constexpr int CW_BAR = 4096;

constexpr int RING_BYTES = 131072;
constexpr int TAB_OFF = RING_BYTES;
constexpr int MISC_OFF = RING_BYTES + 12288;
constexpr int LDS_BYTES = 147456;
constexpr int NWAVES = 8, NTHREADS = 512;

__device__ __forceinline__ unsigned pk2(float lo, float hi) { f32x2 v = {lo, hi}; bf16x2_t b = __builtin_convertvector(v, bf16x2_t); return __builtin_bit_cast(unsigned, b); }
__device__ __forceinline__ float bf_lo(unsigned u) { return __uint_as_float(u << 16); }
__device__ __forceinline__ float bf_hi(unsigned u) { return __uint_as_float(u & 0xffff0000u); }
__device__ __forceinline__ int crow(int r, int hi) { return (r & 3) + 8 * (r >> 2) + 4 * hi; }
__device__ __forceinline__ float wave_sum(float v) {
#pragma unroll
    for (int o = 1; o < 64; o <<= 1) v += __shfl_xor(v, o);
    return v;
}
__device__ __forceinline__ float xhalf_sum(float v) { return v + __shfl_xor(v, 32); }
__device__ __forceinline__ float xhalf_max(float v) { return fmaxf(v, __shfl_xor(v, 32)); }
__device__ __forceinline__ float ssq8(u32x4 w) {
    float s = 0.f;
#pragma unroll
    for (int i = 0; i < 4; ++i) asm volatile("v_dot2c_f32_bf16 %0, %1, %2" : "+v"(s) : "v"(w[i]), "v"(w[i]));
    return s;
}
__device__ __forceinline__ bf16x8 ld_frag(const bf16_t* p) { return __builtin_bit_cast(bf16x8, *(const u32x4*)p); }
__device__ __forceinline__ f32x16 zero16() { f32x16 z;
#pragma unroll
    for (int i = 0; i < 16; ++i) z[i] = 0.f;
    return z; }
__device__ __forceinline__ s16x4 vtr(lds_cptr p) { return __builtin_bit_cast(s16x4, __builtin_amdgcn_ds_read_tr16_b64_v4i16((LAS v4i16_t*)p)); }

namespace pg8 {
#define PG8_LAS __attribute__((address_space(3)))
constexpr int BM = 256, BK = 64, HALF = 128, HTB = HALF * BK * 2, STAGE_BYTES = 8 * HTB, NXCD = 8, WGM = 8;
__host__ __device__ __forceinline__ int lds_byte(int r, int c) { const int st = (r >> 4) * 2 + (c >> 5), rr = r & 15, cc = c & 31, ob = rr * 64 + cc * 2; return st * 1024 + (ob ^ (((ob >> 9) & 1) << 5)); }
__host__ __device__ __forceinline__ void stage_rc(int b, int& R, int& C) { const int st = b / 1024, sb = b % 1024, swz = sb ^ (((sb >> 9) & 1) << 5); R = (st >> 1) * 16 + swz / 64; C = (st & 1) * 32 + (swz % 64) / 2; }
__host__ __device__ __forceinline__ int perm32(int rho) { const int n = rho >> 4, i = rho & 15; return 8 * (i >> 2) + 4 * n + (i & 3); }
struct Unit { int pm, pn; };
struct Gemm { const bf16_t* A; const bf16_t* Bt; int M, N, K; };
struct StaticOrder {
    int nM, nN, nwg, G, c;
    __host__ __device__ void init(int M, int N, int G_, int c_) { nM = M / BM; nN = N / BM; nwg = nM * nN; G = G_; c = c_; }
    __host__ __device__ bool next(int i, Unit& u) const {
        const long L = (long)i * G + c; if (L >= nwg) return false;
        int wgid = (int)L; { const int q = nwg / NXCD, r = nwg % NXCD, xcd = wgid % NXCD, off = wgid / NXCD; wgid = (xcd < r ? xcd * (q + 1) : r * (q + 1) + (xcd - r) * q) + off; }
        const int nig = WGM * nN, gid = wgid / nig, fm = gid * WGM, gsz = (nM - fm) < WGM ? (nM - fm) : WGM;
        u.pm = fm + ((wgid % nig) % gsz); u.pn = (wgid % nig) / gsz; return true;
    }
    __device__ __forceinline__ void a_ready(const Unit&) const {}
    __device__ __forceinline__ void done(const Unit&) const {}
};
template <class Epi, class Sched, bool ALIGN_EPI = false, bool SP2 = false>
__device__ __forceinline__ void gemm_phase(PG8_LAS unsigned char* lds, const Gemm g, const Sched& S, const Epi& E) {
    const int tid = threadIdx.x, wid = __builtin_amdgcn_readfirstlane(tid >> 6), lane = tid & 63, wr = wid >> 2, wc = wid & 3, fr = lane & 15, fq = lane >> 4;
    const int K = g.K, nt = K / BK;
    unsigned voffA[2], voffB[2];
#pragma unroll
    for (int i = 0; i < 2; ++i) { int R, C; stage_rc(tid * 16 + i * 8192, R, C); const int Rb = Epi::PERM ? ((R & ~31) + perm32(R & 31)) : R;
        voffA[i] = (unsigned)(R * K + C) * 2u; voffB[i] = (unsigned)(Rb * K + C) * 2u; }
    const size_t kstep = (size_t)(BK * 2);
    const size_t hstep = (size_t)HALF * K * 2;
    const size_t tstep = 2 * hstep;
    const unsigned ldsw = (unsigned)wid * 1024u;
    const int aoff = lds_byte(wr * 64 + fr, fq * 8), boff = lds_byte(wc * 32 + fr, fq * 8);
#define PG8_SA(b, h) (((b) * 2 + (h)) * HTB)
#define PG8_SB(b, h) ((4 + (b) * 2 + (h)) * HTB)
#define PG8_STAGE(bufoff, gbase, voff) do { _Pragma("unroll") for (int _i = 0; _i < 2; ++_i) \
        __builtin_amdgcn_global_load_lds((const unsigned*)((const char*)(gbase) + (voff)[_i]), (PG8_LAS unsigned*)(lds + (bufoff) + ldsw + _i * 8192), 16, 0, 0); } while (0)
#define PG8_LDA(dst, b, h) do { _Pragma("unroll") for (int m = 0; m < 4; ++m) _Pragma("unroll") for (int k = 0; k < 2; ++k) dst[m][k] = *(const PG8_LAS bf16x8*)(lds + PG8_SA(b, h) + aoff + m * 2048 + k * 1024); } while (0)
#define PG8_LDB(dst, b, h) do { _Pragma("unroll") for (int n = 0; n < 2; ++n) _Pragma("unroll") for (int k = 0; k < 2; ++k) dst[n][k] = *(const PG8_LAS bf16x8*)(lds + PG8_SB(b, h) + boff + n * 2048 + k * 1024); } while (0)
#define PG8_MMA(ai, bj, At, Bt) do { __builtin_amdgcn_s_setprio(1); _Pragma("unroll") for (int m = 0; m < 4; ++m) _Pragma("unroll") for (int n = 0; n < 2; ++n) _Pragma("unroll") for (int k = 0; k < 2; ++k) \
        acc[ai][bj][m][n] = __builtin_amdgcn_mfma_f32_16x16x32_bf16(Bt[n][k], At[m][k], acc[ai][bj][m][n], 0, 0, 0); __builtin_amdgcn_s_setprio(0); } while (0)
#define PG8_WAIT_V(n) asm volatile("s_waitcnt vmcnt(" #n ")" ::: "memory")
#define PG8_WAIT_L(n) asm volatile("s_waitcnt lgkmcnt(" #n ")" ::: "memory")
#define PG8_BAR __builtin_amdgcn_s_barrier()
#define PG8_SCHED __builtin_amdgcn_sched_barrier(0)
    Unit cur, nxt; int ui = 0;
    if (!S.next(0, cur)) return;
    f32x4 acc[2][2][4][2];
#pragma unroll
    for (int a = 0; a < 2; ++a)
#pragma unroll
        for (int b = 0; b < 2; ++b)
#pragma unroll
            for (int m = 0; m < 4; ++m)
#pragma unroll
                for (int n = 0; n < 2; ++n) acc[a][b][m][n] = (f32x4){0.f, 0.f, 0.f, 0.f};
    bf16x8 At[4][2], B0[2][2], B1[2][2];
    const char* cA = (const char*)g.A + (size_t)cur.pm * tstep; const char* cB = (const char*)g.Bt + (size_t)cur.pn * tstep;
    S.a_ready(cur);
    if constexpr (SP2) {
        PG8_STAGE(PG8_SB(0, 0), cB, voffB); PG8_STAGE(PG8_SB(0, 1), cB + hstep, voffB); PG8_STAGE(PG8_SA(0, 0), cA, voffA); PG8_STAGE(PG8_SA(0, 1), cA + hstep, voffA);
        if (wr == 1) PG8_BAR;
        PG8_WAIT_V(2); PG8_BAR;
        PG8_STAGE(PG8_SB(1, 0), cB + kstep, voffB); PG8_STAGE(PG8_SA(1, 0), cA + kstep, voffA); PG8_STAGE(PG8_SB(1, 1), cB + hstep + kstep, voffB);
        PG8_WAIT_V(6); PG8_BAR;
    } else {
        PG8_STAGE(PG8_SB(0, 0), cB, voffB); PG8_STAGE(PG8_SA(0, 0), cA, voffA); PG8_STAGE(PG8_SB(0, 1), cB + hstep, voffB); PG8_STAGE(PG8_SA(0, 1), cA + hstep, voffA);
        if (wr == 1) PG8_BAR;
        PG8_WAIT_V(4); PG8_BAR;
        PG8_STAGE(PG8_SB(1, 0), cB + kstep, voffB); PG8_STAGE(PG8_SA(1, 0), cA + kstep, voffA); PG8_STAGE(PG8_SB(1, 1), cB + hstep + kstep, voffB);
        PG8_WAIT_V(6); PG8_BAR;
    }
    for (;;) {
        const bool has_next = S.next(ui + 1, nxt);
        const char* nA = has_next ? (const char*)g.A + (size_t)nxt.pm * tstep : cA; const char* nB = has_next ? (const char*)g.Bt + (size_t)nxt.pn * tstep : cB;
        for (int t = 0; t < nt; t += 2) {
            const bool last = (t == nt - 2);
            const char* a1 = cA + (size_t)(t + 1) * kstep;
            const char* a2 = last ? nA : cA + (size_t)(t + 2) * kstep; const char* b2 = last ? nB : cB + (size_t)(t + 2) * kstep;
            const char* a3 = a2 + kstep; const char* b3 = b2 + kstep;
            if (last && has_next) S.a_ready(nxt);
            if constexpr (SP2) {
            PG8_LDB(B0, 0, 0); PG8_LDB(B1, 0, 1); PG8_SCHED; PG8_LDA(At, 0, 0); PG8_STAGE(PG8_SA(1, 1), a1 + hstep, voffA);
            PG8_WAIT_V(8); PG8_WAIT_L(0); PG8_BAR; PG8_MMA(0, 0, At, B0); PG8_MMA(0, 1, At, B1); PG8_BAR; PG8_SCHED;
            PG8_LDA(At, 0, 1); PG8_STAGE(PG8_SB(0, 0), b2, voffB); PG8_STAGE(PG8_SB(0, 1), b2 + hstep, voffB); PG8_STAGE(PG8_SA(0, 0), a2, voffA);
            PG8_WAIT_V(8); PG8_WAIT_L(0); PG8_BAR; PG8_MMA(1, 0, At, B0); PG8_MMA(1, 1, At, B1); PG8_BAR; PG8_SCHED;
            PG8_LDB(B0, 1, 0); PG8_LDB(B1, 1, 1); PG8_SCHED; PG8_LDA(At, 1, 0); PG8_STAGE(PG8_SA(0, 1), a2 + hstep, voffA);
            PG8_WAIT_V(8); PG8_WAIT_L(0); PG8_BAR; PG8_MMA(0, 0, At, B0); PG8_MMA(0, 1, At, B1); PG8_BAR; PG8_SCHED;
            PG8_LDA(At, 1, 1); PG8_STAGE(PG8_SB(1, 0), b3, voffB); PG8_STAGE(PG8_SB(1, 1), b3 + hstep, voffB); PG8_STAGE(PG8_SA(1, 0), a3, voffA);
            PG8_WAIT_V(8); PG8_WAIT_L(0); PG8_BAR; PG8_MMA(1, 0, At, B0); PG8_MMA(1, 1, At, B1); PG8_BAR; PG8_SCHED;
            } else {
            PG8_LDB(B0, 0, 0); PG8_SCHED; PG8_LDA(At, 0, 0); PG8_STAGE(PG8_SA(1, 1), a1 + hstep, voffA);
            PG8_WAIT_L(8); PG8_BAR; PG8_WAIT_L(0); PG8_MMA(0, 0, At, B0); PG8_BAR; PG8_SCHED;
            PG8_LDB(B1, 0, 1); PG8_STAGE(PG8_SB(0, 0), b2, voffB);
            PG8_BAR; PG8_WAIT_L(0); PG8_MMA(0, 1, At, B1); PG8_BAR;
            PG8_LDA(At, 0, 1); PG8_STAGE(PG8_SA(0, 0), a2, voffA);
            PG8_BAR; PG8_WAIT_L(0); PG8_MMA(1, 0, At, B0); PG8_BAR; PG8_SCHED;
            PG8_STAGE(PG8_SB(0, 1), b2 + hstep, voffB);
            PG8_WAIT_V(6); PG8_BAR; PG8_MMA(1, 1, At, B1); PG8_BAR;
            PG8_LDB(B0, 1, 0); PG8_SCHED; PG8_LDA(At, 1, 0); PG8_STAGE(PG8_SA(0, 1), a2 + hstep, voffA);
            PG8_WAIT_L(8); PG8_BAR; PG8_WAIT_L(0); PG8_MMA(0, 0, At, B0); PG8_BAR; PG8_SCHED;
            PG8_LDB(B1, 1, 1); PG8_STAGE(PG8_SB(1, 0), b3, voffB);
            PG8_BAR; PG8_WAIT_L(0); PG8_MMA(0, 1, At, B1); PG8_BAR;
            PG8_LDA(At, 1, 1); PG8_STAGE(PG8_SA(1, 0), a3, voffA);
            PG8_BAR; PG8_WAIT_L(0); PG8_MMA(1, 0, At, B0); PG8_BAR; PG8_SCHED;
            PG8_STAGE(PG8_SB(1, 1), b3 + hstep, voffB);
            PG8_WAIT_V(6); PG8_BAR; PG8_MMA(1, 1, At, B1); PG8_BAR;
            }
        }
        if constexpr (ALIGN_EPI) { if (wr == 0) PG8_BAR; }
        E(acc, cur, wr, wc, fr, fq); S.done(cur);
        if (!has_next) break;
#pragma unroll
        for (int a = 0; a < 2; ++a)
#pragma unroll
            for (int b = 0; b < 2; ++b)
#pragma unroll
                for (int m = 0; m < 4; ++m)
#pragma unroll
                    for (int n = 0; n < 2; ++n) acc[a][b][m][n] = (f32x4){0.f, 0.f, 0.f, 0.f};
        cur = nxt; cA = nA; cB = nB; ++ui;
        if constexpr (ALIGN_EPI) { if (wr == 1) PG8_BAR; }
    }
    PG8_WAIT_V(0);
    if constexpr (!ALIGN_EPI) { if (wr == 0) PG8_BAR; }
    PG8_BAR;
#undef PG8_SA
#undef PG8_SB
#undef PG8_STAGE
#undef PG8_LDA
#undef PG8_LDB
#undef PG8_MMA
#undef PG8_WAIT_V
#undef PG8_WAIT_L
#undef PG8_BAR
#undef PG8_SCHED
}
}

struct EpiP1 {
    static constexpr bool PERM = true, AFTER_DRAIN = false;
    bf16_t* P1; const float* rstd;
    __device__ __forceinline__ void operator()(const f32x4 (&acc)[2][2][4][2], const pg8::Unit& u, int wr, int wc, int fr, int fq) const {
#pragma unroll
        for (int ai = 0; ai < 2; ++ai)
#pragma unroll
            for (int m = 0; m < 4; ++m) {
                const int row = u.pm * 256 + ai * 128 + wr * 64 + m * 16 + fr;
                const float rs = rstd[row];
                const size_t prow = (size_t)(row >> 13) * LP + NMETA + (row & (SEQ - 1));
                bf16_t* rowp = P1 + prow * P1W + u.pn * 256 + wc * 32 + 8 * fq;
#pragma unroll
                for (int bj = 0; bj < 2; ++bj) { const f32x4 v0 = acc[ai][bj][m][0] * rs, v1 = acc[ai][bj][m][1] * rs;
                    u32x4 w; w.x = pk2(v0[0], v0[1]); w.y = pk2(v0[2], v0[3]); w.z = pk2(v1[0], v1[1]); w.w = pk2(v1[2], v1[3]);
                    *(u32x4*)(rowp + bj * 128) = w; } }
    }
};
struct EpiRes {
    static constexpr bool PERM = false, AFTER_DRAIN = false;
    const float* x; float* out; bf16_t* hb; float* ssqp;
    __device__ __forceinline__ void operator()(const f32x4 (&acc)[2][2][4][2], const pg8::Unit& u, int wr, int wc, int fr, int fq) const {
#pragma unroll
        for (int ai = 0; ai < 2; ++ai)
#pragma unroll
            for (int m = 0; m < 4; ++m) {
                const int row = u.pm * 256 + ai * 128 + wr * 64 + m * 16 + fr;
                const size_t off = (size_t)row * DMODEL + u.pn * 256 + wc * 32 + 4 * fq;
                float ss = 0.f;
#pragma unroll
                for (int bj = 0; bj < 2; ++bj)
#pragma unroll
                    for (int n = 0; n < 2; ++n) { const f32x4 hv = *(const f32x4*)(x + off + bj * 128 + n * 16) + acc[ai][bj][m][n];
                        u32x2 wv; wv.x = pk2(hv[0], hv[1]); wv.y = pk2(hv[2], hv[3]); *(u32x2*)(hb + off + bj * 128 + n * 16) = wv;
                        ss = __builtin_fmaf(hv[0], hv[0], ss); ss = __builtin_fmaf(hv[1], hv[1], ss); ss = __builtin_fmaf(hv[2], hv[2], ss); ss = __builtin_fmaf(hv[3], hv[3], ss); }
                ss += __shfl_xor(ss, 16); ss += __shfl_xor(ss, 32);
                if (fq == 0) ssqp[(size_t)row * 16 + u.pn * 4 + wc] = ss;
            }
    }
};
struct EpiPlain {
    static constexpr bool PERM = true, AFTER_DRAIN = false;
    bf16_t* O; int ldc;
    __device__ __forceinline__ void operator()(const f32x4 (&acc)[2][2][4][2], const pg8::Unit& u, int wr, int wc, int fr, int fq) const {
#pragma unroll
        for (int ai = 0; ai < 2; ++ai)
#pragma unroll
            for (int m = 0; m < 4; ++m) {
                bf16_t* rowp = O + (size_t)(u.pm * 256 + ai * 128 + wr * 64 + m * 16 + fr) * ldc + u.pn * 256 + wc * 32 + 8 * fq;
#pragma unroll
                for (int bj = 0; bj < 2; ++bj) { const f32x4 v0 = acc[ai][bj][m][0], v1 = acc[ai][bj][m][1];
                    u32x4 w; w.x = pk2(v0[0], v0[1]); w.y = pk2(v0[2], v0[3]); w.z = pk2(v1[0], v1[1]); w.w = pk2(v1[2], v1[3]);
                    *(u32x4*)(rowp + bj * 128) = w; } }
    }
};

#define XB_TMO      128
#define XB_XCNT(j)  (256  + 64 * (j))
#define XB_XSUB(j)  (1280 + 64 * (j))
#define XB_XGEN(j)  (2304 + 64 * (j))
#define XB_TOP      3328
#define XB_TOPGEN   3392
#define XCD_BAR_WORDS 3456
#define XB_SPIN_CAP (1u << 18)
__device__ __forceinline__ unsigned xb_ld(unsigned* p)              { return __hip_atomic_load(p, __ATOMIC_RELAXED, __HIP_MEMORY_SCOPE_AGENT); }
__device__ __forceinline__ unsigned xb_add(unsigned* p, unsigned v) { return __hip_atomic_fetch_add(p, v, __ATOMIC_RELAXED, __HIP_MEMORY_SCOPE_AGENT); }
__device__ __forceinline__ unsigned xb_xcc_id() { return (unsigned)__builtin_amdgcn_s_getreg((3 << 11) | 20) & 0xFu; }
#define XB_SPIN(cond, bar) do { unsigned _sp = 0; while (cond) { __builtin_amdgcn_s_sleep(1); \
    if ((++_sp & 255u) == 0u) { if (xb_ld(&(bar)[XB_TMO])) break; if (_sp > XB_SPIN_CAP) { atomicAdd(&(bar)[XB_TMO], 1u); break; } } } } while (0)
struct XcdBarrier { unsigned* bar; unsigned x; volatile LAS unsigned* st; };
__device__ __forceinline__ XcdBarrier xcd_barrier_post(unsigned* bar, volatile LAS unsigned* st) {
    XcdBarrier b; b.bar = bar; b.x = xb_xcc_id(); b.st = st;
    if (threadIdx.x == 0) (void)xb_add(&bar[XB_XCNT(b.x)], 1u);
    return b;
}
__device__ __forceinline__ void xcd_barrier_complete(unsigned* bar, unsigned x, unsigned& nloc, unsigned& nx) {
    const unsigned G = gridDim.x * gridDim.y * gridDim.z;
    unsigned sum, cnt, mine, sp = 0u;
    for (;;) {
        sum = 0u; cnt = 0u; mine = 0u;
#pragma unroll
        for (unsigned j = 0; j < 16; ++j) { const unsigned c = xb_ld(&bar[XB_XCNT(j)]); sum += c; cnt += (c > 0u) ? 1u : 0u; mine = (j == x) ? c : mine; }
        if (sum == G) break;
        __builtin_amdgcn_s_sleep(1);
        if ((++sp & 255u) == 0u) { if (xb_ld(&bar[XB_TMO])) break; if (sp > XB_SPIN_CAP) { atomicAdd(&bar[XB_TMO], 1u); break; } }
    }
    nloc = mine > 0u ? mine : 1u; nx = cnt > 0u ? cnt : 1u;
}
__device__ __forceinline__ void xcd_barrier(const XcdBarrier& b) {
    asm volatile("s_waitcnt vmcnt(0)" ::: "memory");
    __syncthreads();
    if (threadIdx.x == 0) {
        unsigned* bar = b.bar;
        __builtin_amdgcn_s_waitcnt(0);
        unsigned nloc = b.st[0], nx = b.st[1];
        if (nloc == 0u) { xcd_barrier_complete(bar, b.x, nloc, nx); b.st[0] = nloc; b.st[1] = nx; }
        const unsigned old = xb_add(&bar[XB_XSUB(b.x)], 1u);
        const unsigned gen = old / nloc;
        if (old + 1u == (gen + 1u) * nloc) {
            __builtin_amdgcn_fence(__ATOMIC_RELEASE, "agent");
            asm volatile("s_waitcnt vmcnt(0)" ::: "memory");
            const unsigned og = xb_add(&bar[XB_TOP], 1u);
            const unsigned tg = og / nx;
            if (og + 1u == (tg + 1u) * nx) xb_add(&bar[XB_TOPGEN], 1u);
            else XB_SPIN(xb_ld(&bar[XB_TOPGEN]) == tg, bar);
            __builtin_amdgcn_fence(__ATOMIC_ACQUIRE, "agent");
            xb_add(&bar[XB_XGEN(b.x)], 1u);
            asm volatile("s_waitcnt vmcnt(0)" ::: "memory");
        } else {
            XB_SPIN(xb_ld(&bar[XB_XGEN(b.x)]) == gen, bar);
            __builtin_amdgcn_fence(__ATOMIC_ACQUIRE, "agent");
            asm volatile("s_waitcnt vmcnt(0)" ::: "memory");
        }
    }
    __syncthreads();
}

struct Args { const float* in[24]; float* out; unsigned char* ws; int ph_lo, ph_hi; };
struct Frame {
    lds_ptr lds; int tid, lane, wave, G, gw, ngw;
    float* out; unsigned char* ws;
};
enum { I_X = 0, I_META, I_RELB, I_ANORM, I_WIN, I_QNORM, I_WUQ, I_KVNORM, I_WUKV, I_QKNQ, I_QKNK, I_DQN, I_DKN, I_LQ1, I_LK1, I_LQ2, I_LK2, I_SUBLN, I_WOUT, I_FNORM, I_WPQ, I_SUBK, I_PU, I_PV };

__device__ __forceinline__ void transpose_item(const float* W, int ldw, int c0, int K, int N, const float* gain, bf16_t* WT, int row_off, LAS float* scr, int item, int lane) {
    const int nblk = N / 32, kb = item / nblk, nb = item % nblk, k0 = 64 * kb, n0 = 32 * nb;
#pragma unroll 8
    for (int i = 0; i < 32; ++i) { const int kk = 2 * i + (lane >> 5); float v = W[(size_t)(k0 + kk) * ldw + c0 + n0 + (lane & 31)]; if (gain) v *= gain[k0 + kk]; scr[kk * 33 + (lane & 31)] = v; }
    LDS_WAIT(); asm volatile("" ::: "memory");
    const int c = lane & 7;
#pragma unroll
    for (int j = 0; j < 4; ++j) { const int n = (lane >> 3) + 8 * j; const LAS float* s = scr + (8 * c) * 33 + n;
        u32x4 o; o.x = pk2(s[0 * 33], s[1 * 33]); o.y = pk2(s[2 * 33], s[3 * 33]); o.z = pk2(s[4 * 33], s[5 * 33]); o.w = pk2(s[6 * 33], s[7 * 33]);
        *(u32x4*)(WT + (size_t)(row_off + n0 + n) * K + k0 + 8 * c) = o; }
    LDS_WAIT(); asm volatile("" ::: "memory");
}
__device__ __forceinline__ void cvt_row_1024(const float* src, bf16_t* dst, int lane) {
    const f32x4* xr = (const f32x4*)src + lane; f32x4 v[4];
#pragma unroll
    for (int j = 0; j < 4; ++j) v[j] = xr[64 * j];
    u32x2* o8 = (u32x2*)dst + lane;
#pragma unroll
    for (int j = 0; j < 4; ++j) { u32x2 w; w.x = pk2(v[j][0], v[j][1]); w.y = pk2(v[j][2], v[j][3]); o8[64 * j] = w; }
}
__device__ __forceinline__ float cvt_row_1024_ssq(const float* src, bf16_t* dst, int lane) {
    const f32x4* xr = (const f32x4*)src + lane; f32x4 v[4]; float s = 0.f;
#pragma unroll
    for (int j = 0; j < 4; ++j) { v[j] = xr[64 * j]; s += (v[j][0] * v[j][0] + v[j][1] * v[j][1]) + (v[j][2] * v[j][2] + v[j][3] * v[j][3]); }
    u32x2* o8 = (u32x2*)dst + lane;
#pragma unroll
    for (int j = 0; j < 4; ++j) { u32x2 w; w.x = pk2(v[j][0], v[j][1]); w.y = pk2(v[j][2], v[j][3]); o8[64 * j] = w; }
    return wave_sum(s);
}
__device__ __forceinline__ float quant_f32x4x4(const f32x4 (&v)[4], unsigned* dst, int off, int lane) {
    float am = 0.f;
#pragma unroll
    for (int j = 0; j < 4; ++j) am = fmaxf(fmaxf(am, fmaxf(fabsf(v[j][0]), fabsf(v[j][1]))), fmaxf(fabsf(v[j][2]), fabsf(v[j][3])));
#pragma unroll
    for (int o = 1; o < 64; o <<= 1) am = fmaxf(am, __shfl_xor(am, o));
    const float inv = am > 0.f ? 127.0f / am : 0.f;
#pragma unroll
    for (int j = 0; j < 4; ++j) { unsigned w = 0u;
#pragma unroll
        for (int i = 0; i < 4; ++i) { const int q = (int)__builtin_rintf(v[j][i] * inv) + off; w |= ((unsigned)q & 255u) << (8 * i); }
        dst[lane + 64 * j] = w; }
    return am * (1.0f / 127.0f);
}
__device__ __forceinline__ float quant_row_1024_fp8(const float* src, unsigned* dst, int lane) {
    const f32x4* xr = (const f32x4*)src + lane; f32x4 v[4]; float am = 0.f;
#pragma unroll
    for (int j = 0; j < 4; ++j) { v[j] = xr[64 * j]; am = fmaxf(fmaxf(am, fmaxf(fabsf(v[j][0]), fabsf(v[j][1]))), fmaxf(fabsf(v[j][2]), fabsf(v[j][3]))); }
#pragma unroll
    for (int o = 1; o < 64; o <<= 1) am = fmaxf(am, __shfl_xor(am, o));
    const float inv = am > 0.f ? 440.0f / am : 0.f;
#pragma unroll
    for (int j = 0; j < 4; ++j) { int w = __builtin_amdgcn_cvt_pk_fp8_f32(v[j][0] * inv, v[j][1] * inv, 0, false); w = __builtin_amdgcn_cvt_pk_fp8_f32(v[j][2] * inv, v[j][3] * inv, w, true); dst[lane + 64 * j] = (unsigned)w; }
    return am * (1.0f / 440.0f);
}
__device__ __forceinline__ float quant_row_1024(const float* src, unsigned* dst, int off, int lane) {
    const f32x4* xr = (const f32x4*)src + lane; f32x4 v[4];
#pragma unroll
    for (int j = 0; j < 4; ++j) v[j] = xr[64 * j];
    return quant_f32x4x4(v, dst, off, lane);
}
__device__ __forceinline__ void zero_bytes_wave(unsigned char* p, int nbytes, int lane) {
    for (int o = lane * 16; o < nbytes; o += 1024) *(u32x4*)(p + o) = (u32x4){0u, 0u, 0u, 0u};
}
__device__ __forceinline__ void quant_expert_tables(Frame& F, const Args& A) {
    unsigned char* ws = F.ws; const int gw = F.gw, NGW = F.ngw, lane = F.lane;
    { signed char* U8 = (signed char*)(ws + WS_U8); unsigned char* V8 = (unsigned char*)(ws + WS_V8); float* SU = (float*)(ws + WS_SU); float* SV = (float*)(ws + WS_SV);
      for (int it = gw; it < 32768; it += NGW) { const bool isv = it >= 16384; const int e = isv ? it - 16384 : it;
          const float* src = (isv ? A.in[I_PV] : A.in[I_PU]) + (size_t)e * 1024; unsigned* dst = (unsigned*)((isv ? (unsigned char*)V8 : (unsigned char*)U8) + (size_t)e * 1024);
          const float sc = isv ? quant_row_1024_fp8(src, dst, lane) : quant_row_1024(src, dst, 0, lane); if (lane == 0) (isv ? SV : SU)[e] = sc; } }
}
__device__ __forceinline__ void p0_prologue(Frame& F, const Args& A) {
    LAS float* scr = (LAS float*)(F.lds + F.wave * 16384);
    const int gw = F.gw, NGW = F.ngw, lane = F.lane;
    unsigned char* ws = F.ws;
    bf16_t* W1T = (bf16_t*)(ws + WS_W1T); bf16_t* WKR = (bf16_t*)(ws + WS_WKR); bf16_t* WUQ = (bf16_t*)(ws + WS_WUQ); bf16_t* WUKV = (bf16_t*)(ws + WS_WUKV);
    bf16_t* WOUT = (bf16_t*)(ws + WS_WOUT); bf16_t* WPQ = (bf16_t*)(ws + WS_WPQ); bf16_t* SK = (bf16_t*)(ws + WS_SK);
    constexpr int I_A = 16 * 16, I_B = 16 * 48, I_C = 16 * 1, I_D = 4 * 24, I_E = 4 * 32, I_F = 16 * 32, I_G = 16 * 64;
    constexpr int NITEMS = I_A + I_B + I_C + I_D + I_E + I_F + I_G;
    for (int it = gw; it < NITEMS; it += NGW) {
        int r = it;
        if (r < I_A) { transpose_item(A.in[I_WIN], 2080, 0, 1024, 512, A.in[I_ANORM], W1T, 0, scr, r, lane); continue; } r -= I_A;
        if (r < I_B) { transpose_item(A.in[I_WIN], 2080, 544, 1024, 1536, A.in[I_ANORM], W1T, 512, scr, r, lane); continue; } r -= I_B;
        if (r < I_C) { transpose_item(A.in[I_WIN], 2080, 512, 1024, 32, A.in[I_ANORM], WKR, 0, scr, r, lane); continue; } r -= I_C;
        if (r < I_D) { transpose_item(A.in[I_WUQ], 768, 0, 256, 768, A.in[I_QNORM], WUQ, 0, scr, r, lane); continue; } r -= I_D;
        if (r < I_E) { transpose_item(A.in[I_WUKV], 1024, 0, 256, 1024, A.in[I_KVNORM], WUKV, 0, scr, r, lane); continue; } r -= I_E;
        if (r < I_F) { transpose_item(A.in[I_WOUT], 1024, 0, 1024, 1024, nullptr, WOUT, 0, scr, r, lane); continue; } r -= I_F;
        transpose_item(A.in[I_WPQ], 2048, 0, 1024, 2048, A.in[I_FNORM], WPQ, 0, scr, r, lane);
    }
    for (int it = gw; it < 256; it += NGW) cvt_row_1024(A.in[I_SUBK] + (size_t)it * 1024, SK + (size_t)it * 1024, lane);
    { bf16_t* XB = (bf16_t*)(ws + WS_XB); float* RS = (float*)(ws + WS_RSTD1);
      for (int it = gw; it < XB_ROWS; it += NGW) {
          if (it < XB_ZERO) { const float* src = it < MTOK ? A.in[I_X] + (size_t)it * 1024 : A.in[I_META] + (size_t)(it - MTOK) * 1024;
              const float ss = cvt_row_1024_ssq(src, XB + (size_t)it * 1024, lane); if (lane == 0) RS[it] = 1.0f / sqrtf(ss * (1.0f / 1024.0f) + EPS); }
          else { zero_bytes_wave((unsigned char*)(XB + (size_t)it * 1024), 2048, lane); if (lane == 0) RS[it] = 0.f; } } }
    { bf16_t* P1 = (bf16_t*)(ws + WS_P1); bf16_t* KM = (bf16_t*)(ws + WS_KM); bf16_t* VM = (bf16_t*)(ws + WS_VM);
      for (int it = gw; it < BATCH * (LP - LREAL); it += NGW) { const size_t prow = (size_t)(it / (LP - LREAL)) * LP + LREAL + (it % (LP - LREAL));
          zero_bytes_wave((unsigned char*)(P1 + prow * P1W), P1W * 2, lane); zero_bytes_wave((unsigned char*)(KM + prow * 768), 768 * 2, lane);
          zero_bytes_wave((unsigned char*)(VM + prow * 512), 512 * 2, lane); } }
}

__device__ __forceinline__ void p1_meta_tile(Frame& F, int c) {
    const int lane = F.lane, r32 = lane & 31, hi = lane >> 5;
    const bf16_t* W1T = (const bf16_t*)(F.ws + WS_W1T); const bf16_t* XB = (const bf16_t*)(F.ws + WS_XB); const float* RS = (const float*)(F.ws + WS_RSTD1);
    const int xrow = r32 < NMETA ? XB_META + r32 : XB_ZERO;
    const bf16_t* ap = W1T + (size_t)(32 * c + r32) * 1024 + 8 * hi; const bf16_t* bp = XB + (size_t)xrow * 1024 + 8 * hi;
    f32x16 acc = zero16();
#pragma unroll 8
    for (int s = 0; s < 64; ++s) acc = MFMA32(ld_frag(ap + 16 * s), ld_frag(bp + 16 * s), acc);
    const float rs = RS[xrow];
    bf16_t* P1 = (bf16_t*)(F.ws + WS_P1);
    if (r32 < NMETA) {
#pragma unroll
        for (int g = 0; g < 4; ++g) { u32x2 w; w.x = pk2(acc[4 * g] * rs, acc[4 * g + 1] * rs); w.y = pk2(acc[4 * g + 2] * rs, acc[4 * g + 3] * rs);
#pragma unroll
            for (int b = 0; b < BATCH; ++b) *(u32x2*)(P1 + ((size_t)b * LP + r32) * P1W + 32 * c + 8 * g + 4 * hi) = w; }
    }
}

__device__ __forceinline__ void rope_tables(int pos, int hi, float (&cs)[8], float (&sn)[8]) {
#pragma unroll
    for (int r = 0; r < 8; ++r) { const int i = (r & 3) + 8 * (r >> 2) + 4 * hi;
        const double turns = (double)pos * ROPE_INVF[i] * 0.15915494309189535; const float fr = (float)(turns - __builtin_rint(turns));
        sn[r] = __builtin_amdgcn_sinf(fr); cs[r] = __builtin_amdgcn_cosf(fr); }
}
__device__ __forceinline__ void store4(bf16_t* p, float a, float b, float c, float d) { u32x2 w; w.x = pk2(a, b); w.y = pk2(c, d); *(u32x2*)p = w; }

__device__ __forceinline__ void glds16(const void* gsrc, unsigned lds_dst) { unsigned keep;
    asm volatile("s_mov_b32 %0, m0\n\ts_mov_b32 m0, %2\n\ts_nop 0\n\tglobal_load_lds_dwordx4 %1, off\n\ts_mov_b32 m0, %0" : "=&s"(keep) : "v"(gsrc), "s"(lds_dst) : "memory"); }

template <bool KV>
__device__ __forceinline__ void p2_block(Frame& F, int bj, LAS const float* tab) {
    constexpr int NR = KV ? 128 : 96, NCH = NR * 32 / NTHREADS;
    int tid_o = F.tid; asm volatile("" : "+v"(tid_o));
    const int tid = tid_o, lane = tid & 63, r32 = lane & 31, hi = lane >> 5, w = F.wave;
    const int pb = bj * 8 + w; const bool active = (pb < MP / 32) && ((pb % (LP / 32)) != (LP / 32) - 1);
    const size_t prow0 = (size_t)(active ? pb : 0) * 32, prow = prow0 + r32; const int b = (int)(prow / LP), pos = (int)(prow % LP);
    bf16_t* P1 = (bf16_t*)(F.ws + WS_P1);
    const bf16_t* W = (const bf16_t*)(F.ws + (KV ? WS_WUKV : WS_WUQ));
    const lds_ptr lds = F.lds;
    const unsigned lds0 = (unsigned)(size_t)F.lds;
    constexpr int NDI = NR / 2 / NWAVES;
#define P2_WDMA(h, buf) do { _Pragma("unroll") for (int i_ = 0; i_ < NDI; ++i_) { const int row_ = 2 * (w * NDI + i_) + (lane >> 5); \
        glds16(W + ((size_t)(h) * NR + row_) * 256 + (((lane & 31) ^ (row_ & 31)) * 8), (unsigned)__builtin_amdgcn_readfirstlane((int)(lds0 + (buf) * 65536 + (w * NDI + i_) * 1024))); } } while (0)
#define P2_WAIT_BAR() asm volatile("s_waitcnt vmcnt(0) lgkmcnt(0)\n\ts_barrier" ::: "memory")
#define P2_AFRAG(buf, t, s) (*(const LAS bf16x8*)(lds + (buf) * 65536 + ((t) * 32 + r32o) * 512 + (((2 * (s) + hio) ^ r32o) * 16)))
    __syncthreads();
    if (KV) { const bf16_t* WKR = (const bf16_t*)(F.ws + WS_WKR);
#pragma unroll
        for (int i = 0; i < 8; ++i) { const int hr = w * 8 + i, row = hr >> 1, slot = (hr & 1) * 64 + lane;
            glds16(WKR + (size_t)row * 1024 + ((slot ^ (row & 31)) * 8), (unsigned)__builtin_amdgcn_readfirstlane((int)(lds0 + 65536 + hr * 1024))); }
    }
    P2_WDMA(0, 0);
    bf16x8 cf[16]; float ss = 0.f;
#pragma unroll
    for (int s = 0; s < 16; ++s) { const u32x4 wv = *(const u32x4*)(P1 + prow * P1W + (KV ? C_CKV : C_CQ) + 16 * s + 8 * hi); ss += ssq8(wv); cf[s] = __builtin_bit_cast(bf16x8, wv); }
    const float rstd_c = 1.0f / sqrtf(xhalf_sum(ss) * (1.0f / 256.0f) + EPS);
    float cs[8], sn[8]; rope_tables(pos, hi, cs, sn);
    f32x16 kr = zero16(); float krss = 0.f;
    if (KV) {
        const bf16_t* WKR = (const bf16_t*)(F.ws + WS_WKR); const bf16_t* XB = (const bf16_t*)(F.ws + WS_XB); const float* RS = (const float*)(F.ws + WS_RSTD1);
        P2_WAIT_BAR();
        const int xrow = pos < NMETA ? XB_META + pos : (pos < LREAL ? b * SEQ + pos - NMETA : XB_ZERO);
        const bf16_t* bp = XB + (size_t)xrow * 1024 + 8 * hi;
#pragma unroll 8
        for (int s = 0; s < 64; ++s) kr = MFMA32(*(const LAS bf16x8*)(lds + 65536 + r32 * 2048 + (((2 * s + hi) ^ r32) * 16)), ld_frag(bp + 16 * s), kr);
        const float rs1 = RS[xrow];
#pragma unroll
        for (int r = 0; r < 16; ++r) { kr[r] *= rs1; krss = __builtin_fmaf(kr[r], kr[r], krss); }
        __syncthreads();
    } else {
        P2_WAIT_BAR();
    }
    bf16_t* QM = (bf16_t*)(F.ws + WS_QM); bf16_t* KM = (bf16_t*)(F.ws + WS_KM); bf16_t* VM = (bf16_t*)(F.ws + WS_VM);
#pragma unroll 1
    for (int h = 0; h < 8; ++h) {
        const int buf = h & 1;
        int r32o = r32, hio = hi; size_t prowo = prow; asm volatile("" : "+v"(r32o), "+v"(hio), "+v"(prowo));
        if (h + 1 < 8) P2_WDMA(h + 1, buf ^ 1);
        if (active) {
            if (!KV) {
                f32x16 acc[3];
#pragma unroll
                for (int t = 0; t < 3; ++t) { acc[t] = zero16();
#pragma unroll
                    for (int s = 0; s < 16; ++s) { acc[t] = MFMA32(P2_AFRAG(buf, t, s), cf[s], acc[t]); if ((s & 3) == 3) __builtin_amdgcn_sched_barrier(0); } }
                float s2 = 0.f;
#pragma unroll
                for (int t = 0; t < 3; ++t)
#pragma unroll
                    for (int r = 0; r < 16; ++r) { acc[t][r] *= rstd_c; s2 = __builtin_fmaf(acc[t][r], acc[t][r], s2); }
                const float rn = 1.0f / sqrtf(xhalf_sum(s2) * (1.0f / 96.0f) + EPS);
#pragma unroll
                for (int t = 0; t < 3; ++t)
#pragma unroll
                    for (int g = 0; g < 4; ++g) { const f32x4 gn = *(LAS const f32x4*)(tab + t * 32 + 8 * g + 4 * hio);
#pragma unroll
                        for (int j = 0; j < 4; ++j) acc[t][4 * g + j] *= rn * gn[j]; }
#pragma unroll
                for (int r = 0; r < 8; ++r) { const float x1 = acc[2][r], x2 = acc[2][r + 8]; acc[2][r] = x1 * cs[r] - x2 * sn[r]; acc[2][r + 8] = x1 * sn[r] + x2 * cs[r]; }
                bf16_t* qp = QM + prowo * 768 + h * 96 + 4 * hio;
#pragma unroll
                for (int t = 0; t < 3; ++t)
#pragma unroll
                    for (int g = 0; g < 4; ++g) store4(qp + t * 32 + 8 * g, acc[t][4 * g] * QS_MLA, acc[t][4 * g + 1] * QS_MLA, acc[t][4 * g + 2] * QS_MLA, acc[t][4 * g + 3] * QS_MLA);
            } else {
                {
                    f32x16 acc[2];
#pragma unroll
                    for (int t = 0; t < 2; ++t) { acc[t] = zero16();
#pragma unroll
                        for (int s = 0; s < 16; ++s) { acc[t] = MFMA32(P2_AFRAG(buf, t, s), cf[s], acc[t]); if ((s & 3) == 3) __builtin_amdgcn_sched_barrier(0); } }
                    float s2 = krss;
#pragma unroll
                    for (int t = 0; t < 2; ++t)
#pragma unroll
                        for (int r = 0; r < 16; ++r) { acc[t][r] *= rstd_c; s2 = __builtin_fmaf(acc[t][r], acc[t][r], s2); }
                    const float rn = 1.0f / sqrtf(xhalf_sum(s2) * (1.0f / 96.0f) + EPS);
                    bf16_t* kp = KM + prowo * 768 + h * 96 + 4 * hio;
#pragma unroll
                    for (int t = 0; t < 2; ++t)
#pragma unroll
                        for (int g = 0; g < 4; ++g) { const f32x4 gn = *(LAS const f32x4*)(tab + 96 + t * 32 + 8 * g + 4 * hio);
                            store4(kp + t * 32 + 8 * g, acc[t][4 * g] * rn * gn[0], acc[t][4 * g + 1] * rn * gn[1], acc[t][4 * g + 2] * rn * gn[2], acc[t][4 * g + 3] * rn * gn[3]); }
                    float kn[16];
#pragma unroll
                    for (int g = 0; g < 4; ++g) { const f32x4 gn = *(LAS const f32x4*)(tab + 96 + 64 + 8 * g + 4 * hio);
#pragma unroll
                        for (int j = 0; j < 4; ++j) kn[4 * g + j] = kr[4 * g + j] * rn * gn[j]; }
#pragma unroll
                    for (int r = 0; r < 8; ++r) { const float x1 = kn[r], x2 = kn[r + 8]; kn[r] = x1 * cs[r] - x2 * sn[r]; kn[r + 8] = x1 * sn[r] + x2 * cs[r]; }
#pragma unroll
                    for (int g = 0; g < 4; ++g) store4(kp + 64 + 8 * g, kn[4 * g], kn[4 * g + 1], kn[4 * g + 2], kn[4 * g + 3]);
                }
                {
                    f32x16 acc[2];
#pragma unroll
                    for (int t = 0; t < 2; ++t) { acc[t] = zero16();
#pragma unroll
                        for (int s = 0; s < 16; ++s) { acc[t] = MFMA32(P2_AFRAG(buf, 2 + t, s), cf[s], acc[t]); if ((s & 3) == 3) __builtin_amdgcn_sched_barrier(0); } }
                    bf16_t* vp = VM + prowo * 512 + h * 64 + 4 * hio;
#pragma unroll
                    for (int t = 0; t < 2; ++t)
#pragma unroll
                        for (int g = 0; g < 4; ++g) store4(vp + t * 32 + 8 * g, acc[t][4 * g] * rstd_c, acc[t][4 * g + 1] * rstd_c, acc[t][4 * g + 2] * rstd_c, acc[t][4 * g + 3] * rstd_c);
                }
            }
        }
        P2_WAIT_BAR();
    }
#undef P2_WDMA
#undef P2_WAIT_BAR
#undef P2_AFRAG
    if (!KV && active) {
        float gq[8], gk[8];
#pragma unroll
        for (int j = 0; j < 8; ++j) { gq[j] = tab[192 + (lane & 7) * 8 + j] * QS_DIFF; gk[j] = tab[256 + (lane & 7) * 8 + j]; }
#pragma unroll 4
        for (int rr = 0; rr < 32; ++rr) {
            bf16_t* qrow = P1 + (prow0 + rr) * P1W + C_DQ + lane * 8; bf16_t* krow = P1 + (prow0 + rr) * P1W + C_DK + lane * 8;
            const u32x4 wq = *(const u32x4*)qrow, wk = *(const u32x4*)krow;
            float sq = ssq8(wq), sk = ssq8(wk);
            sq += __shfl_xor(sq, 1); sk += __shfl_xor(sk, 1); sq += __shfl_xor(sq, 2); sk += __shfl_xor(sk, 2); sq += __shfl_xor(sq, 4); sk += __shfl_xor(sk, 4);
            const float rq = 1.0f / sqrtf(sq * (1.0f / 64.0f) + EPS), rk = 1.0f / sqrtf(sk * (1.0f / 64.0f) + EPS);
            u32x4 oq, ok;
#pragma unroll
            for (int i = 0; i < 4; ++i) { oq[i] = pk2(bf_lo(wq[i]) * rq * gq[2 * i], bf_hi(wq[i]) * rq * gq[2 * i + 1]); ok[i] = pk2(bf_lo(wk[i]) * rk * gk[2 * i], bf_hi(wk[i]) * rk * gk[2 * i + 1]); }
            *(u32x4*)qrow = oq; *(u32x4*)krow = ok;
        }
    }
}

template <bool DIFF, bool FIXED>
__device__ __forceinline__ void attn_unit(Frame& F, int b, int h, int qt, LAS const float* btab, float bref) {
    constexpr int NDS = DIFF ? 4 : 6;
    constexpr int NVB = DIFF ? 4 : 2;
    constexpr int QROWS = DIFF ? 128 : 256;
    constexpr int KCH = DIFF ? 16 : 12;
    constexpr int KBYTES = KCH * 1024, VBYTES = NVB * 4096, TILEB = KBYTES + VBYTES;
    int lane_o = F.lane; asm volatile("" : "+v"(lane_o));
    const int tid = F.tid, lane = lane_o, r32 = lane & 31, hi = lane >> 5, w = F.wave;
    const int map = DIFF ? (w >> 2) : 0, wq = DIFF ? (w & 3) : w;
    const bf16_t* Qg; const bf16_t* Kg; const bf16_t* Vg; int qpitch, kpitch, vpitch;
    if (DIFF) { const bf16_t* P1 = (const bf16_t*)(F.ws + WS_P1); Qg = P1 + C_DQ + h * 128 + map * 64; Kg = P1 + C_DK + h * 128; Vg = P1 + C_DV + h * 128; qpitch = kpitch = vpitch = P1W; }
    else { Qg = (const bf16_t*)(F.ws + WS_QM) + h * 96; Kg = (const bf16_t*)(F.ws + WS_KM) + h * 96; Vg = (const bf16_t*)(F.ws + WS_VM) + h * 64; qpitch = kpitch = 768; vpitch = 512; }
    const size_t brow = (size_t)b * LP;
    const int qpos0 = NMETA + qt * QROWS + wq * 32;
    const int qpos = qpos0 + r32;
    const int NT = (NMETA + qt * QROWS + QROWS + 63) >> 6;
    const int tlast = (qpos0 + 31) >> 6;
    bf16x8 qf[NDS];
#pragma unroll
    for (int d0 = 0; d0 < NDS; ++d0) qf[d0] = ld_frag(Qg + (brow + qpos) * qpitch + 16 * d0 + 8 * hi);
    __builtin_amdgcn_s_waitcnt(0x0F70);
#pragma unroll
    for (int d0 = 0; d0 < NDS; ++d0) asm volatile("" : "+v"(qf[d0]));
    constexpr int NPW = DIFF ? 4 : 3;
    const int kc1 = DIFF ? (w + 8) : (8 + (w & 3));
    const bf16_t* ksrc0 = Kg + (brow + lane) * kpitch + w * 8;
    const bf16_t* ksrc1 = Kg + (brow + lane) * kpitch + kc1 * 8;
    const bf16_t* vsrc0 = Vg + (brow + 16 * (w & 3) + (lane >> 2)) * vpitch + (w >> 2) * 32 + (lane & 3) * 8;
    const bf16_t* vsrc1 = Vg + (brow + 16 * (w & 3) + (lane >> 2)) * vpitch + ((w + 8) >> 2) * 32 + (lane & 3) * 8;
    const lds_ptr lds = F.lds; const unsigned lds0 = (unsigned)(size_t)F.lds;
    const int kdst0 = w * 1024, kdst1 = kc1 * 1024, vdst0 = KBYTES + w * 1024, vdst1 = KBYTES + (w + 8) * 1024;
    const int kbase = (DIFF ? map * 8192 : 0) + hi * 1024 + r32 * 16;
    const int vbase = KBYTES + ((lane >> 4) & 1) * 32 + (lane & 3) * 8 + (4 * hi + ((lane & 15) >> 2)) * 64;
#define ATT_GLDS(src, dst) glds16((src), (unsigned)__builtin_amdgcn_readfirstlane((int)(lds0 + (unsigned)(dst))))
#define ATT_DMA(t, so) do { const size_t to_ = (size_t)(t) * 64; ATT_GLDS(ksrc0 + to_ * kpitch, (so) + kdst0); ATT_GLDS(ksrc1 + to_ * kpitch, (so) + kdst1); \
        ATT_GLDS(vsrc0 + to_ * vpitch, (so) + vdst0); if (DIFF) ATT_GLDS(vsrc1 + to_ * vpitch, (so) + vdst1); } while (0)
#define ATT_WAIT_BAR(n) asm volatile("s_waitcnt vmcnt(" #n ") lgkmcnt(0)\n\ts_barrier" ::: "memory")
    float m_run = FIXED ? bref : 0.f, l_run = 0.f; f32x16 o[NVB];
#pragma unroll
    for (int v = 0; v < NVB; ++v) o[v] = zero16();
    const float bfar = DIFF ? btab[512 + h] : 0.f;
    f32x16 cini;
#pragma unroll
    for (int r = 0; r < 16; ++r) cini[r] = bfar - m_run;
    const bool grpB = (w >= 4);
    __syncthreads();
    ATT_DMA(0, 0); ATT_DMA(1, TILEB);
    if (DIFF) ATT_WAIT_BAR(4); else ATT_WAIT_BAR(3);
    int so_cur = 0, so_nn = 2 * TILEB;
    for (int t = 0; t < NT; ++t) {
        if (t + 2 < NT) ATT_DMA(t + 2, so_nn);
        const bool act = (t <= tlast);
        bf16x8 pa[4]; s16x4 vlo[2][NVB], vhi[2][NVB];
        if (act) {
            const lds_cptr kp = (lds_cptr)lds + so_cur + kbase;
            f32x16 p0, p1;
            bf16x8 kf0[NDS], kf1[NDS];
#pragma unroll
            for (int d0 = 0; d0 < NDS; ++d0) { kf0[d0] = *(const LAS bf16x8*)(kp + d0 * 2048); kf1[d0] = *(const LAS bf16x8*)(kp + d0 * 2048 + 512); }
            __builtin_amdgcn_sched_barrier(0);
            const int kpos0 = 64 * t + 4 * hi;
            if (DIFF && !(qpos0 - (64 * t + 63) >= 113)) {
                LAS const float* bt = btab + h * 128;
#pragma unroll
                for (int r = 0; r < 16; ++r) { const int d0_ = qpos - (kpos0 + (r & 3) + 8 * (r >> 2)); const int d1_ = d0_ - 32;
                    p0[r] = bt[min(max(d0_, 0), 127)] - m_run; p1[r] = bt[min(max(d1_, 0), 127)] - m_run; }
            } else { p0 = cini; p1 = cini; }
#pragma unroll
            for (int d0 = 0; d0 < NDS; ++d0) { p0 = MFMA32(kf0[d0], qf[d0], p0); p1 = MFMA32(kf1[d0], qf[d0], p1); }
            if (64 * t + 63 > qpos0) {
#pragma unroll
                for (int r = 0; r < 16; ++r) { const int kv = kpos0 + (r & 3) + 8 * (r >> 2); if (kv > qpos) p0[r] = -INFINITY; if (kv + 32 > qpos) p1[r] = -INFINITY; }
            }
            if (!FIXED) {
            float mx;
            { float a_ = fmaxf(fmaxf(p0[0], p0[1]), p1[0]), b_ = fmaxf(fmaxf(p0[2], p0[3]), p1[1]); a_ = fmaxf(fmaxf(a_, p1[2]), p1[3]);
#pragma unroll
              for (int r = 4; r < 16; r += 4) { a_ = fmaxf(fmaxf(a_, p0[r]), p0[r + 1]); b_ = fmaxf(fmaxf(b_, p0[r + 2]), p0[r + 3]); a_ = fmaxf(fmaxf(a_, p1[r]), p1[r + 1]); b_ = fmaxf(fmaxf(b_, p1[r + 2]), p1[r + 3]); }
              const float m_ = fmaxf(a_, b_); auto rr = __builtin_amdgcn_permlane32_swap(__float_as_uint(m_), __float_as_uint(m_), false, false);
              mx = fmaxf(__uint_as_float(rr[0]), __uint_as_float(rr[1])); }
            if (t == 0 || __any(mx > SM_THR)) {
                const float dl = (t == 0) ? mx : fmaxf(mx, 0.f); const float al = (t == 0) ? 0.f : __builtin_amdgcn_exp2f(-dl);
                m_run += dl; l_run *= al;
#pragma unroll
                for (int v = 0; v < NVB; ++v)
#pragma unroll
                    for (int r = 0; r < 16; ++r) o[v][r] *= al;
#pragma unroll
                for (int r = 0; r < 16; ++r) { p0[r] -= dl; p1[r] -= dl; cini[r] = bfar - m_run; }
            }
            }
            { const lds_cptr vp = (lds_cptr)lds + so_cur + vbase;
#pragma unroll
              for (int v = 0; v < NVB; ++v) { vlo[0][v] = vtr(vp + v * 4096); vhi[0][v] = vtr(vp + v * 4096 + 512); } }
            __builtin_amdgcn_sched_barrier(0);
            float ls = 0.f;
#pragma unroll
            for (int r = 0; r < 16; ++r) { p0[r] = __builtin_amdgcn_exp2f(p0[r]); p1[r] = __builtin_amdgcn_exp2f(p1[r]); ls += p0[r] + p1[r]; }
            l_run += ls;
            { u32x4 a0, a1, a2, a3;
#pragma unroll
              for (int i = 0; i < 4; ++i) { a0[i] = pk2(p0[2 * i], p0[2 * i + 1]); a1[i] = pk2(p0[8 + 2 * i], p0[9 + 2 * i]); a2[i] = pk2(p1[2 * i], p1[2 * i + 1]); a3[i] = pk2(p1[8 + 2 * i], p1[9 + 2 * i]); }
              pa[0] = __builtin_bit_cast(bf16x8, a0); pa[1] = __builtin_bit_cast(bf16x8, a1); pa[2] = __builtin_bit_cast(bf16x8, a2); pa[3] = __builtin_bit_cast(bf16x8, a3); }
        }
        if (grpB) { if (t + 2 < NT) { if (DIFF) ATT_WAIT_BAR(4); else ATT_WAIT_BAR(3); } else ATT_WAIT_BAR(0); }
        if (act) {
            const lds_cptr vp = (lds_cptr)lds + so_cur + vbase;
#pragma unroll
            for (int s = 0; s < 4; ++s) {
                if (s < 3) {
#pragma unroll
                    for (int v = 0; v < NVB; ++v) { vlo[(s + 1) & 1][v] = vtr(vp + v * 4096 + (s + 1) * 1024); vhi[(s + 1) & 1][v] = vtr(vp + v * 4096 + (s + 1) * 1024 + 512); }
                }
                __builtin_amdgcn_sched_barrier(0);
#pragma unroll
                for (int v = 0; v < NVB; ++v) { const s16x4 lo = vlo[s & 1][v], hi4 = vhi[s & 1][v];
                    const bf16x8 vf = (bf16x8){lo[0], lo[1], lo[2], lo[3], hi4[0], hi4[1], hi4[2], hi4[3]};
                    o[v] = MFMA32(vf, pa[s], o[v]); }
                __builtin_amdgcn_sched_barrier(0);
            }
        }
        if (!grpB) { if (t + 2 < NT) { if (DIFF) ATT_WAIT_BAR(4); else ATT_WAIT_BAR(3); } else ATT_WAIT_BAR(0); }
        so_nn = (so_nn == 3 * TILEB) ? 0 : so_nn + TILEB; so_cur = (so_cur == 3 * TILEB) ? 0 : so_cur + TILEB;
    }
    __syncthreads();
#undef ATT_GLDS
#undef ATT_DMA
#undef ATT_WAIT_BAR
    const float inv = 1.0f / xhalf_sum(l_run);
    const int tok = b * SEQ + (qpos - NMETA);
    bf16_t* Y = (bf16_t*)(F.ws + WS_Y);
    if (!DIFF) {
        bf16_t* yp = Y + (size_t)tok * 1024 + h * 64 + 4 * hi;
#pragma unroll
        for (int v = 0; v < NVB; ++v)
#pragma unroll
            for (int g = 0; g < 4; ++g) { const float z_ = PROBE_ZERO_MLA ? 0.f : inv; store4(yp + v * 32 + 8 * g, o[v][4 * g] * z_, o[v][4 * g + 1] * z_, o[v][4 * g + 2] * z_, o[v][4 * g + 3] * z_); }
    } else {
        LAS float* xch = (LAS float*)lds + (size_t)wq * 4096 + lane;
        if (map == 1) {
#pragma unroll
            for (int v = 0; v < NVB; ++v)
#pragma unroll
                for (int r = 0; r < 16; ++r) xch[(v * 16 + r) * 64] = o[v][r] * inv;
        }
        __syncthreads();
        if (map == 0) {
            const float lam = btab[516]; float s2 = 0.f;
#pragma unroll
            for (int v = 0; v < NVB; ++v)
#pragma unroll
                for (int r = 0; r < 16; ++r) { const float d = o[v][r] * inv - lam * xch[(v * 16 + r) * 64]; o[v][r] = d; s2 += d * d; }
            const float rn = (1.0f - LAMBDA_INIT) / sqrtf(xhalf_sum(s2) * (1.0f / 128.0f) + EPS);
            bf16_t* yp = Y + (size_t)tok * 1024 + 512 + h * 128 + 4 * hi;
#pragma unroll
            for (int v = 0; v < NVB; ++v)
#pragma unroll
                for (int g = 0; g < 4; ++g) { const f32x4 gn = *(LAS const f32x4*)(btab + 520 + v * 32 + 8 * g + 4 * hi);
                    store4(yp + v * 32 + 8 * g, o[v][4 * g] * rn * gn[0], o[v][4 * g + 1] * rn * gn[1], o[v][4 * g + 2] * rn * gn[2], o[v][4 * g + 3] * rn * gn[3]); }
        }
    }
}

__device__ __forceinline__ void attn_unit_mla2(Frame& F, int b, int h, int qt, float bref) {
    constexpr int NDS = 6, NVB = 2, QROWS = 512, KBYTES = 12 * 1024, VBYTES = NVB * 4096, TILEB = KBYTES + VBYTES;
    int lane_o = F.lane; asm volatile("" : "+v"(lane_o));
    const int lane = lane_o, r32 = lane & 31, hi = lane >> 5, w = F.wave;
    const bf16_t* Qg = (const bf16_t*)(F.ws + WS_QM) + h * 96; const bf16_t* Kg = (const bf16_t*)(F.ws + WS_KM) + h * 96; const bf16_t* Vg = (const bf16_t*)(F.ws + WS_VM) + h * 64;
    constexpr int qpitch = 768, kpitch = 768, vpitch = 512;
    const size_t brow = (size_t)b * LP;
    const int qposA0 = NMETA + qt * QROWS + w * 64, qposB0 = qposA0 + 32, qposA = qposA0 + r32, qposB = qposB0 + r32;
    const int NT = (NMETA + qt * QROWS + QROWS + 63) >> 6, tlast = (qposB0 + 31) >> 6;
    bf16x8 qa[NDS], qb[NDS];
#pragma unroll
    for (int d0 = 0; d0 < NDS; ++d0) { qa[d0] = ld_frag(Qg + (brow + qposA) * qpitch + 16 * d0 + 8 * hi); qb[d0] = ld_frag(Qg + (brow + qposB) * qpitch + 16 * d0 + 8 * hi); }
    __builtin_amdgcn_s_waitcnt(0x0F70);
#pragma unroll
    for (int d0 = 0; d0 < NDS; ++d0) asm volatile("" : "+v"(qa[d0]), "+v"(qb[d0]));
    const int kc1 = 8 + (w & 3);
    const bf16_t* ksrc0 = Kg + (brow + lane) * kpitch + w * 8;
    const bf16_t* ksrc1 = Kg + (brow + lane) * kpitch + kc1 * 8;
    const bf16_t* vsrc0 = Vg + (brow + 16 * (w & 3) + (lane >> 2)) * vpitch + (w >> 2) * 32 + (lane & 3) * 8;
    const lds_ptr lds = F.lds; const unsigned lds0 = (unsigned)(size_t)F.lds;
    const int kdst0 = w * 1024, kdst1 = kc1 * 1024, vdst0 = KBYTES + w * 1024;
    const int kbase = hi * 1024 + r32 * 16;
    const int vbase = KBYTES + ((lane >> 4) & 1) * 32 + (lane & 3) * 8 + (4 * hi + ((lane & 15) >> 2)) * 64;
#define AM2_GLDS(src, dst) glds16((src), (unsigned)__builtin_amdgcn_readfirstlane((int)(lds0 + (unsigned)(dst))))
#define AM2_DMA(t, so) do { const size_t to_ = (size_t)(t) * 64; AM2_GLDS(ksrc0 + to_ * kpitch, (so) + kdst0); AM2_GLDS(ksrc1 + to_ * kpitch, (so) + kdst1); AM2_GLDS(vsrc0 + to_ * vpitch, (so) + vdst0); } while (0)
#define AM2_WAIT_BAR(n) asm volatile("s_waitcnt vmcnt(" #n ") lgkmcnt(0)\n\ts_barrier" ::: "memory")
    float la = 0.f, lb = 0.f; f32x16 oa[NVB], ob[NVB];
#pragma unroll
    for (int v = 0; v < NVB; ++v) { oa[v] = zero16(); ob[v] = zero16(); }
    (void)bref;
    const bool grpB = (w >= 4);
    __syncthreads();
    AM2_DMA(0, 0); AM2_DMA(1, TILEB);
    AM2_WAIT_BAR(3);
    int so_cur = 0, so_nn = 2 * TILEB;
    for (int t = 0; t < NT; ++t) {
        if (t + 2 < NT) AM2_DMA(t + 2, so_nn);
        const bool act = (t <= tlast);
        bf16x8 pa[4], pb[4];
        if (act) {
            const lds_cptr kp = (lds_cptr)lds + so_cur + kbase;
            f32x16 a0 = zero16(), a1 = zero16(), b0 = zero16(), b1 = zero16();
#pragma unroll
            for (int d0 = 0; d0 < NDS; ++d0) { const bf16x8 k0 = *(const LAS bf16x8*)(kp + d0 * 2048), k1 = *(const LAS bf16x8*)(kp + d0 * 2048 + 512);
                a0 = MFMA32(k0, qa[d0], a0); b0 = MFMA32(k0, qb[d0], b0); a1 = MFMA32(k1, qa[d0], a1); b1 = MFMA32(k1, qb[d0], b1);
                if (d0 & 1) __builtin_amdgcn_sched_barrier(0); }
            if (64 * t + 63 > qposA0) {
                const int kpos0 = 64 * t + 4 * hi;
#pragma unroll
                for (int r = 0; r < 16; ++r) { const int kv = kpos0 + (r & 3) + 8 * (r >> 2);
                    if (kv > qposA) a0[r] = -INFINITY; if (kv + 32 > qposA) a1[r] = -INFINITY; if (kv > qposB) b0[r] = -INFINITY; if (kv + 32 > qposB) b1[r] = -INFINITY; }
            }
            { float ls = 0.f;
#pragma unroll
              for (int r = 0; r < 16; ++r) { a0[r] = __builtin_amdgcn_exp2f(a0[r]); a1[r] = __builtin_amdgcn_exp2f(a1[r]); ls += a0[r] + a1[r]; }
              la += ls; u32x4 x0, x1, x2, x3;
#pragma unroll
              for (int i = 0; i < 4; ++i) { x0[i] = pk2(a0[2 * i], a0[2 * i + 1]); x1[i] = pk2(a0[8 + 2 * i], a0[9 + 2 * i]); x2[i] = pk2(a1[2 * i], a1[2 * i + 1]); x3[i] = pk2(a1[8 + 2 * i], a1[9 + 2 * i]); }
              pa[0] = __builtin_bit_cast(bf16x8, x0); pa[1] = __builtin_bit_cast(bf16x8, x1); pa[2] = __builtin_bit_cast(bf16x8, x2); pa[3] = __builtin_bit_cast(bf16x8, x3); }
            __builtin_amdgcn_sched_barrier(0);
            { float ls = 0.f;
#pragma unroll
              for (int r = 0; r < 16; ++r) { b0[r] = __builtin_amdgcn_exp2f(b0[r]); b1[r] = __builtin_amdgcn_exp2f(b1[r]); ls += b0[r] + b1[r]; }
              lb += ls; u32x4 x0, x1, x2, x3;
#pragma unroll
              for (int i = 0; i < 4; ++i) { x0[i] = pk2(b0[2 * i], b0[2 * i + 1]); x1[i] = pk2(b0[8 + 2 * i], b0[9 + 2 * i]); x2[i] = pk2(b1[2 * i], b1[2 * i + 1]); x3[i] = pk2(b1[8 + 2 * i], b1[9 + 2 * i]); }
              pb[0] = __builtin_bit_cast(bf16x8, x0); pb[1] = __builtin_bit_cast(bf16x8, x1); pb[2] = __builtin_bit_cast(bf16x8, x2); pb[3] = __builtin_bit_cast(bf16x8, x3); }
        }
        if (grpB) { if (t + 2 < NT) AM2_WAIT_BAR(3); else AM2_WAIT_BAR(0); }
        if (act) {
            const lds_cptr vp = (lds_cptr)lds + so_cur + vbase;
#pragma unroll
            for (int ks = 0; ks < 4; ++ks)
#pragma unroll
                for (int v = 0; v < NVB; ++v) { const s16x4 lo = vtr(vp + v * 4096 + ks * 1024), hi4 = vtr(vp + v * 4096 + ks * 1024 + 512);
                    const bf16x8 vf = (bf16x8){lo[0], lo[1], lo[2], lo[3], hi4[0], hi4[1], hi4[2], hi4[3]};
                    oa[v] = MFMA32(vf, pa[ks], oa[v]); ob[v] = MFMA32(vf, pb[ks], ob[v]); }
        }
        if (!grpB) { if (t + 2 < NT) AM2_WAIT_BAR(3); else AM2_WAIT_BAR(0); }
        so_nn = (so_nn == 3 * TILEB) ? 0 : so_nn + TILEB; so_cur = (so_cur == 3 * TILEB) ? 0 : so_cur + TILEB;
    }
    __syncthreads();
#undef AM2_GLDS
#undef AM2_DMA
#undef AM2_WAIT_BAR
    const float inva = 1.0f / xhalf_sum(la), invb = 1.0f / xhalf_sum(lb);
    bf16_t* Y = (bf16_t*)(F.ws + WS_Y);
    bf16_t* ya = Y + (size_t)(b * SEQ + (qposA - NMETA)) * 1024 + h * 64 + 4 * hi; bf16_t* yb = Y + (size_t)(b * SEQ + (qposB - NMETA)) * 1024 + h * 64 + 4 * hi;
#pragma unroll
    for (int v = 0; v < NVB; ++v)
#pragma unroll
        for (int g = 0; g < 4; ++g) { store4(ya + v * 32 + 8 * g, oa[v][4 * g] * inva, oa[v][4 * g + 1] * inva, oa[v][4 * g + 2] * inva, oa[v][4 * g + 3] * inva);
                                      store4(yb + v * 32 + 8 * g, ob[v][4 * g] * invb, ob[v][4 * g + 1] * invb, ob[v][4 * g + 2] * invb, ob[v][4 * g + 3] * invb); }
}

__device__ __forceinline__ int f2key(float f) { const int b = __float_as_int(f); return b ^ ((b >> 31) & 0x7fffffff); }
__device__ __forceinline__ float key2f(int k) { return __int_as_float(k ^ ((k >> 31) & 0x7fffffff)); }
#define TOPK_INS(top, x) do { int x_ = (x); _Pragma("unroll") for (int i_ = 0; i_ < 16; ++i_) { const int hi_ = max(top[i_], x_); x_ = min(top[i_], x_); top[i_] = hi_; } } while (0)
#define CE_DESC(a, b) do { const int hi_ = max((a), (b)); const int lo_ = min((a), (b)); (a) = hi_; (b) = lo_; } while (0)
__device__ __forceinline__ void sort16_desc(int (&x)[16]) {
#pragma unroll
    for (int k = 2; k <= 16; k <<= 1)
#pragma unroll
        for (int j = k >> 1; j > 0; j >>= 1)
#pragma unroll
            for (int i = 0; i < 16; ++i) { const int l = i ^ j; if (l > i) { if ((i & k) == 0) CE_DESC(x[i], x[l]); else CE_DESC(x[l], x[i]); } }
}
__device__ __forceinline__ void merge16_desc(int (&top)[16], const int (&x)[16]) {
#pragma unroll
    for (int i = 0; i < 16; ++i) top[i] = max(top[i], x[15 - i]);
#pragma unroll
    for (int j = 8; j > 0; j >>= 1)
#pragma unroll
        for (int i = 0; i < 16; ++i) { const int l = i ^ j; if (l > i) CE_DESC(top[i], top[l]); }
}
__device__ __forceinline__ void p7_job(Frame& F, int tb, int h) {
    const int lane = F.lane, r32 = lane & 31, hi = lane >> 5;
    const bf16_t* QP = (const bf16_t*)(F.ws + WS_QP);
    const int tok = tb * 32 + r32;
    int s1[16], s2[16];
#pragma unroll 1
    for (int p = 0; p < 2; ++p) {
        bf16x8 qf[8];
#pragma unroll
        for (int s = 0; s < 8; ++s) qf[s] = ld_frag(QP + (size_t)tok * 2048 + h * 256 + p * 128 + 16 * s + 8 * hi);
        int top[16];
#pragma unroll
        for (int i = 0; i < 16; ++i) top[i] = (int)0x80000000;
#pragma unroll 1
        for (int kt = 0; kt < 4; ++kt) {
            f32x16 sc = zero16(); const lds_cptr ap = (lds_cptr)F.lds + (p * 128 + kt * 32 + r32) * 256;
#pragma unroll
            for (int s = 0; s < 8; ++s) sc = MFMA32(*(const LAS bf16x8*)(ap + (((2 * s + hi) ^ (r32 & 15)) * 16)), qf[s], sc);
            int x[16];
#pragma unroll
            for (int r = 0; r < 16; ++r) x[r] = (f2key(sc[r]) & ~127) | (kt * 32 + (r & 3) + 8 * (r >> 2) + 4 * hi);
            sort16_desc(x); merge16_desc(top, x);
        }
        int oth[16];
#pragma unroll
        for (int i = 0; i < 16; ++i) oth[i] = __shfl_xor(top[i], 32);
        merge16_desc(top, oth);
#pragma unroll
        for (int i = 0; i < 16; ++i) { if (p == 0) s1[i] = top[i]; else s2[i] = top[i]; }
    }
    float a1[16], a2[16];
#pragma unroll
    for (int i = 0; i < 16; ++i) { a1[i] = key2f(s1[i] & ~127); a2[i] = key2f(s2[i] & ~127); }
#define CAND(i, j) ((f2key(a1[i] + a2[j]) & ~255) | ((i) << 4) | (j))
    int best[16], ca[16], cb[16];
#pragma unroll
    for (int j = 0; j < 16; ++j) best[j] = CAND(0, j);
    ca[0] = CAND(1, 0); ca[1] = CAND(1, 1); ca[2] = CAND(1, 2); ca[3] = CAND(1, 3); ca[4] = CAND(1, 4); ca[5] = CAND(1, 5); ca[6] = CAND(1, 6); ca[7] = CAND(1, 7);
    ca[8] = CAND(2, 0); ca[9] = CAND(2, 1); ca[10] = CAND(2, 2); ca[11] = CAND(2, 3); ca[12] = CAND(2, 4); ca[13] = CAND(3, 0); ca[14] = CAND(3, 1); ca[15] = CAND(3, 2);
    cb[0] = CAND(3, 3); cb[1] = CAND(4, 0); cb[2] = CAND(4, 1); cb[3] = CAND(4, 2); cb[4] = CAND(5, 0); cb[5] = CAND(5, 1); cb[6] = CAND(6, 0); cb[7] = CAND(6, 1);
    cb[8] = CAND(7, 0); cb[9] = CAND(7, 1); cb[10] = CAND(8, 0); cb[11] = CAND(9, 0); cb[12] = CAND(10, 0); cb[13] = CAND(11, 0); cb[14] = CAND(12, 0); cb[15] = CAND(13, 0);
    sort16_desc(ca); merge16_desc(best, ca); sort16_desc(cb); merge16_desc(best, cb);
    TOPK_INS(best, CAND(14, 0)); TOPK_INS(best, CAND(15, 0));
#undef CAND
    LAS int* st = (LAS int*)(F.lds + 65536 + F.wave * 8192) + lane;
#pragma unroll
    for (int i = 0; i < 16; ++i) { st[i * 64] = s1[i] & 127; st[(16 + i) * 64] = s2[i] & 127; }
    float bv[8]; int ex[8];
#pragma unroll
    for (int k = 0; k < 8; ++k) { const int bk = hi ? best[8 + k] : best[k]; const int ci = (bk >> 4) & 15, cj = bk & 15;
        ex[k] = st[ci * 64] * 128 + st[(16 + cj) * 64]; bv[k] = key2f(bk & ~255); }
    float rs2;
    { const f32x4* sp = (const f32x4*)((const float*)(F.ws + WS_SSQP) + (size_t)tok * 16); const f32x4 a = sp[0], b = sp[1], c = sp[2], d = sp[3];
      const float ssq = ((a[0] + a[1]) + (a[2] + a[3])) + ((b[0] + b[1]) + (b[2] + b[3])) + ((c[0] + c[1]) + (c[2] + c[3])) + ((d[0] + d[1]) + (d[2] + d[3])); rs2 = 1.0f / sqrtf(ssq * (1.0f / 1024.0f) + EPS); }
    const float bmax = key2f(best[0] & ~255); float sum = 0.f;
#pragma unroll
    for (int k = 0; k < 8; ++k) { bv[k] = __expf((bv[k] - bmax) * rs2); sum += bv[k]; }
    sum += __shfl_xor(sum, 32);
    const float inv = 1.0f / sum;
    int* EI = (int*)(F.ws + WS_EI); float* EG = (float*)(F.ws + WS_EG);
    u32x4 i0, i1; f32x4 g0, g1;
#pragma unroll
    for (int k = 0; k < 4; ++k) { i0[k] = (unsigned)ex[k]; i1[k] = (unsigned)ex[4 + k]; g0[k] = bv[k] * inv; g1[k] = bv[4 + k] * inv; }
    int* ip = EI + (size_t)tok * 128 + h * 16 + hi * 8; float* gp = EG + (size_t)tok * 128 + h * 16 + hi * 8;
    *(u32x4*)ip = i0; *(u32x4*)(ip + 4) = i1; *(f32x4*)gp = g0; *(f32x4*)(gp + 4) = g1;
}

__device__ __forceinline__ float gelu_exact(float v) {
    const float av = fabsf(v), t = __builtin_amdgcn_rcpf(av * 0.2316418882f + 1.0f);
    float q = t * 0.5307027145f + (-0.7265760135f); q = q * t + 0.7107068705f; q = q * t + (-0.142248368f); q = q * t + 0.127414796f; q = q * t;
    const float e = __builtin_amdgcn_exp2f((v * v) * (-0.72134752044f));
    const float m = v * (q * e);
    return v < 0.f ? m : v - m;
}
__device__ __forceinline__ int wave_sum_i(int v) {
#pragma unroll
    for (int o = 1; o < 64; o <<= 1) v += __shfl_xor(v, o);
    return v;
}
constexpr int P8_SYNC_MASK = 15;
constexpr int P8_LOG_NSL = 4, P8_NSL = 1 << P8_LOG_NSL;
constexpr int P8_TS = 8, P8_NSW = (16 + P8_TS - 1) / P8_TS;
constexpr int P8_WLDS = P8_TS * 2048;
__device__ __forceinline__ int dpp_xor1(int v) { return __builtin_amdgcn_update_dpp(0, v, 0xB1, 0xF, 0xF, false); }
__device__ __forceinline__ int dpp_xor2(int v) { return __builtin_amdgcn_update_dpp(0, v, 0x4E, 0xF, 0xF, false); }
__device__ __forceinline__ int dpp_hmir(int v) { return __builtin_amdgcn_update_dpp(0, v, 0x141, 0xF, 0xF, false); }
struct P8True { static constexpr bool value = true; }; struct P8False { static constexpr bool value = false; };
template <class BarT> __device__ __forceinline__ void p8_block16(Frame& F, int tb, int sw, const BarT& bar, int sync_mask, const float* FN) {
    const int lane = F.lane, g = lane >> 3, i8 = lane & 7;
    const unsigned char* U8 = F.ws + WS_U8; const unsigned char* V8 = F.ws + WS_V8;
    const int* EI = (const int*)(F.ws + WS_EI); const float* EG = (const float*)(F.ws + WS_EG);
    const float* SU = (const float*)(F.ws + WS_SU); const float* SV = (const float*)(F.ws + WS_SV);
    const lds_ptr wl = F.lds + F.wave * P8_WLDS;
    LAS unsigned short* ids = (LAS unsigned short*)wl; LAS float* gts = (LAS float*)(wl + P8_TS * 256); LAS unsigned short* ofs = (LAS unsigned short*)(wl + P8_TS * 768);
    const lds_ptr nql = wl + P8_TS * 1024;
    const int ntk = min(P8_TS, 16 - sw * P8_TS);
    const unsigned long long ltmask = (1ull << lane) - 1ull;
    {
        const int tok0 = tb * 16 + sw * P8_TS;
#pragma unroll
        for (int ti = 0; ti < P8_TS; ++ti) if (ti < ntk) {
            const int tok = tok0 + ti;
            {
              const u32x4* hr = (const u32x4*)((const bf16_t*)(F.ws + WS_H2B) + (size_t)tok * 1024 + lane * 16); const u32x4 hA = hr[0], hB = hr[1]; f32x4 y[4];
              const f32x4* sp = (const f32x4*)((const float*)(F.ws + WS_SSQP) + (size_t)tok * 16); const f32x4 pa_ = sp[0], pb_ = sp[1], pc_ = sp[2], pd_ = sp[3];
              const float ssq = ((pa_[0] + pa_[1]) + (pa_[2] + pa_[3])) + ((pb_[0] + pb_[1]) + (pb_[2] + pb_[3])) + ((pc_[0] + pc_[1]) + (pc_[2] + pc_[3])) + ((pd_[0] + pd_[1]) + (pd_[2] + pd_[3]));
              const float rs2 = 1.0f / sqrtf(ssq * (1.0f / 1024.0f) + EPS); float am = 0.f;
#pragma unroll
              for (int i = 0; i < 4; ++i) { const unsigned w0 = (i < 2 ? hA : hB)[2 * (i & 1)], w1 = (i < 2 ? hA : hB)[2 * (i & 1) + 1];
                  const f32x4 hv = {__uint_as_float(w0 << 16), __uint_as_float(w0 & 0xffff0000u), __uint_as_float(w1 << 16), __uint_as_float(w1 & 0xffff0000u)};
                  y[i] = hv * rs2 * *(const f32x4*)(FN + lane * 16 + 4 * i);
                  am = fmaxf(fmaxf(am, fmaxf(fabsf(y[i][0]), fabsf(y[i][1]))), fmaxf(fabsf(y[i][2]), fabsf(y[i][3]))); }
#pragma unroll
              for (int o = 1; o < 64; o <<= 1) am = fmaxf(am, __shfl_xor(am, o));
              const float inv = am > 0.f ? 127.0f / am : 0.f; u32x4 qv;
#pragma unroll
              for (int i = 0; i < 4; ++i) { unsigned wv = 0u;
#pragma unroll
                  for (int k = 0; k < 4; ++k) wv |= ((unsigned)(int)__builtin_rintf(y[i][k] * inv) & 255u) << (8 * k);
                  qv[i] = wv; }
              *(LAS u32x4*)(nql + ti * 1024 + lane * 16) = qv; if (lane == 0) *(LAS float*)(wl + P8_TS * 896 + ti * 4) = am * (1.0f / 127.0f); }
            const int e0 = EI[(size_t)tok * 128 + lane], e1 = EI[(size_t)tok * 128 + 64 + lane];
            const float g0 = EG[(size_t)tok * 128 + lane], g1 = EG[(size_t)tok * 128 + 64 + lane];
            const int s0 = e0 >> (14 - P8_LOG_NSL), s1 = e1 >> (14 - P8_LOG_NSL);
            int run = 0, pos0 = 0, pos1 = 0, myoff = 0;
#pragma unroll 1
            for (int sl = 0; sl < P8_NSL; ++sl) {
                const unsigned long long m0 = __ballot(s0 == sl), m1 = __ballot(s1 == sl);
                const int c0 = __popcll(m0), c1 = __popcll(m1);
                if (s0 == sl) pos0 = run + __popcll(m0 & ltmask);
                if (s1 == sl) pos1 = run + c0 + __popcll(m1 & ltmask);
                if (lane == sl) myoff = run;
                run += c0 + c1;
            }
            if (lane == P8_NSL) myoff = 128;
            ids[ti * 128 + pos0] = (unsigned short)e0; ids[ti * 128 + pos1] = (unsigned short)e1; gts[ti * 128 + pos0] = g0; gts[ti * 128 + pos1] = g1;
            if (lane <= P8_NSL) ofs[ti * 64 + lane] = (unsigned short)myoff;
        }
        f32x2 acc[P8_TS][8];
#pragma unroll
        for (int ti = 0; ti < P8_TS; ++ti)
#pragma unroll
            for (int i = 0; i < 8; ++i) acc[ti][i] = (f32x2){0.f, 0.f};
#pragma unroll 1
        for (int sl = 0; sl < P8_NSL; ++sl) {
            if (sl && (sl & sync_mask) == 0) xcd_barrier(bar);
#pragma unroll
            for (int ti = 0; ti < P8_TS; ++ti) if (ti < ntk) {
                const int lo = __builtin_amdgcn_readfirstlane((int)ofs[ti * 64 + sl]), hi = __builtin_amdgcn_readfirstlane((int)ofs[ti * 64 + sl + 1]);
#pragma unroll 1
                for (int c0 = lo; c0 < hi; c0 += 8) {
                    const int nd = min(8, hi - c0);
                    auto step = [&](auto fullc) {
                        constexpr bool FULL = decltype(fullc)::value;
                        const int n = FULL ? 8 : nd;
                        const int idx = ti * 128 + c0 + (FULL ? g : min(g, n - 1));
                        const int id = ids[idx]; const float gate = (FULL || g < n) ? gts[idx] : 0.f;
                        const float su = SU[id], sv = SV[id];
                        const unsigned char* up = U8 + (size_t)id * 1024 + i8 * 16;
                        u32x4 ur[8], vr[8];
#pragma unroll
                        for (int j = 0; j < 8; ++j) ur[j] = *(const u32x4*)(up + 128 * j);
#pragma unroll
                        for (int k = 0; k < 8; ++k) if (k < n) { const int e = __builtin_amdgcn_readlane(id, 8 * k); vr[k] = *(const u32x4*)(V8 + (size_t)e * 1024 + lane * 16); }
                        int d = 0; unsigned nqo = (unsigned)(ti * 1024 + i8 * 16); asm volatile("" : "+v"(nqo));
#pragma unroll
                        for (int j = 0; j < 8; ++j) { const u32x4 q = *(const LAS u32x4*)(nql + nqo + 128 * j);
#pragma unroll
                            for (int i = 0; i < 4; ++i) d = __builtin_amdgcn_sdot4((int)ur[j][i], (int)q[i], d, false); }
                        d += dpp_xor1(d); d += dpp_xor2(d); d += dpp_hmir(d);
                        const float coef = gate * gelu_exact((float)d * (*(const LAS float*)(wl + P8_TS * 896 + (nqo & 0x1c00u) / 256u) * su)) * sv;
#pragma unroll
                        for (int k = 0; k < 8; ++k) if (k < n) { const float c = __builtin_bit_cast(float, __builtin_amdgcn_readlane(__builtin_bit_cast(int, coef), 8 * k)); const f32x2 c2 = {c, c};
#pragma unroll
                            for (int i = 0; i < 4; ++i) { const f32x2 lo2 = __builtin_amdgcn_cvt_pk_f32_fp8((int)vr[k][i], false), hi2 = __builtin_amdgcn_cvt_pk_f32_fp8((int)vr[k][i], true);
                                acc[ti][2 * i] = c2 * lo2 + acc[ti][2 * i]; acc[ti][2 * i + 1] = c2 * hi2 + acc[ti][2 * i + 1]; } }
                    };
                    if (nd == 8) step(P8True{}); else step(P8False{});
                }
            }
        }
#pragma unroll
        for (int ti = 0; ti < P8_TS; ++ti) if (ti < ntk) {
            int lane_f = lane; asm volatile("" : "+v"(lane_f));
            float* op = F.out + (size_t)(tok0 + ti) * 1024 + lane_f * 16;
            const u32x2* hr = (const u32x2*)((const bf16_t*)(F.ws + WS_H2B) + (size_t)(tok0 + ti) * 1024 + lane_f * 16);
#pragma unroll
            for (int i = 0; i < 4; ++i) { const u32x2 hw = hr[i]; const unsigned w0 = hw.x, w1 = hw.y;
                f32x4 hv = {__uint_as_float(w0 << 16), __uint_as_float(w0 & 0xffff0000u), __uint_as_float(w1 << 16), __uint_as_float(w1 & 0xffff0000u)};
                hv += (f32x4){acc[ti][2 * i][0], acc[ti][2 * i][1], acc[ti][2 * i + 1][0], acc[ti][2 * i + 1][1]}; *(f32x4*)(op + 4 * i) = hv; }
        }
    }
}

constexpr int N_PHASES = 8;
__global__ void __launch_bounds__(NTHREADS, 2) mega_fwd(Args args) {
    extern __shared__ __attribute__((aligned(16))) unsigned char lds_raw[];
    Frame F;
    F.lds = (lds_ptr)lds_raw; F.tid = threadIdx.x; F.lane = F.tid & 63; F.wave = __builtin_amdgcn_readfirstlane(F.tid >> 6);
    F.G = gridDim.x; F.gw = blockIdx.x * NWAVES + F.wave; F.ngw = F.G * NWAVES;
    F.out = args.out; F.ws = args.ws;
    volatile LAS unsigned* MISC = (volatile LAS unsigned*)(F.lds + MISC_OFF);
    LAS float* tab = (LAS float*)(F.lds + TAB_OFF);
    if (F.tid < 64) MISC[F.tid] = 0u;
    __syncthreads();
    const int lo = args.ph_lo, hi = args.ph_hi;
    XcdBarrier bar; bar.bar = (unsigned*)(F.ws + WS_CTL) + CW_BAR; bar.x = 0; bar.st = nullptr;
    if (hi - lo > 1) bar = xcd_barrier_post((unsigned*)(F.ws + WS_CTL) + CW_BAR, MISC + 8);
#ifndef PHASE_MASK
#define PHASE_MASK 0x0ff
#endif
#define IN(k) (((PHASE_MASK >> (k)) & 1) && lo <= (k) && (k) < hi)
#define SEAM(k) do { if (IN(k) && IN((k) + 1)) xcd_barrier(bar); } while (0)
#define REPS(k) ((((REPEAT_MASK) >> (k)) & 1) ? 2 : 1)
#define PHASE(k) if (IN(k)) _Pragma("unroll") for (int rep_ = 0; rep_ < REPS(k); ++rep_)
#define REP_BAR() do { if (rep_) xcd_barrier(bar); } while (0)

    PHASE(0) { REP_BAR(); p0_prologue(F, args); }
    SEAM(0);
    PHASE(1) { REP_BAR();
        if (F.wave == 0 && blockIdx.x < 64) p1_meta_tile(F, blockIdx.x);
        __syncthreads();
        pg8::Gemm g{(const bf16_t*)(F.ws + WS_XB), (const bf16_t*)(F.ws + WS_W1T), MTOK, 2048, 1024}; pg8::StaticOrder S; S.init(MTOK, 2048, F.G, (int)blockIdx.x);
        EpiP1 E{(bf16_t*)(F.ws + WS_P1), (const float*)(F.ws + WS_RSTD1)};
        pg8::gemm_phase<EpiP1, pg8::StaticOrder, true, true>(F.lds, g, S, E);
    }
    SEAM(1);
    if (IN(2)) {
        for (int i = F.tid; i < 320; i += NTHREADS) tab[i] = i < 96 ? args.in[I_QKNQ][i] : (i < 192 ? args.in[I_QKNK][i - 96] : (i < 256 ? args.in[I_DQN][i - 192] : args.in[I_DKN][i - 256]));
        __syncthreads();
        constexpr int NPB = MP / 32;
        constexpr int NBJ = (NPB + 7) / 8;
        for (int j = blockIdx.x; j < 2 * NBJ; j += F.G) { if (j < NBJ) { if (P2ON & 1) p2_block<false>(F, j, tab); } else { if (P2ON & 2) p2_block<true>(F, j - NBJ, tab); } }
    }
    SEAM(2);
    PHASE(3) { REP_BAR();
        for (int i = F.tid; i < 512; i += NTHREADS) { const int hh = i >> 7, n = i & 127; tab[i] = args.in[I_RELB][T5_BUCKET[n] * 4 + hh] * LOG2E; }
        if (F.tid < 4) tab[512 + F.tid] = args.in[I_RELB][31 * 4 + F.tid] * LOG2E;
        if (F.tid >= 64 && F.tid < 192) tab[520 + F.tid - 64] = args.in[I_SUBLN][F.tid - 64];
        if (F.wave == 4) { const float a = wave_sum(args.in[I_LQ1][F.lane] * args.in[I_LK1][F.lane]), c = wave_sum(args.in[I_LQ2][F.lane] * args.in[I_LK2][F.lane]);
            if (F.lane == 0) tab[516] = expf(a) - expf(c) + LAMBDA_INIT; }
        if (F.wave == 5) {
            const int l = F.lane;
            float gq = fmaxf(fabsf(args.in[I_QKNQ][l]), l < 32 ? fabsf(args.in[I_QKNQ][64 + l]) : 0.f), gk = fmaxf(fabsf(args.in[I_QKNK][l]), l < 32 ? fabsf(args.in[I_QKNK][64 + l]) : 0.f);
            float dq = fabsf(args.in[I_DQN][l]), dk = fabsf(args.in[I_DKN][l]), rb = fmaxf(fabsf(args.in[I_RELB][l]), fabsf(args.in[I_RELB][64 + l]));
#pragma unroll
            for (int o = 1; o < 64; o <<= 1) { gq = fmaxf(gq, __shfl_xor(gq, o)); gk = fmaxf(gk, __shfl_xor(gk, o)); dq = fmaxf(dq, __shfl_xor(dq, o)); dk = fmaxf(dk, __shfl_xor(dk, o)); rb = fmaxf(rb, __shfl_xor(rb, o)); }
            if (l == 0) { tab[517] = 9.79795897f * LOG2E * gq * gk * 1.02f + 0.5f; tab[518] = (8.0f * dq * dk * 1.02f + rb) * LOG2E + 0.5f; }
        }
        __syncthreads();
        quant_expert_tables(F, args);
        const float bnd_m = __builtin_bit_cast(float, __builtin_amdgcn_readfirstlane(__builtin_bit_cast(int, tab[517]))), bnd_d = __builtin_bit_cast(float, __builtin_amdgcn_readfirstlane(__builtin_bit_cast(int, tab[518]))); const bool fix_m = bnd_m <= 60.f, fix_d = bnd_d <= 60.f;
        const int x = blockIdx.x & 7, jj = blockIdx.x >> 3;
        const bool bal = (F.G == 256);
        const int nun = bal ? 4 : (1024 - (int)blockIdx.x + F.G - 1) / F.G;
        if (fix_m) {
            const int nun2 = bal ? 2 : (512 - (int)blockIdx.x + F.G - 1) / F.G;
            for (int i = 0; i < nun2; ++i) { int bb, hh, qt;
                if (bal) { const int bh = x + 8 * (jj >> 3), pr = jj & 7; bb = bh >> 3; hh = bh & 7; qt = (i & 1) ? 15 - pr : pr; }
                else { const int u = blockIdx.x + i * F.G; bb = u >> 7; hh = (u >> 4) & 7; qt = u & 15; }
                attn_unit_mla2(F, bb, hh, qt, bnd_m); }
        } else {
        for (int i = 0; i < nun; ++i) { int bb, hh, qt;
            if (bal) { const int pi = jj + 32 * (i >> 1), bh = x + 8 * (pi >> 4), pr = pi & 15; bb = bh >> 3; hh = bh & 7; qt = (i & 1) ? 31 - pr : pr; }
            else { const int u = blockIdx.x + i * F.G; bb = u >> 8; hh = (u >> 5) & 7; qt = u & 31; }
            attn_unit<false, false>(F, bb, hh, qt, tab, 0.f); }
        }
        for (int i = 0; i < nun; ++i) { int bb, hh, qt;
            if (bal) { const int bh = x + 8 * (i >> 1); bb = bh >> 2; hh = bh & 3; qt = (i & 1) ? 63 - jj : jj; }
            else { const int u = blockIdx.x + i * F.G; bb = u >> 8; hh = (u >> 6) & 3; qt = u & 63; }
            if (fix_d) attn_unit<true, true>(F, bb, hh, qt, tab, bnd_d); else attn_unit<true, false>(F, bb, hh, qt, tab, 0.f); }
    }
    SEAM(3);
    PHASE(4) { REP_BAR();
        pg8::Gemm g{(const bf16_t*)(F.ws + WS_Y), (const bf16_t*)(F.ws + WS_WOUT), MTOK, 1024, 1024}; pg8::StaticOrder S; S.init(MTOK, 1024, F.G, (int)blockIdx.x);
        EpiRes E{args.in[I_X], F.out, (bf16_t*)(F.ws + WS_H2B), (float*)(F.ws + WS_SSQP)};
        pg8::gemm_phase<EpiRes, pg8::StaticOrder, true, true>(F.lds, g, S, E);
    }
    SEAM(4);
    PHASE(5) { REP_BAR();
        pg8::Gemm g{(const bf16_t*)(F.ws + WS_H2B), (const bf16_t*)(F.ws + WS_WPQ), MTOK, 2048, 1024}; pg8::StaticOrder S; S.init(MTOK, 2048, F.G, (int)blockIdx.x);
        EpiPlain E{(bf16_t*)(F.ws + WS_QP), 2048};
        pg8::gemm_phase<EpiPlain, pg8::StaticOrder, true, true>(F.lds, g, S, E);
    }
    SEAM(5);
    PHASE(6) { REP_BAR();
        const unsigned lds0 = (unsigned)(size_t)F.lds; const bf16_t* SK = (const bf16_t*)(F.ws + WS_SK);
        int cur_h = -1;
        for (int j = blockIdx.x; j < (MTOK / 256) * 8; j += F.G) {
            const int h = j & 7;
            if (h != cur_h) {
                __syncthreads();
#pragma unroll
                for (int i = 0; i < 8; ++i) { const int pc = F.wave * 8 + i, row = 4 * pc + (F.lane >> 4);
                    glds16(SK + ((size_t)h * 256 + row) * 128 + (((F.lane & 15) ^ (row & 15)) * 8), (unsigned)__builtin_amdgcn_readfirstlane((int)(lds0 + pc * 1024))); }
                asm volatile("s_waitcnt vmcnt(0)\n\ts_barrier" ::: "memory");
                cur_h = h;
            }
            p7_job(F, (j >> 3) * 8 + F.wave, h);
        }
    }
    SEAM(6);
    if (IN(7)) {
#pragma unroll 1
        for (int sw = 0; sw < P8_NSW; ++sw) {
            if (sw > 0 && hi - lo > 1) xcd_barrier(bar);
            const int smask = (hi - lo > 1 && F.ngw * 16 == MTOK) ? P8_SYNC_MASK : -1;
            for (int tb = F.gw; tb < MTOK / 16; tb += F.ngw) p8_block16(F, tb, sw, bar, smask, args.in[I_FNORM]);
        }
    }
#undef IN
#undef SEAM
}

extern "C" void kernel_launch(void* const* d_in, const int* in_sizes, int n_in, void* d_out, int out_size, void* d_ws, size_t ws_size, hipStream_t stream) {
    static int grid = 0;
    if (grid == 0) {
        if (n_in != 24 || out_size != MTOK * DMODEL || ws_size < WS_END) { fprintf(stderr, "kernel_launch: unexpected shapes (n_in %d, out %d, ws %zu < %zu)\n", n_in, out_size, ws_size, (size_t)WS_END); grid = -1; return; }
        int dev = 0, cus = 0, per_cu = 0;
        if (hipGetDevice(&dev) != hipSuccess || hipDeviceGetAttribute(&cus, hipDeviceAttributeMultiprocessorCount, dev) != hipSuccess) { grid = -1; return; }
        if (hipFuncSetAttribute((const void*)mega_fwd, hipFuncAttributeMaxDynamicSharedMemorySize, LDS_BYTES) != hipSuccess) { fprintf(stderr, "kernel_launch: hipFuncSetAttribute failed\n"); grid = -1; return; }
        if (hipOccupancyMaxActiveBlocksPerMultiprocessor(&per_cu, (const void*)mega_fwd, NTHREADS, LDS_BYTES) != hipSuccess || per_cu < 1) fprintf(stderr, "kernel_launch: occupancy query reports %d\n", per_cu);
        (void)hipGetLastError();
        grid = cus;
    }
    if (grid < 0) return;
    (void)hipMemsetAsync((char*)d_ws + WS_CTL, 0, CTL_ZERO_BYTES, stream);
    Args a{};
    for (int i = 0; i < 24; ++i) a.in[i] = (const float*)d_in[i];
    a.out = (float*)d_out; a.ws = (unsigned char*)d_ws;
#if MK_PER_PHASE
    for (int ph = 0; ph < N_PHASES; ++ph) { a.ph_lo = ph; a.ph_hi = ph + 1; hipLaunchKernelGGL(mega_fwd, dim3(grid), dim3(NTHREADS), LDS_BYTES, stream, a); }
#else
    a.ph_lo = 0; a.ph_hi = N_PHASES; hipLaunchKernelGGL(mega_fwd, dim3(grid), dim3(NTHREADS), LDS_BYTES, stream, a);
#endif
}
```

```cpp
#include <hip/hip_runtime.h>
#include <cstdio>
#include <cstdint>

#ifndef MK_PER_PHASE
#define MK_PER_PHASE 0
#endif

#ifndef REPEAT_MASK
#define REPEAT_MASK 0
#endif
#ifndef P2ON
#define P2ON 3
#endif
#ifndef PROBE_P8
#define PROBE_P8 0
#endif
#ifndef PROBE_ZERO_MLA
#define PROBE_ZERO_MLA 0
#endif
#define GAS __attribute__((address_space(1)))
#define LAS __attribute__((address_space(3)))
typedef unsigned short bf16_t;
typedef short bf16x8 __attribute__((ext_vector_type(8)));
typedef short s16x4 __attribute__((ext_vector_type(4)));
typedef short v4i16_t __attribute__((ext_vector_type(4)));
typedef float f32x2 __attribute__((ext_vector_type(2)));
typedef float f32x4 __attribute__((ext_vector_type(4)));
typedef float f32x16 __attribute__((ext_vector_type(16)));
typedef unsigned u32x2 __attribute__((ext_vector_type(2)));
typedef unsigned u32x4 __attribute__((ext_vector_type(4)));
typedef __bf16 bf16x2_t __attribute__((ext_vector_type(2)));
typedef LAS unsigned char* lds_ptr;
typedef LAS const char* lds_cptr;

#define MFMA32(a, b, c) __builtin_amdgcn_mfma_f32_32x32x16_bf16((a), (b), (c), 0, 0, 0)
#define LDS_WAIT() asm volatile("s_waitcnt lgkmcnt(0)" ::: "memory")
#define VM_WAIT() asm volatile("s_waitcnt vmcnt(0)" ::: "memory")

constexpr int BATCH = 4, SEQ = 8192, DMODEL = 1024, MTOK = BATCH * SEQ;
constexpr int NMETA = 16, LREAL = NMETA + SEQ, LP = 8256, MP = BATCH * LP;
constexpr int P1W = 2048;
constexpr int C_CQ = 0, C_CKV = 256, C_DQ = 512, C_DK = 1024, C_DV = 1536;
constexpr int XB_ROWS = MTOK + 256;
constexpr int XB_META = MTOK, XB_ZERO = MTOK + 16;
constexpr float EPS = 1e-6f;
constexpr float LOG2E = 1.4426950408889634f;
constexpr float QS_MLA = 0.10206207261596577f * LOG2E;
constexpr float QS_DIFF = 0.125f * LOG2E;
constexpr float LAMBDA_INIT = 0.2f;
constexpr float SM_THR = 8.0f;

__device__ const double ROPE_INVF[16] = {1.0, 0.5623413251903491, 0.31622776601683794, 0.1778279410038923, 0.1, 0.05623413251903491, 0.03162277660168379, 0.01778279410038923,
    0.01, 0.005623413251903491, 0.0031622776601683794, 0.0017782794100389228, 0.001, 0.0005623413251903491, 0.00031622776601683794, 0.00017782794100389227};
__device__ const unsigned char T5_BUCKET[128] = {0, 1, 2, 3, 4, 5, 6, 7, 8, 9, 10, 11, 12, 13, 14, 15, 16, 16, 16, 17, 17, 18, 18, 18, 19, 19, 19, 20, 20, 20, 20, 21, 21, 21, 21, 22, 22, 22, 22, 22,
    23, 23, 23, 23, 23, 23, 24, 24, 24, 24, 24, 24, 25, 25, 25, 25, 25, 25, 25, 26, 26, 26, 26, 26, 26, 26, 26, 27, 27, 27, 27, 27, 27, 27, 27, 27, 27, 28, 28, 28, 28, 28, 28, 28, 28, 28, 28,
    29, 29, 29, 29, 29, 29, 29, 29, 29, 29, 29, 29, 30, 30, 30, 30, 30, 30, 30, 30, 30, 30, 30, 30, 30, 30, 31, 31, 31, 31, 31, 31, 31, 31, 31, 31, 31, 31, 31, 31, 31};

constexpr size_t al256(size_t x) { return (x + 255) & ~(size_t)255; }
constexpr size_t WS_CTL = 0, CTL_ZERO_BYTES = 1u << 20;
constexpr size_t WS_W1T = CTL_ZERO_BYTES;
constexpr size_t WS_WKR = WS_W1T + (size_t)2048 * 1024 * 2;
constexpr size_t WS_WUQ = WS_WKR + (size_t)32 * 1024 * 2;
constexpr size_t WS_WUKV = WS_WUQ + (size_t)768 * 256 * 2;
constexpr size_t WS_SK = WS_WUKV + (size_t)1024 * 256 * 2;
constexpr size_t WS_WOUT = WS_SK + (size_t)16 * 128 * 128 * 2;
constexpr size_t WS_WPQ = WS_WOUT + (size_t)1024 * 1024 * 2;
constexpr size_t WS_RSTD1 = WS_WPQ + (size_t)2048 * 1024 * 2;
constexpr size_t WS_SU = al256(WS_RSTD1 + (size_t)XB_ROWS * 4);
constexpr size_t WS_SV = WS_SU + (size_t)16384 * 4;
constexpr size_t WS_SSQP = WS_SV + (size_t)16384 * 4;
constexpr size_t WS_U8 = al256(WS_SSQP + (size_t)MTOK * 16 * 4);
constexpr size_t WS_V8 = WS_U8 + (size_t)16384 * 1024;
constexpr size_t WS_XB = al256(WS_V8 + (size_t)16384 * 1024);
constexpr size_t WS_H2B = WS_XB;
constexpr size_t WS_P1 = al256(WS_XB + (size_t)XB_ROWS * 1024 * 2);
constexpr size_t WS_QP = WS_P1;
constexpr size_t WS_QM = al256(WS_P1 + (size_t)MP * P1W * 2);
constexpr size_t WS_EI = WS_QM, WS_EG = WS_QM + (size_t)MTOK * 128 * 4;
constexpr size_t WS_KM = al256(WS_QM + (size_t)MP * 768 * 2);
constexpr size_t WS_VM = al256(WS_KM + (size_t)MP * 768 * 2);
constexpr size_t WS_Y = al256(WS_VM + (size_t)MP * 512 * 2);
constexpr size_t WS_END = al256(WS_Y + (size_t)MTOK * 1024 * 2);
static_assert(WS_EG + (size_t)MTOK * 128 * 4 <= WS_KM, "EI/EG overlay fits in QM");
static_assert((size_t)MTOK * 2048 * 2 <= (size_t)MP * P1W * 2, "QP overlay fits in P1");
constexpr int CW_BAR = 4096;

constexpr int RING_BYTES = 131072;
constexpr int TAB_OFF = RING_BYTES;
constexpr int MISC_OFF = RING_BYTES + 12288;
constexpr int LDS_BYTES = 147456;
constexpr int NWAVES = 8, NTHREADS = 512;

__device__ __forceinline__ unsigned pk2(float lo, float hi) { f32x2 v = {lo, hi}; bf16x2_t b = __builtin_convertvector(v, bf16x2_t); return __builtin_bit_cast(unsigned, b); }
__device__ __forceinline__ float bf_lo(unsigned u) { return __uint_as_float(u << 16); }
__device__ __forceinline__ float bf_hi(unsigned u) { return __uint_as_float(u & 0xffff0000u); }
__device__ __forceinline__ int crow(int r, int hi) { return (r & 3) + 8 * (r >> 2) + 4 * hi; }
__device__ __forceinline__ float wave_sum(float v) {
#pragma unroll
    for (int o = 1; o < 64; o <<= 1) v += __shfl_xor(v, o);
    return v;
}
__device__ __forceinline__ float xhalf_sum(float v) { return v + __shfl_xor(v, 32); }
__device__ __forceinline__ float xhalf_max(float v) { return fmaxf(v, __shfl_xor(v, 32)); }
__device__ __forceinline__ float ssq8(u32x4 w) {
    float s = 0.f;
#pragma unroll
    for (int i = 0; i < 4; ++i) asm volatile("v_dot2c_f32_bf16 %0, %1, %2" : "+v"(s) : "v"(w[i]), "v"(w[i]));
    return s;
}
__device__ __forceinline__ bf16x8 ld_frag(const bf16_t* p) { return __builtin_bit_cast(bf16x8, *(const u32x4*)p); }
__device__ __forceinline__ f32x16 zero16() { f32x16 z;
#pragma unroll
    for (int i = 0; i < 16; ++i) z[i] = 0.f;
    return z; }
__device__ __forceinline__ s16x4 vtr(lds_cptr p) { return __builtin_bit_cast(s16x4, __builtin_amdgcn_ds_read_tr16_b64_v4i16((LAS v4i16_t*)p)); }

namespace pg8 {
#define PG8_LAS __attribute__((address_space(3)))
constexpr int BM = 256, BK = 64, HALF = 128, HTB = HALF * BK * 2, STAGE_BYTES = 8 * HTB, NXCD = 8, WGM = 8;
__host__ __device__ __forceinline__ int lds_byte(int r, int c) { const int st = (r >> 4) * 2 + (c >> 5), rr = r & 15, cc = c & 31, ob = rr * 64 + cc * 2; return st * 1024 + (ob ^ (((ob >> 9) & 1) << 5)); }
__host__ __device__ __forceinline__ void stage_rc(int b, int& R, int& C) { const int st = b / 1024, sb = b % 1024, swz = sb ^ (((sb >> 9) & 1) << 5); R = (st >> 1) * 16 + swz / 64; C = (st & 1) * 32 + (swz % 64) / 2; }
__host__ __device__ __forceinline__ int perm32(int rho) { const int n = rho >> 4, i = rho & 15; return 8 * (i >> 2) + 4 * n + (i & 3); }
struct Unit { int pm, pn; };
struct Gemm { const bf16_t* A; const bf16_t* Bt; int M, N, K; };
struct StaticOrder {
    int nM, nN, nwg, G, c;
    __host__ __device__ void init(int M, int N, int G_, int c_) { nM = M / BM; nN = N / BM; nwg = nM * nN; G = G_; c = c_; }
    __host__ __device__ bool next(int i, Unit& u) const {
        const long L = (long)i * G + c; if (L >= nwg) return false;
        int wgid = (int)L; { const int q = nwg / NXCD, r = nwg % NXCD, xcd = wgid % NXCD, off = wgid / NXCD; wgid = (xcd < r ? xcd * (q + 1) : r * (q + 1) + (xcd - r) * q) + off; }
        const int nig = WGM * nN, gid = wgid / nig, fm = gid * WGM, gsz = (nM - fm) < WGM ? (nM - fm) : WGM;
        u.pm = fm + ((wgid % nig) % gsz); u.pn = (wgid % nig) / gsz; return true;
    }
    __device__ __forceinline__ void a_ready(const Unit&) const {}
    __device__ __forceinline__ void done(const Unit&) const {}
};
template <class Epi, class Sched, bool ALIGN_EPI = false, bool SP2 = false>
__device__ __forceinline__ void gemm_phase(PG8_LAS unsigned char* lds, const Gemm g, const Sched& S, const Epi& E) {
    const int tid = threadIdx.x, wid = __builtin_amdgcn_readfirstlane(tid >> 6), lane = tid & 63, wr = wid >> 2, wc = wid & 3, fr = lane & 15, fq = lane >> 4;
    const int K = g.K, nt = K / BK;
    unsigned voffA[2], voffB[2];
#pragma unroll
    for (int i = 0; i < 2; ++i) { int R, C; stage_rc(tid * 16 + i * 8192, R, C); const int Rb = Epi::PERM ? ((R & ~31) + perm32(R & 31)) : R;
        voffA[i] = (unsigned)(R * K + C) * 2u; voffB[i] = (unsigned)(Rb * K + C) * 2u; }
    const size_t kstep = (size_t)(BK * 2);
    const size_t hstep = (size_t)HALF * K * 2;
    const size_t tstep = 2 * hstep;
    const unsigned ldsw = (unsigned)wid * 1024u;
    const int aoff = lds_byte(wr * 64 + fr, fq * 8), boff = lds_byte(wc * 32 + fr, fq * 8);
#define PG8_SA(b, h) (((b) * 2 + (h)) * HTB)
#define PG8_SB(b, h) ((4 + (b) * 2 + (h)) * HTB)
#define PG8_STAGE(bufoff, gbase, voff) do { _Pragma("unroll") for (int _i = 0; _i < 2; ++_i) \
        __builtin_amdgcn_global_load_lds((const unsigned*)((const char*)(gbase) + (voff)[_i]), (PG8_LAS unsigned*)(lds + (bufoff) + ldsw + _i * 8192), 16, 0, 0); } while (0)
#define PG8_LDA(dst, b, h) do { _Pragma("unroll") for (int m = 0; m < 4; ++m) _Pragma("unroll") for (int k = 0; k < 2; ++k) dst[m][k] = *(const PG8_LAS bf16x8*)(lds + PG8_SA(b, h) + aoff + m * 2048 + k * 1024); } while (0)
#define PG8_LDB(dst, b, h) do { _Pragma("unroll") for (int n = 0; n < 2; ++n) _Pragma("unroll") for (int k = 0; k < 2; ++k) dst[n][k] = *(const PG8_LAS bf16x8*)(lds + PG8_SB(b, h) + boff + n * 2048 + k * 1024); } while (0)
#define PG8_MMA(ai, bj, At, Bt) do { __builtin_amdgcn_s_setprio(1); _Pragma("unroll") for (int m = 0; m < 4; ++m) _Pragma("unroll") for (int n = 0; n < 2; ++n) _Pragma("unroll") for (int k = 0; k < 2; ++k) \
        acc[ai][bj][m][n] = __builtin_amdgcn_mfma_f32_16x16x32_bf16(Bt[n][k], At[m][k], acc[ai][bj][m][n], 0, 0, 0); __builtin_amdgcn_s_setprio(0); } while (0)
#define PG8_WAIT_V(n) asm volatile("s_waitcnt vmcnt(" #n ")" ::: "memory")
#define PG8_WAIT_L(n) asm volatile("s_waitcnt lgkmcnt(" #n ")" ::: "memory")
#define PG8_BAR __builtin_amdgcn_s_barrier()
#define PG8_SCHED __builtin_amdgcn_sched_barrier(0)
    Unit cur, nxt; int ui = 0;
    if (!S.next(0, cur)) return;
    f32x4 acc[2][2][4][2];
#pragma unroll
    for (int a = 0; a < 2; ++a)
#pragma unroll
        for (int b = 0; b < 2; ++b)
#pragma unroll
            for (int m = 0; m < 4; ++m)
#pragma unroll
                for (int n = 0; n < 2; ++n) acc[a][b][m][n] = (f32x4){0.f, 0.f, 0.f, 0.f};
    bf16x8 At[4][2], B0[2][2], B1[2][2];
    const char* cA = (const char*)g.A + (size_t)cur.pm * tstep; const char* cB = (const char*)g.Bt + (size_t)cur.pn * tstep;
    S.a_ready(cur);
    if constexpr (SP2) {
        PG8_STAGE(PG8_SB(0, 0), cB, voffB); PG8_STAGE(PG8_SB(0, 1), cB + hstep, voffB); PG8_STAGE(PG8_SA(0, 0), cA, voffA); PG8_STAGE(PG8_SA(0, 1), cA + hstep, voffA);
        if (wr == 1) PG8_BAR;
        PG8_WAIT_V(2); PG8_BAR;
        PG8_STAGE(PG8_SB(1, 0), cB + kstep, voffB); PG8_STAGE(PG8_SA(1, 0), cA + kstep, voffA); PG8_STAGE(PG8_SB(1, 1), cB + hstep + kstep, voffB);
        PG8_WAIT_V(6); PG8_BAR;
    } else {
        PG8_STAGE(PG8_SB(0, 0), cB, voffB); PG8_STAGE(PG8_SA(0, 0), cA, voffA); PG8_STAGE(PG8_SB(0, 1), cB + hstep, voffB); PG8_STAGE(PG8_SA(0, 1), cA + hstep, voffA);
        if (wr == 1) PG8_BAR;
        PG8_WAIT_V(4); PG8_BAR;
        PG8_STAGE(PG8_SB(1, 0), cB + kstep, voffB); PG8_STAGE(PG8_SA(1, 0), cA + kstep, voffA); PG8_STAGE(PG8_SB(1, 1), cB + hstep + kstep, voffB);
        PG8_WAIT_V(6); PG8_BAR;
    }
    for (;;) {
        const bool has_next = S.next(ui + 1, nxt);
        const char* nA = has_next ? (const char*)g.A + (size_t)nxt.pm * tstep : cA; const char* nB = has_next ? (const char*)g.Bt + (size_t)nxt.pn * tstep : cB;
        for (int t = 0; t < nt; t += 2) {
            const bool last = (t == nt - 2);
            const char* a1 = cA + (size_t)(t + 1) * kstep;
            const char* a2 = last ? nA : cA + (size_t)(t + 2) * kstep; const char* b2 = last ? nB : cB + (size_t)(t + 2) * kstep;
            const char* a3 = a2 + kstep; const char* b3 = b2 + kstep;
            if (last && has_next) S.a_ready(nxt);
            if constexpr (SP2) {
            PG8_LDB(B0, 0, 0); PG8_LDB(B1, 0, 1); PG8_SCHED; PG8_LDA(At, 0, 0); PG8_STAGE(PG8_SA(1, 1), a1 + hstep, voffA);
            PG8_WAIT_V(8); PG8_WAIT_L(0); PG8_BAR; PG8_MMA(0, 0, At, B0); PG8_MMA(0, 1, At, B1); PG8_BAR; PG8_SCHED;
            PG8_LDA(At, 0, 1); PG8_STAGE(PG8_SB(0, 0), b2, voffB); PG8_STAGE(PG8_SB(0, 1), b2 + hstep, voffB); PG8_STAGE(PG8_SA(0, 0), a2, voffA);
            PG8_WAIT_V(8); PG8_WAIT_L(0); PG8_BAR; PG8_MMA(1, 0, At, B0); PG8_MMA(1, 1, At, B1); PG8_BAR; PG8_SCHED;
            PG8_LDB(B0, 1, 0); PG8_LDB(B1, 1, 1); PG8_SCHED; PG8_LDA(At, 1, 0); PG8_STAGE(PG8_SA(0, 1), a2 + hstep, voffA);
            PG8_WAIT_V(8); PG8_WAIT_L(0); PG8_BAR; PG8_MMA(0, 0, At, B0); PG8_MMA(0, 1, At, B1); PG8_BAR; PG8_SCHED;
            PG8_LDA(At, 1, 1); PG8_STAGE(PG8_SB(1, 0), b3, voffB); PG8_STAGE(PG8_SB(1, 1), b3 + hstep, voffB); PG8_STAGE(PG8_SA(1, 0), a3, voffA);
            PG8_WAIT_V(8); PG8_WAIT_L(0); PG8_BAR; PG8_MMA(1, 0, At, B0); PG8_MMA(1, 1, At, B1); PG8_BAR; PG8_SCHED;
            } else {
            PG8_LDB(B0, 0, 0); PG8_SCHED; PG8_LDA(At, 0, 0); PG8_STAGE(PG8_SA(1, 1), a1 + hstep, voffA);
            PG8_WAIT_L(8); PG8_BAR; PG8_WAIT_L(0); PG8_MMA(0, 0, At, B0); PG8_BAR; PG8_SCHED;
            PG8_LDB(B1, 0, 1); PG8_STAGE(PG8_SB(0, 0), b2, voffB);
            PG8_BAR; PG8_WAIT_L(0); PG8_MMA(0, 1, At, B1); PG8_BAR;
            PG8_LDA(At, 0, 1); PG8_STAGE(PG8_SA(0, 0), a2, voffA);
            PG8_BAR; PG8_WAIT_L(0); PG8_MMA(1, 0, At, B0); PG8_BAR; PG8_SCHED;
            PG8_STAGE(PG8_SB(0, 1), b2 + hstep, voffB);
            PG8_WAIT_V(6); PG8_BAR; PG8_MMA(1, 1, At, B1); PG8_BAR;
            PG8_LDB(B0, 1, 0); PG8_SCHED; PG8_LDA(At, 1, 0); PG8_STAGE(PG8_SA(0, 1), a2 + hstep, voffA);
            PG8_WAIT_L(8); PG8_BAR; PG8_WAIT_L(0); PG8_MMA(0, 0, At, B0); PG8_BAR; PG8_SCHED;
            PG8_LDB(B1, 1, 1); PG8_STAGE(PG8_SB(1, 0), b3, voffB);
            PG8_BAR; PG8_WAIT_L(0); PG8_MMA(0, 1, At, B1); PG8_BAR;
            PG8_LDA(At, 1, 1); PG8_STAGE(PG8_SA(1, 0), a3, voffA);
            PG8_BAR; PG8_WAIT_L(0); PG8_MMA(1, 0, At, B0); PG8_BAR; PG8_SCHED;
            PG8_STAGE(PG8_SB(1, 1), b3 + hstep, voffB);
            PG8_WAIT_V(6); PG8_BAR; PG8_MMA(1, 1, At, B1); PG8_BAR;
            }
        }
        if constexpr (ALIGN_EPI) { if (wr == 0) PG8_BAR; }
        E(acc, cur, wr, wc, fr, fq); S.done(cur);
        if (!has_next) break;
#pragma unroll
        for (int a = 0; a < 2; ++a)
#pragma unroll
            for (int b = 0; b < 2; ++b)
#pragma unroll
                for (int m = 0; m < 4; ++m)
#pragma unroll
                    for (int n = 0; n < 2; ++n) acc[a][b][m][n] = (f32x4){0.f, 0.f, 0.f, 0.f};
        cur = nxt; cA = nA; cB = nB; ++ui;
        if constexpr (ALIGN_EPI) { if (wr == 1) PG8_BAR; }
    }
    PG8_WAIT_V(0);
    if constexpr (!ALIGN_EPI) { if (wr == 0) PG8_BAR; }
    PG8_BAR;
#undef PG8_SA
#undef PG8_SB
#undef PG8_STAGE
#undef PG8_LDA
#undef PG8_LDB
#undef PG8_MMA
#undef PG8_WAIT_V
#undef PG8_WAIT_L
#undef PG8_BAR
#undef PG8_SCHED
}
}

struct EpiP1 {
    static constexpr bool PERM = true, AFTER_DRAIN = false;
    bf16_t* P1; const float* rstd;
    __device__ __forceinline__ void operator()(const f32x4 (&acc)[2][2][4][2], const pg8::Unit& u, int wr, int wc, int fr, int fq) const {
#pragma unroll
        for (int ai = 0; ai < 2; ++ai)
#pragma unroll
            for (int m = 0; m < 4; ++m) {
                const int row = u.pm * 256 + ai * 128 + wr * 64 + m * 16 + fr;
                const float rs = rstd[row];
                const size_t prow = (size_t)(row >> 13) * LP + NMETA + (row & (SEQ - 1));
                bf16_t* rowp = P1 + prow * P1W + u.pn * 256 + wc * 32 + 8 * fq;
#pragma unroll
                for (int bj = 0; bj < 2; ++bj) { const f32x4 v0 = acc[ai][bj][m][0] * rs, v1 = acc[ai][bj][m][1] * rs;
                    u32x4 w; w.x = pk2(v0[0], v0[1]); w.y = pk2(v0[2], v0[3]); w.z = pk2(v1[0], v1[1]); w.w = pk2(v1[2], v1[3]);
                    *(u32x4*)(rowp + bj * 128) = w; } }
    }
};
struct EpiRes {
    static constexpr bool PERM = false, AFTER_DRAIN = false;
    const float* x; float* out; bf16_t* hb; float* ssqp;
    __device__ __forceinline__ void operator()(const f32x4 (&acc)[2][2][4][2], const pg8::Unit& u, int wr, int wc, int fr, int fq) const {
#pragma unroll
        for (int ai = 0; ai < 2; ++ai)
#pragma unroll
            for (int m = 0; m < 4; ++m) {
                const int row = u.pm * 256 + ai * 128 + wr * 64 + m * 16 + fr;
                const size_t off = (size_t)row * DMODEL + u.pn * 256 + wc * 32 + 4 * fq;
                float ss = 0.f;
#pragma unroll
                for (int bj = 0; bj < 2; ++bj)
#pragma unroll
                    for (int n = 0; n < 2; ++n) { const f32x4 hv = *(const f32x4*)(x + off + bj * 128 + n * 16) + acc[ai][bj][m][n];
                        u32x2 wv; wv.x = pk2(hv[0], hv[1]); wv.y = pk2(hv[2], hv[3]); *(u32x2*)(hb + off + bj * 128 + n * 16) = wv;
                        ss = __builtin_fmaf(hv[0], hv[0], ss); ss = __builtin_fmaf(hv[1], hv[1], ss); ss = __builtin_fmaf(hv[2], hv[2], ss); ss = __builtin_fmaf(hv[3], hv[3], ss); }
                ss += __shfl_xor(ss, 16); ss += __shfl_xor(ss, 32);
                if (fq == 0) ssqp[(size_t)row * 16 + u.pn * 4 + wc] = ss;
            }
    }
};
struct EpiPlain {
    static constexpr bool PERM = true, AFTER_DRAIN = false;
    bf16_t* O; int ldc;
    __device__ __forceinline__ void operator()(const f32x4 (&acc)[2][2][4][2], const pg8::Unit& u, int wr, int wc, int fr, int fq) const {
#pragma unroll
        for (int ai = 0; ai < 2; ++ai)
#pragma unroll
            for (int m = 0; m < 4; ++m) {
                bf16_t* rowp = O + (size_t)(u.pm * 256 + ai * 128 + wr * 64 + m * 16 + fr) * ldc + u.pn * 256 + wc * 32 + 8 * fq;
#pragma unroll
                for (int bj = 0; bj < 2; ++bj) { const f32x4 v0 = acc[ai][bj][m][0], v1 = acc[ai][bj][m][1];
                    u32x4 w; w.x = pk2(v0[0], v0[1]); w.y = pk2(v0[2], v0[3]); w.z = pk2(v1[0], v1[1]); w.w = pk2(v1[2], v1[3]);
                    *(u32x4*)(rowp + bj * 128) = w; } }
    }
};

#define XB_TMO      128
#define XB_XCNT(j)  (256  + 64 * (j))
#define XB_XSUB(j)  (1280 + 64 * (j))
#define XB_XGEN(j)  (2304 + 64 * (j))
#define XB_TOP      3328
#define XB_TOPGEN   3392
#define XCD_BAR_WORDS 3456
#define XB_SPIN_CAP (1u << 18)
__device__ __forceinline__ unsigned xb_ld(unsigned* p)              { return __hip_atomic_load(p, __ATOMIC_RELAXED, __HIP_MEMORY_SCOPE_AGENT); }
__device__ __forceinline__ unsigned xb_add(unsigned* p, unsigned v) { return __hip_atomic_fetch_add(p, v, __ATOMIC_RELAXED, __HIP_MEMORY_SCOPE_AGENT); }
__device__ __forceinline__ unsigned xb_xcc_id() { return (unsigned)__builtin_amdgcn_s_getreg((3 << 11) | 20) & 0xFu; }
#define XB_SPIN(cond, bar) do { unsigned _sp = 0; while (cond) { __builtin_amdgcn_s_sleep(1); \
    if ((++_sp & 255u) == 0u) { if (xb_ld(&(bar)[XB_TMO])) break; if (_sp > XB_SPIN_CAP) { atomicAdd(&(bar)[XB_TMO], 1u); break; } } } } while (0)
struct XcdBarrier { unsigned* bar; unsigned x; volatile LAS unsigned* st; };
__device__ __forceinline__ XcdBarrier xcd_barrier_post(unsigned* bar, volatile LAS unsigned* st) {
    XcdBarrier b; b.bar = bar; b.x = xb_xcc_id(); b.st = st;
    if (threadIdx.x == 0) (void)xb_add(&bar[XB_XCNT(b.x)], 1u);
    return b;
}
__device__ __forceinline__ void xcd_barrier_complete(unsigned* bar, unsigned x, unsigned& nloc, unsigned& nx) {
    const unsigned G = gridDim.x * gridDim.y * gridDim.z;
    unsigned sum, cnt, mine, sp = 0u;
    for (;;) {
        sum = 0u; cnt = 0u; mine = 0u;
#pragma unroll
        for (unsigned j = 0; j < 16; ++j) { const unsigned c = xb_ld(&bar[XB_XCNT(j)]); sum += c; cnt += (c > 0u) ? 1u : 0u; mine = (j == x) ? c : mine; }
        if (sum == G) break;
        __builtin_amdgcn_s_sleep(1);
        if ((++sp & 255u) == 0u) { if (xb_ld(&bar[XB_TMO])) break; if (sp > XB_SPIN_CAP) { atomicAdd(&bar[XB_TMO], 1u); break; } }
    }
    nloc = mine > 0u ? mine : 1u; nx = cnt > 0u ? cnt : 1u;
}
__device__ __forceinline__ void xcd_barrier(const XcdBarrier& b) {
    asm volatile("s_waitcnt vmcnt(0)" ::: "memory");
    __syncthreads();
    if (threadIdx.x == 0) {
        unsigned* bar = b.bar;
        __builtin_amdgcn_s_waitcnt(0);
        unsigned nloc = b.st[0], nx = b.st[1];
        if (nloc == 0u) { xcd_barrier_complete(bar, b.x, nloc, nx); b.st[0] = nloc; b.st[1] = nx; }
        const unsigned old = xb_add(&bar[XB_XSUB(b.x)], 1u);
        const unsigned gen = old / nloc;
        if (old + 1u == (gen + 1u) * nloc) {
            __builtin_amdgcn_fence(__ATOMIC_RELEASE, "agent");
            asm volatile("s_waitcnt vmcnt(0)" ::: "memory");
            const unsigned og = xb_add(&bar[XB_TOP], 1u);
            const unsigned tg = og / nx;
            if (og + 1u == (tg + 1u) * nx) xb_add(&bar[XB_TOPGEN], 1u);
            else XB_SPIN(xb_ld(&bar[XB_TOPGEN]) == tg, bar);
            __builtin_amdgcn_fence(__ATOMIC_ACQUIRE, "agent");
            xb_add(&bar[XB_XGEN(b.x)], 1u);
            asm volatile("s_waitcnt vmcnt(0)" ::: "memory");
        } else {
            XB_SPIN(xb_ld(&bar[XB_XGEN(b.x)]) == gen, bar);
            __builtin_amdgcn_fence(__ATOMIC_ACQUIRE, "agent");
            asm volatile("s_waitcnt vmcnt(0)" ::: "memory");
        }
    }
    __syncthreads();
}

struct Args { const float* in[24]; float* out; unsigned char* ws; int ph_lo, ph_hi; };
struct Frame {
    lds_ptr lds; int tid, lane, wave, G, gw, ngw;
    float* out; unsigned char* ws;
};
enum { I_X = 0, I_META, I_RELB, I_ANORM, I_WIN, I_QNORM, I_WUQ, I_KVNORM, I_WUKV, I_QKNQ, I_QKNK, I_DQN, I_DKN, I_LQ1, I_LK1, I_LQ2, I_LK2, I_SUBLN, I_WOUT, I_FNORM, I_WPQ, I_SUBK, I_PU, I_PV };

__device__ __forceinline__ void transpose_item(const float* W, int ldw, int c0, int K, int N, const float* gain, bf16_t* WT, int row_off, LAS float* scr, int item, int lane) {
    const int nblk = N / 32, kb = item / nblk, nb = item % nblk, k0 = 64 * kb, n0 = 32 * nb;
#pragma unroll 8
    for (int i = 0; i < 32; ++i) { const int kk = 2 * i + (lane >> 5); float v = W[(size_t)(k0 + kk) * ldw + c0 + n0 + (lane & 31)]; if (gain) v *= gain[k0 + kk]; scr[kk * 33 + (lane & 31)] = v; }
    LDS_WAIT(); asm volatile("" ::: "memory");
    const int c = lane & 7;
#pragma unroll
    for (int j = 0; j < 4; ++j) { const int n = (lane >> 3) + 8 * j; const LAS float* s = scr + (8 * c) * 33 + n;
        u32x4 o; o.x = pk2(s[0 * 33], s[1 * 33]); o.y = pk2(s[2 * 33], s[3 * 33]); o.z = pk2(s[4 * 33], s[5 * 33]); o.w = pk2(s[6 * 33], s[7 * 33]);
        *(u32x4*)(WT + (size_t)(row_off + n0 + n) * K + k0 + 8 * c) = o; }
    LDS_WAIT(); asm volatile("" ::: "memory");
}
__device__ __forceinline__ void cvt_row_1024(const float* src, bf16_t* dst, int lane) {
    const f32x4* xr = (const f32x4*)src + lane; f32x4 v[4];
#pragma unroll
    for (int j = 0; j < 4; ++j) v[j] = xr[64 * j];
    u32x2* o8 = (u32x2*)dst + lane;
#pragma unroll
    for (int j = 0; j < 4; ++j) { u32x2 w; w.x = pk2(v[j][0], v[j][1]); w.y = pk2(v[j][2], v[j][3]); o8[64 * j] = w; }
}
__device__ __forceinline__ float cvt_row_1024_ssq(const float* src, bf16_t* dst, int lane) {
    const f32x4* xr = (const f32x4*)src + lane; f32x4 v[4]; float s = 0.f;
#pragma unroll
    for (int j = 0; j < 4; ++j) { v[j] = xr[64 * j]; s += (v[j][0] * v[j][0] + v[j][1] * v[j][1]) + (v[j][2] * v[j][2] + v[j][3] * v[j][3]); }
    u32x2* o8 = (u32x2*)dst + lane;
#pragma unroll
    for (int j = 0; j < 4; ++j) { u32x2 w; w.x = pk2(v[j][0], v[j][1]); w.y = pk2(v[j][2], v[j][3]); o8[64 * j] = w; }
    return wave_sum(s);
}
__device__ __forceinline__ float quant_f32x4x4(const f32x4 (&v)[4], unsigned* dst, int off, int lane) {
    float am = 0.f;
#pragma unroll
    for (int j = 0; j < 4; ++j) am = fmaxf(fmaxf(am, fmaxf(fabsf(v[j][0]), fabsf(v[j][1]))), fmaxf(fabsf(v[j][2]), fabsf(v[j][3])));
#pragma unroll
    for (int o = 1; o < 64; o <<= 1) am = fmaxf(am, __shfl_xor(am, o));
    const float inv = am > 0.f ? 127.0f / am : 0.f;
#pragma unroll
    for (int j = 0; j < 4; ++j) { unsigned w = 0u;
#pragma unroll
        for (int i = 0; i < 4; ++i) { const int q = (int)__builtin_rintf(v[j][i] * inv) + off; w |= ((unsigned)q & 255u) << (8 * i); }
        dst[lane + 64 * j] = w; }
    return am * (1.0f / 127.0f);
}
__device__ __forceinline__ float quant_row_1024_fp8(const float* src, unsigned* dst, int lane) {
    const f32x4* xr = (const f32x4*)src + lane; f32x4 v[4]; float am = 0.f;
#pragma unroll
    for (int j = 0; j < 4; ++j) { v[j] = xr[64 * j]; am = fmaxf(fmaxf(am, fmaxf(fabsf(v[j][0]), fabsf(v[j][1]))), fmaxf(fabsf(v[j][2]), fabsf(v[j][3]))); }
#pragma unroll
    for (int o = 1; o < 64; o <<= 1) am = fmaxf(am, __shfl_xor(am, o));
    const float inv = am > 0.f ? 440.0f / am : 0.f;
#pragma unroll
    for (int j = 0; j < 4; ++j) { int w = __builtin_amdgcn_cvt_pk_fp8_f32(v[j][0] * inv, v[j][1] * inv, 0, false); w = __builtin_amdgcn_cvt_pk_fp8_f32(v[j][2] * inv, v[j][3] * inv, w, true); dst[lane + 64 * j] = (unsigned)w; }
    return am * (1.0f / 440.0f);
}
__device__ __forceinline__ float quant_row_1024(const float* src, unsigned* dst, int off, int lane) {
    const f32x4* xr = (const f32x4*)src + lane; f32x4 v[4];
#pragma unroll
    for (int j = 0; j < 4; ++j) v[j] = xr[64 * j];
    return quant_f32x4x4(v, dst, off, lane);
}
__device__ __forceinline__ void zero_bytes_wave(unsigned char* p, int nbytes, int lane) {
    for (int o = lane * 16; o < nbytes; o += 1024) *(u32x4*)(p + o) = (u32x4){0u, 0u, 0u, 0u};
}
__device__ __forceinline__ void quant_expert_tables(Frame& F, const Args& A) {
    unsigned char* ws = F.ws; const int gw = F.gw, NGW = F.ngw, lane = F.lane;
    { signed char* U8 = (signed char*)(ws + WS_U8); unsigned char* V8 = (unsigned char*)(ws + WS_V8); float* SU = (float*)(ws + WS_SU); float* SV = (float*)(ws + WS_SV);
      for (int it = gw; it < 32768; it += NGW) { const bool isv = it >= 16384; const int e = isv ? it - 16384 : it;
          const float* src = (isv ? A.in[I_PV] : A.in[I_PU]) + (size_t)e * 1024; unsigned* dst = (unsigned*)((isv ? (unsigned char*)V8 : (unsigned char*)U8) + (size_t)e * 1024);
          const float sc = isv ? quant_row_1024_fp8(src, dst, lane) : quant_row_1024(src, dst, 0, lane); if (lane == 0) (isv ? SV : SU)[e] = sc; } }
}
__device__ __forceinline__ void p0_prologue(Frame& F, const Args& A) {
    LAS float* scr = (LAS float*)(F.lds + F.wave * 16384);
    const int gw = F.gw, NGW = F.ngw, lane = F.lane;
    unsigned char* ws = F.ws;
    bf16_t* W1T = (bf16_t*)(ws + WS_W1T); bf16_t* WKR = (bf16_t*)(ws + WS_WKR); bf16_t* WUQ = (bf16_t*)(ws + WS_WUQ); bf16_t* WUKV = (bf16_t*)(ws + WS_WUKV);
    bf16_t* WOUT = (bf16_t*)(ws + WS_WOUT); bf16_t* WPQ = (bf16_t*)(ws + WS_WPQ); bf16_t* SK = (bf16_t*)(ws + WS_SK);
    constexpr int I_A = 16 * 16, I_B = 16 * 48, I_C = 16 * 1, I_D = 4 * 24, I_E = 4 * 32, I_F = 16 * 32, I_G = 16 * 64;
    constexpr int NITEMS = I_A + I_B + I_C + I_D + I_E + I_F + I_G;
    for (int it = gw; it < NITEMS; it += NGW) {
        int r = it;
        if (r < I_A) { transpose_item(A.in[I_WIN], 2080, 0, 1024, 512, A.in[I_ANORM], W1T, 0, scr, r, lane); continue; } r -= I_A;
        if (r < I_B) { transpose_item(A.in[I_WIN], 2080, 544, 1024, 1536, A.in[I_ANORM], W1T, 512, scr, r, lane); continue; } r -= I_B;
        if (r < I_C) { transpose_item(A.in[I_WIN], 2080, 512, 1024, 32, A.in[I_ANORM], WKR, 0, scr, r, lane); continue; } r -= I_C;
        if (r < I_D) { transpose_item(A.in[I_WUQ], 768, 0, 256, 768, A.in[I_QNORM], WUQ, 0, scr, r, lane); continue; } r -= I_D;
        if (r < I_E) { transpose_item(A.in[I_WUKV], 1024, 0, 256, 1024, A.in[I_KVNORM], WUKV, 0, scr, r, lane); continue; } r -= I_E;
        if (r < I_F) { transpose_item(A.in[I_WOUT], 1024, 0, 1024, 1024, nullptr, WOUT, 0, scr, r, lane); continue; } r -= I_F;
        transpose_item(A.in[I_WPQ], 2048, 0, 1024, 2048, A.in[I_FNORM], WPQ, 0, scr, r, lane);
    }
    for (int it = gw; it < 256; it += NGW) cvt_row_1024(A.in[I_SUBK] + (size_t)it * 1024, SK + (size_t)it * 1024, lane);
    { bf16_t* XB = (bf16_t*)(ws + WS_XB); float* RS = (float*)(ws + WS_RSTD1);
      for (int it = gw; it < XB_ROWS; it += NGW) {
          if (it < XB_ZERO) { const float* src = it < MTOK ? A.in[I_X] + (size_t)it * 1024 : A.in[I_META] + (size_t)(it - MTOK) * 1024;
              const float ss = cvt_row_1024_ssq(src, XB + (size_t)it * 1024, lane); if (lane == 0) RS[it] = 1.0f / sqrtf(ss * (1.0f / 1024.0f) + EPS); }
          else { zero_bytes_wave((unsigned char*)(XB + (size_t)it * 1024), 2048, lane); if (lane == 0) RS[it] = 0.f; } } }
    { bf16_t* P1 = (bf16_t*)(ws + WS_P1); bf16_t* KM = (bf16_t*)(ws + WS_KM); bf16_t* VM = (bf16_t*)(ws + WS_VM);
      for (int it = gw; it < BATCH * (LP - LREAL); it += NGW) { const size_t prow = (size_t)(it / (LP - LREAL)) * LP + LREAL + (it % (LP - LREAL));
          zero_bytes_wave((unsigned char*)(P1 + prow * P1W), P1W * 2, lane); zero_bytes_wave((unsigned char*)(KM + prow * 768), 768 * 2, lane);
          zero_bytes_wave((unsigned char*)(VM + prow * 512), 512 * 2, lane); } }
}

__device__ __forceinline__ void p1_meta_tile(Frame& F, int c) {
    const int lane = F.lane, r32 = lane & 31, hi = lane >> 5;
    const bf16_t* W1T = (const bf16_t*)(F.ws + WS_W1T); const bf16_t* XB = (const bf16_t*)(F.ws + WS_XB); const float* RS = (const float*)(F.ws + WS_RSTD1);
    const int xrow = r32 < NMETA ? XB_META + r32 : XB_ZERO;
    const bf16_t* ap = W1T + (size_t)(32 * c + r32) * 1024 + 8 * hi; const bf16_t* bp = XB + (size_t)xrow * 1024 + 8 * hi;
    f32x16 acc = zero16();
#pragma unroll 8
    for (int s = 0; s < 64; ++s) acc = MFMA32(ld_frag(ap + 16 * s), ld_frag(bp + 16 * s), acc);
    const float rs = RS[xrow];
    bf16_t* P1 = (bf16_t*)(F.ws + WS_P1);
    if (r32 < NMETA) {
#pragma unroll
        for (int g = 0; g < 4; ++g) { u32x2 w; w.x = pk2(acc[4 * g] * rs, acc[4 * g + 1] * rs); w.y = pk2(acc[4 * g + 2] * rs, acc[4 * g + 3] * rs);
#pragma unroll
            for (int b = 0; b < BATCH; ++b) *(u32x2*)(P1 + ((size_t)b * LP + r32) * P1W + 32 * c + 8 * g + 4 * hi) = w; }
    }
}

__device__ __forceinline__ void rope_tables(int pos, int hi, float (&cs)[8], float (&sn)[8]) {
#pragma unroll
    for (int r = 0; r < 8; ++r) { const int i = (r & 3) + 8 * (r >> 2) + 4 * hi;
        const double turns = (double)pos * ROPE_INVF[i] * 0.15915494309189535; const float fr = (float)(turns - __builtin_rint(turns));
        sn[r] = __builtin_amdgcn_sinf(fr); cs[r] = __builtin_amdgcn_cosf(fr); }
}
__device__ __forceinline__ void store4(bf16_t* p, float a, float b, float c, float d) { u32x2 w; w.x = pk2(a, b); w.y = pk2(c, d); *(u32x2*)p = w; }

__device__ __forceinline__ void glds16(const void* gsrc, unsigned lds_dst) { unsigned keep;
    asm volatile("s_mov_b32 %0, m0\n\ts_mov_b32 m0, %2\n\ts_nop 0\n\tglobal_load_lds_dwordx4 %1, off\n\ts_mov_b32 m0, %0" : "=&s"(keep) : "v"(gsrc), "s"(lds_dst) : "memory"); }

template <bool KV>
__device__ __forceinline__ void p2_block(Frame& F, int bj, LAS const float* tab) {
    constexpr int NR = KV ? 128 : 96, NCH = NR * 32 / NTHREADS;
    int tid_o = F.tid; asm volatile("" : "+v"(tid_o));
    const int tid = tid_o, lane = tid & 63, r32 = lane & 31, hi = lane >> 5, w = F.wave;
    const int pb = bj * 8 + w; const bool active = (pb < MP / 32) && ((pb % (LP / 32)) != (LP / 32) - 1);
    const size_t prow0 = (size_t)(active ? pb : 0) * 32, prow = prow0 + r32; const int b = (int)(prow / LP), pos = (int)(prow % LP);
    bf16_t* P1 = (bf16_t*)(F.ws + WS_P1);
    const bf16_t* W = (const bf16_t*)(F.ws + (KV ? WS_WUKV : WS_WUQ));
    const lds_ptr lds = F.lds;
    const unsigned lds0 = (unsigned)(size_t)F.lds;
    constexpr int NDI = NR / 2 / NWAVES;
#define P2_WDMA(h, buf) do { _Pragma("unroll") for (int i_ = 0; i_ < NDI; ++i_) { const int row_ = 2 * (w * NDI + i_) + (lane >> 5); \
        glds16(W + ((size_t)(h) * NR + row_) * 256 + (((lane & 31) ^ (row_ & 31)) * 8), (unsigned)__builtin_amdgcn_readfirstlane((int)(lds0 + (buf) * 65536 + (w * NDI + i_) * 1024))); } } while (0)
#define P2_WAIT_BAR() asm volatile("s_waitcnt vmcnt(0) lgkmcnt(0)\n\ts_barrier" ::: "memory")
#define P2_AFRAG(buf, t, s) (*(const LAS bf16x8*)(lds + (buf) * 65536 + ((t) * 32 + r32o) * 512 + (((2 * (s) + hio) ^ r32o) * 16)))
    __syncthreads();
    if (KV) { const bf16_t* WKR = (const bf16_t*)(F.ws + WS_WKR);
#pragma unroll
        for (int i = 0; i < 8; ++i) { const int hr = w * 8 + i, row = hr >> 1, slot = (hr & 1) * 64 + lane;
            glds16(WKR + (size_t)row * 1024 + ((slot ^ (row & 31)) * 8), (unsigned)__builtin_amdgcn_readfirstlane((int)(lds0 + 65536 + hr * 1024))); }
    }
    P2_WDMA(0, 0);
    bf16x8 cf[16]; float ss = 0.f;
#pragma unroll
    for (int s = 0; s < 16; ++s) { const u32x4 wv = *(const u32x4*)(P1 + prow * P1W + (KV ? C_CKV : C_CQ) + 16 * s + 8 * hi); ss += ssq8(wv); cf[s] = __builtin_bit_cast(bf16x8, wv); }
    const float rstd_c = 1.0f / sqrtf(xhalf_sum(ss) * (1.0f / 256.0f) + EPS);
    float cs[8], sn[8]; rope_tables(pos, hi, cs, sn);
    f32x16 kr = zero16(); float krss = 0.f;
    if (KV) {
        const bf16_t* WKR = (const bf16_t*)(F.ws + WS_WKR); const bf16_t* XB = (const bf16_t*)(F.ws + WS_XB); const float* RS = (const float*)(F.ws + WS_RSTD1);
        P2_WAIT_BAR();
        const int xrow = pos < NMETA ? XB_META + pos : (pos < LREAL ? b * SEQ + pos - NMETA : XB_ZERO);
        const bf16_t* bp = XB + (size_t)xrow * 1024 + 8 * hi;
#pragma unroll 8
        for (int s = 0; s < 64; ++s) kr = MFMA32(*(const LAS bf16x8*)(lds + 65536 + r32 * 2048 + (((2 * s + hi) ^ r32) * 16)), ld_frag(bp + 16 * s), kr);
        const float rs1 = RS[xrow];
#pragma unroll
        for (int r = 0; r < 16; ++r) { kr[r] *= rs1; krss = __builtin_fmaf(kr[r], kr[r], krss); }
        __syncthreads();
    } else {
        P2_WAIT_BAR();
    }
    bf16_t* QM = (bf16_t*)(F.ws + WS_QM); bf16_t* KM = (bf16_t*)(F.ws + WS_KM); bf16_t* VM = (bf16_t*)(F.ws + WS_VM);
#pragma unroll 1
    for (int h = 0; h < 8; ++h) {
        const int buf = h & 1;
        int r32o = r32, hio = hi; size_t prowo = prow; asm volatile("" : "+v"(r32o), "+v"(hio), "+v"(prowo));
        if (h + 1 < 8) P2_WDMA(h + 1, buf ^ 1);
        if (active) {
            if (!KV) {
                f32x16 acc[3];
#pragma unroll
                for (int t = 0; t < 3; ++t) { acc[t] = zero16();
#pragma unroll
                    for (int s = 0; s < 16; ++s) { acc[t] = MFMA32(P2_AFRAG(buf, t, s), cf[s], acc[t]); if ((s & 3) == 3) __builtin_amdgcn_sched_barrier(0); } }
                float s2 = 0.f;
#pragma unroll
                for (int t = 0; t < 3; ++t)
#pragma unroll
                    for (int r = 0; r < 16; ++r) { acc[t][r] *= rstd_c; s2 = __builtin_fmaf(acc[t][r], acc[t][r], s2); }
                const float rn = 1.0f / sqrtf(xhalf_sum(s2) * (1.0f / 96.0f) + EPS);
#pragma unroll
                for (int t = 0; t < 3; ++t)
#pragma unroll
                    for (int g = 0; g < 4; ++g) { const f32x4 gn = *(LAS const f32x4*)(tab + t * 32 + 8 * g + 4 * hio);
#pragma unroll
                        for (int j = 0; j < 4; ++j) acc[t][4 * g + j] *= rn * gn[j]; }
#pragma unroll
                for (int r = 0; r < 8; ++r) { const float x1 = acc[2][r], x2 = acc[2][r + 8]; acc[2][r] = x1 * cs[r] - x2 * sn[r]; acc[2][r + 8] = x1 * sn[r] + x2 * cs[r]; }
                bf16_t* qp = QM + prowo * 768 + h * 96 + 4 * hio;
#pragma unroll
                for (int t = 0; t < 3; ++t)
#pragma unroll
                    for (int g = 0; g < 4; ++g) store4(qp + t * 32 + 8 * g, acc[t][4 * g] * QS_MLA, acc[t][4 * g + 1] * QS_MLA, acc[t][4 * g + 2] * QS_MLA, acc[t][4 * g + 3] * QS_MLA);
            } else {
                {
                    f32x16 acc[2];
#pragma unroll
                    for (int t = 0; t < 2; ++t) { acc[t] = zero16();
#pragma unroll
                        for (int s = 0; s < 16; ++s) { acc[t] = MFMA32(P2_AFRAG(buf, t, s), cf[s], acc[t]); if ((s & 3) == 3) __builtin_amdgcn_sched_barrier(0); } }
                    float s2 = krss;
#pragma unroll
                    for (int t = 0; t < 2; ++t)
#pragma unroll
                        for (int r = 0; r < 16; ++r) { acc[t][r] *= rstd_c; s2 = __builtin_fmaf(acc[t][r], acc[t][r], s2); }
                    const float rn = 1.0f / sqrtf(xhalf_sum(s2) * (1.0f / 96.0f) + EPS);
                    bf16_t* kp = KM + prowo * 768 + h * 96 + 4 * hio;
#pragma unroll
                    for (int t = 0; t < 2; ++t)
#pragma unroll
                        for (int g = 0; g < 4; ++g) { const f32x4 gn = *(LAS const f32x4*)(tab + 96 + t * 32 + 8 * g + 4 * hio);
                            store4(kp + t * 32 + 8 * g, acc[t][4 * g] * rn * gn[0], acc[t][4 * g + 1] * rn * gn[1], acc[t][4 * g + 2] * rn * gn[2], acc[t][4 * g + 3] * rn * gn[3]); }
                    float kn[16];
#pragma unroll
                    for (int g = 0; g < 4; ++g) { const f32x4 gn = *(LAS const f32x4*)(tab + 96 + 64 + 8 * g + 4 * hio);
#pragma unroll
                        for (int j = 0; j < 4; ++j) kn[4 * g + j] = kr[4 * g + j] * rn * gn[j]; }
#pragma unroll
                    for (int r = 0; r < 8; ++r) { const float x1 = kn[r], x2 = kn[r + 8]; kn[r] = x1 * cs[r] - x2 * sn[r]; kn[r + 8] = x1 * sn[r] + x2 * cs[r]; }
#pragma unroll
                    for (int g = 0; g < 4; ++g) store4(kp + 64 + 8 * g, kn[4 * g], kn[4 * g + 1], kn[4 * g + 2], kn[4 * g + 3]);
                }
                {
                    f32x16 acc[2];
#pragma unroll
                    for (int t = 0; t < 2; ++t) { acc[t] = zero16();
#pragma unroll
                        for (int s = 0; s < 16; ++s) { acc[t] = MFMA32(P2_AFRAG(buf, 2 + t, s), cf[s], acc[t]); if ((s & 3) == 3) __builtin_amdgcn_sched_barrier(0); } }
                    bf16_t* vp = VM + prowo * 512 + h * 64 + 4 * hio;
#pragma unroll
                    for (int t = 0; t < 2; ++t)
#pragma unroll
                        for (int g = 0; g < 4; ++g) store4(vp + t * 32 + 8 * g, acc[t][4 * g] * rstd_c, acc[t][4 * g + 1] * rstd_c, acc[t][4 * g + 2] * rstd_c, acc[t][4 * g + 3] * rstd_c);
                }
            }
        }
        P2_WAIT_BAR();
    }
#undef P2_WDMA
#undef P2_WAIT_BAR
#undef P2_AFRAG
    if (!KV && active) {
        float gq[8], gk[8];
#pragma unroll
        for (int j = 0; j < 8; ++j) { gq[j] = tab[192 + (lane & 7) * 8 + j] * QS_DIFF; gk[j] = tab[256 + (lane & 7) * 8 + j]; }
#pragma unroll 4
        for (int rr = 0; rr < 32; ++rr) {
            bf16_t* qrow = P1 + (prow0 + rr) * P1W + C_DQ + lane * 8; bf16_t* krow = P1 + (prow0 + rr) * P1W + C_DK + lane * 8;
            const u32x4 wq = *(const u32x4*)qrow, wk = *(const u32x4*)krow;
            float sq = ssq8(wq), sk = ssq8(wk);
            sq += __shfl_xor(sq, 1); sk += __shfl_xor(sk, 1); sq += __shfl_xor(sq, 2); sk += __shfl_xor(sk, 2); sq += __shfl_xor(sq, 4); sk += __shfl_xor(sk, 4);
            const float rq = 1.0f / sqrtf(sq * (1.0f / 64.0f) + EPS), rk = 1.0f / sqrtf(sk * (1.0f / 64.0f) + EPS);
            u32x4 oq, ok;
#pragma unroll
            for (int i = 0; i < 4; ++i) { oq[i] = pk2(bf_lo(wq[i]) * rq * gq[2 * i], bf_hi(wq[i]) * rq * gq[2 * i + 1]); ok[i] = pk2(bf_lo(wk[i]) * rk * gk[2 * i], bf_hi(wk[i]) * rk * gk[2 * i + 1]); }
            *(u32x4*)qrow = oq; *(u32x4*)krow = ok;
        }
    }
}

template <bool DIFF, bool FIXED>
__device__ __forceinline__ void attn_unit(Frame& F, int b, int h, int qt, LAS const float* btab, float bref) {
    constexpr int NDS = DIFF ? 4 : 6;
    constexpr int NVB = DIFF ? 4 : 2;
    constexpr int QROWS = DIFF ? 128 : 256;
    constexpr int KCH = DIFF ? 16 : 12;
    constexpr int KBYTES = KCH * 1024, VBYTES = NVB * 4096, TILEB = KBYTES + VBYTES;
    int lane_o = F.lane; asm volatile("" : "+v"(lane_o));
    const int tid = F.tid, lane = lane_o, r32 = lane & 31, hi = lane >> 5, w = F.wave;
    const int map = DIFF ? (w >> 2) : 0, wq = DIFF ? (w & 3) : w;
    const bf16_t* Qg; const bf16_t* Kg; const bf16_t* Vg; int qpitch, kpitch, vpitch;
    if (DIFF) { const bf16_t* P1 = (const bf16_t*)(F.ws + WS_P1); Qg = P1 + C_DQ + h * 128 + map * 64; Kg = P1 + C_DK + h * 128; Vg = P1 + C_DV + h * 128; qpitch = kpitch = vpitch = P1W; }
    else { Qg = (const bf16_t*)(F.ws + WS_QM) + h * 96; Kg = (const bf16_t*)(F.ws + WS_KM) + h * 96; Vg = (const bf16_t*)(F.ws + WS_VM) + h * 64; qpitch = kpitch = 768; vpitch = 512; }
    const size_t brow = (size_t)b * LP;
    const int qpos0 = NMETA + qt * QROWS + wq * 32;
    const int qpos = qpos0 + r32;
    const int NT = (NMETA + qt * QROWS + QROWS + 63) >> 6;
    const int tlast = (qpos0 + 31) >> 6;
    bf16x8 qf[NDS];
#pragma unroll
    for (int d0 = 0; d0 < NDS; ++d0) qf[d0] = ld_frag(Qg + (brow + qpos) * qpitch + 16 * d0 + 8 * hi);
    __builtin_amdgcn_s_waitcnt(0x0F70);
#pragma unroll
    for (int d0 = 0; d0 < NDS; ++d0) asm volatile("" : "+v"(qf[d0]));
    constexpr int NPW = DIFF ? 4 : 3;
    const int kc1 = DIFF ? (w + 8) : (8 + (w & 3));
    const bf16_t* ksrc0 = Kg + (brow + lane) * kpitch + w * 8;
    const bf16_t* ksrc1 = Kg + (brow + lane) * kpitch + kc1 * 8;
    const bf16_t* vsrc0 = Vg + (brow + 16 * (w & 3) + (lane >> 2)) * vpitch + (w >> 2) * 32 + (lane & 3) * 8;
    const bf16_t* vsrc1 = Vg + (brow + 16 * (w & 3) + (lane >> 2)) * vpitch + ((w + 8) >> 2) * 32 + (lane & 3) * 8;
    const lds_ptr lds = F.lds; const unsigned lds0 = (unsigned)(size_t)F.lds;
    const int kdst0 = w * 1024, kdst1 = kc1 * 1024, vdst0 = KBYTES + w * 1024, vdst1 = KBYTES + (w + 8) * 1024;
    const int kbase = (DIFF ? map * 8192 : 0) + hi * 1024 + r32 * 16;
    const int vbase = KBYTES + ((lane >> 4) & 1) * 32 + (lane & 3) * 8 + (4 * hi + ((lane & 15) >> 2)) * 64;
#define ATT_GLDS(src, dst) glds16((src), (unsigned)__builtin_amdgcn_readfirstlane((int)(lds0 + (unsigned)(dst))))
#define ATT_DMA(t, so) do { const size_t to_ = (size_t)(t) * 64; ATT_GLDS(ksrc0 + to_ * kpitch, (so) + kdst0); ATT_GLDS(ksrc1 + to_ * kpitch, (so) + kdst1); \
        ATT_GLDS(vsrc0 + to_ * vpitch, (so) + vdst0); if (DIFF) ATT_GLDS(vsrc1 + to_ * vpitch, (so) + vdst1); } while (0)
#define ATT_WAIT_BAR(n) asm volatile("s_waitcnt vmcnt(" #n ") lgkmcnt(0)\n\ts_barrier" ::: "memory")
    float m_run = FIXED ? bref : 0.f, l_run = 0.f; f32x16 o[NVB];
#pragma unroll
    for (int v = 0; v < NVB; ++v) o[v] = zero16();
    const float bfar = DIFF ? btab[512 + h] : 0.f;
    f32x16 cini;
#pragma unroll
    for (int r = 0; r < 16; ++r) cini[r] = bfar - m_run;
    const bool grpB = (w >= 4);
    __syncthreads();
    ATT_DMA(0, 0); ATT_DMA(1, TILEB);
    if (DIFF) ATT_WAIT_BAR(4); else ATT_WAIT_BAR(3);
    int so_cur = 0, so_nn = 2 * TILEB;
    for (int t = 0; t < NT; ++t) {
        if (t + 2 < NT) ATT_DMA(t + 2, so_nn);
        const bool act = (t <= tlast);
        bf16x8 pa[4]; s16x4 vlo[2][NVB], vhi[2][NVB];
        if (act) {
            const lds_cptr kp = (lds_cptr)lds + so_cur + kbase;
            f32x16 p0, p1;
            bf16x8 kf0[NDS], kf1[NDS];
#pragma unroll
            for (int d0 = 0; d0 < NDS; ++d0) { kf0[d0] = *(const LAS bf16x8*)(kp + d0 * 2048); kf1[d0] = *(const LAS bf16x8*)(kp + d0 * 2048 + 512); }
            __builtin_amdgcn_sched_barrier(0);
            const int kpos0 = 64 * t + 4 * hi;
            if (DIFF && !(qpos0 - (64 * t + 63) >= 113)) {
                LAS const float* bt = btab + h * 128;
#pragma unroll
                for (int r = 0; r < 16; ++r) { const int d0_ = qpos - (kpos0 + (r & 3) + 8 * (r >> 2)); const int d1_ = d0_ - 32;
                    p0[r] = bt[min(max(d0_, 0), 127)] - m_run; p1[r] = bt[min(max(d1_, 0), 127)] - m_run; }
            } else { p0 = cini; p1 = cini; }
#pragma unroll
            for (int d0 = 0; d0 < NDS; ++d0) { p0 = MFMA32(kf0[d0], qf[d0], p0); p1 = MFMA32(kf1[d0], qf[d0], p1); }
            if (64 * t + 63 > qpos0) {
#pragma unroll
                for (int r = 0; r < 16; ++r) { const int kv = kpos0 + (r & 3) + 8 * (r >> 2); if (kv > qpos) p0[r] = -INFINITY; if (kv + 32 > qpos) p1[r] = -INFINITY; }
            }
            if (!FIXED) {
            float mx;
            { float a_ = fmaxf(fmaxf(p0[0], p0[1]), p1[0]), b_ = fmaxf(fmaxf(p0[2], p0[3]), p1[1]); a_ = fmaxf(fmaxf(a_, p1[2]), p1[3]);
#pragma unroll
              for (int r = 4; r < 16; r += 4) { a_ = fmaxf(fmaxf(a_, p0[r]), p0[r + 1]); b_ = fmaxf(fmaxf(b_, p0[r + 2]), p0[r + 3]); a_ = fmaxf(fmaxf(a_, p1[r]), p1[r + 1]); b_ = fmaxf(fmaxf(b_, p1[r + 2]), p1[r + 3]); }
              const float m_ = fmaxf(a_, b_); auto rr = __builtin_amdgcn_permlane32_swap(__float_as_uint(m_), __float_as_uint(m_), false, false);
              mx = fmaxf(__uint_as_float(rr[0]), __uint_as_float(rr[1])); }
            if (t == 0 || __any(mx > SM_THR)) {
                const float dl = (t == 0) ? mx : fmaxf(mx, 0.f); const float al = (t == 0) ? 0.f : __builtin_amdgcn_exp2f(-dl);
                m_run += dl; l_run *= al;
#pragma unroll
                for (int v = 0; v < NVB; ++v)
#pragma unroll
                    for (int r = 0; r < 16; ++r) o[v][r] *= al;
#pragma unroll
                for (int r = 0; r < 16; ++r) { p0[r] -= dl; p1[r] -= dl; cini[r] = bfar - m_run; }
            }
            }
            { const lds_cptr vp = (lds_cptr)lds + so_cur + vbase;
#pragma unroll
              for (int v = 0; v < NVB; ++v) { vlo[0][v] = vtr(vp + v * 4096); vhi[0][v] = vtr(vp + v * 4096 + 512); } }
            __builtin_amdgcn_sched_barrier(0);
            float ls = 0.f;
#pragma unroll
            for (int r = 0; r < 16; ++r) { p0[r] = __builtin_amdgcn_exp2f(p0[r]); p1[r] = __builtin_amdgcn_exp2f(p1[r]); ls += p0[r] + p1[r]; }
            l_run += ls;
            { u32x4 a0, a1, a2, a3;
#pragma unroll
              for (int i = 0; i < 4; ++i) { a0[i] = pk2(p0[2 * i], p0[2 * i + 1]); a1[i] = pk2(p0[8 + 2 * i], p0[9 + 2 * i]); a2[i] = pk2(p1[2 * i], p1[2 * i + 1]); a3[i] = pk2(p1[8 + 2 * i], p1[9 + 2 * i]); }
              pa[0] = __builtin_bit_cast(bf16x8, a0); pa[1] = __builtin_bit_cast(bf16x8, a1); pa[2] = __builtin_bit_cast(bf16x8, a2); pa[3] = __builtin_bit_cast(bf16x8, a3); }
        }
        if (grpB) { if (t + 2 < NT) { if (DIFF) ATT_WAIT_BAR(4); else ATT_WAIT_BAR(3); } else ATT_WAIT_BAR(0); }
        if (act) {
            const lds_cptr vp = (lds_cptr)lds + so_cur + vbase;
#pragma unroll
            for (int s = 0; s < 4; ++s) {
                if (s < 3) {
#pragma unroll
                    for (int v = 0; v < NVB; ++v) { vlo[(s + 1) & 1][v] = vtr(vp + v * 4096 + (s + 1) * 1024); vhi[(s + 1) & 1][v] = vtr(vp + v * 4096 + (s + 1) * 1024 + 512); }
                }
                __builtin_amdgcn_sched_barrier(0);
#pragma unroll
                for (int v = 0; v < NVB; ++v) { const s16x4 lo = vlo[s & 1][v], hi4 = vhi[s & 1][v];
                    const bf16x8 vf = (bf16x8){lo[0], lo[1], lo[2], lo[3], hi4[0], hi4[1], hi4[2], hi4[3]};
                    o[v] = MFMA32(vf, pa[s], o[v]); }
                __builtin_amdgcn_sched_barrier(0);
            }
        }
        if (!grpB) { if (t + 2 < NT) { if (DIFF) ATT_WAIT_BAR(4); else ATT_WAIT_BAR(3); } else ATT_WAIT_BAR(0); }
        so_nn = (so_nn == 3 * TILEB) ? 0 : so_nn + TILEB; so_cur = (so_cur == 3 * TILEB) ? 0 : so_cur + TILEB;
    }
    __syncthreads();
#undef ATT_GLDS
#undef ATT_DMA
#undef ATT_WAIT_BAR
    const float inv = 1.0f / xhalf_sum(l_run);
    const int tok = b * SEQ + (qpos - NMETA);
    bf16_t* Y = (bf16_t*)(F.ws + WS_Y);
    if (!DIFF) {
        bf16_t* yp = Y + (size_t)tok * 1024 + h * 64 + 4 * hi;
#pragma unroll
        for (int v = 0; v < NVB; ++v)
#pragma unroll
            for (int g = 0; g < 4; ++g) { const float z_ = PROBE_ZERO_MLA ? 0.f : inv; store4(yp + v * 32 + 8 * g, o[v][4 * g] * z_, o[v][4 * g + 1] * z_, o[v][4 * g + 2] * z_, o[v][4 * g + 3] * z_); }
    } else {
        LAS float* xch = (LAS float*)lds + (size_t)wq * 4096 + lane;
        if (map == 1) {
#pragma unroll
            for (int v = 0; v < NVB; ++v)
#pragma unroll
                for (int r = 0; r < 16; ++r) xch[(v * 16 + r) * 64] = o[v][r] * inv;
        }
        __syncthreads();
        if (map == 0) {
            const float lam = btab[516]; float s2 = 0.f;
#pragma unroll
            for (int v = 0; v < NVB; ++v)
#pragma unroll
                for (int r = 0; r < 16; ++r) { const float d = o[v][r] * inv - lam * xch[(v * 16 + r) * 64]; o[v][r] = d; s2 += d * d; }
            const float rn = (1.0f - LAMBDA_INIT) / sqrtf(xhalf_sum(s2) * (1.0f / 128.0f) + EPS);
            bf16_t* yp = Y + (size_t)tok * 1024 + 512 + h * 128 + 4 * hi;
#pragma unroll
            for (int v = 0; v < NVB; ++v)
#pragma unroll
                for (int g = 0; g < 4; ++g) { const f32x4 gn = *(LAS const f32x4*)(btab + 520 + v * 32 + 8 * g + 4 * hi);
                    store4(yp + v * 32 + 8 * g, o[v][4 * g] * rn * gn[0], o[v][4 * g + 1] * rn * gn[1], o[v][4 * g + 2] * rn * gn[2], o[v][4 * g + 3] * rn * gn[3]); }
        }
    }
}

__device__ __forceinline__ void attn_unit_mla2(Frame& F, int b, int h, int qt, float bref) {
    constexpr int NDS = 6, NVB = 2, QROWS = 512, KBYTES = 12 * 1024, VBYTES = NVB * 4096, TILEB = KBYTES + VBYTES;
    int lane_o = F.lane; asm volatile("" : "+v"(lane_o));
    const int lane = lane_o, r32 = lane & 31, hi = lane >> 5, w = F.wave;
    const bf16_t* Qg = (const bf16_t*)(F.ws + WS_QM) + h * 96; const bf16_t* Kg = (const bf16_t*)(F.ws + WS_KM) + h * 96; const bf16_t* Vg = (const bf16_t*)(F.ws + WS_VM) + h * 64;
    constexpr int qpitch = 768, kpitch = 768, vpitch = 512;
    const size_t brow = (size_t)b * LP;
    const int qposA0 = NMETA + qt * QROWS + w * 64, qposB0 = qposA0 + 32, qposA = qposA0 + r32, qposB = qposB0 + r32;
    const int NT = (NMETA + qt * QROWS + QROWS + 63) >> 6, tlast = (qposB0 + 31) >> 6;
    bf16x8 qa[NDS], qb[NDS];
#pragma unroll
    for (int d0 = 0; d0 < NDS; ++d0) { qa[d0] = ld_frag(Qg + (brow + qposA) * qpitch + 16 * d0 + 8 * hi); qb[d0] = ld_frag(Qg + (brow + qposB) * qpitch + 16 * d0 + 8 * hi); }
    __builtin_amdgcn_s_waitcnt(0x0F70);
#pragma unroll
    for (int d0 = 0; d0 < NDS; ++d0) asm volatile("" : "+v"(qa[d0]), "+v"(qb[d0]));
    const int kc1 = 8 + (w & 3);
    const bf16_t* ksrc0 = Kg + (brow + lane) * kpitch + w * 8;
    const bf16_t* ksrc1 = Kg + (brow + lane) * kpitch + kc1 * 8;
    const bf16_t* vsrc0 = Vg + (brow + 16 * (w & 3) + (lane >> 2)) * vpitch + (w >> 2) * 32 + (lane & 3) * 8;
    const lds_ptr lds = F.lds; const unsigned lds0 = (unsigned)(size_t)F.lds;
    const int kdst0 = w * 1024, kdst1 = kc1 * 1024, vdst0 = KBYTES + w * 1024;
    const int kbase = hi * 1024 + r32 * 16;
    const int vbase = KBYTES + ((lane >> 4) & 1) * 32 + (lane & 3) * 8 + (4 * hi + ((lane & 15) >> 2)) * 64;
#define AM2_GLDS(src, dst) glds16((src), (unsigned)__builtin_amdgcn_readfirstlane((int)(lds0 + (unsigned)(dst))))
#define AM2_DMA(t, so) do { const size_t to_ = (size_t)(t) * 64; AM2_GLDS(ksrc0 + to_ * kpitch, (so) + kdst0); AM2_GLDS(ksrc1 + to_ * kpitch, (so) + kdst1); AM2_GLDS(vsrc0 + to_ * vpitch, (so) + vdst0); } while (0)
#define AM2_WAIT_BAR(n) asm volatile("s_waitcnt vmcnt(" #n ") lgkmcnt(0)\n\ts_barrier" ::: "memory")
    float la = 0.f, lb = 0.f; f32x16 oa[NVB], ob[NVB];
#pragma unroll
    for (int v = 0; v < NVB; ++v) { oa[v] = zero16(); ob[v] = zero16(); }
    (void)bref;
    const bool grpB = (w >= 4);
    __syncthreads();
    AM2_DMA(0, 0); AM2_DMA(1, TILEB);
    AM2_WAIT_BAR(3);
    int so_cur = 0, so_nn = 2 * TILEB;
    for (int t = 0; t < NT; ++t) {
        if (t + 2 < NT) AM2_DMA(t + 2, so_nn);
        const bool act = (t <= tlast);
        bf16x8 pa[4], pb[4];
        if (act) {
            const lds_cptr kp = (lds_cptr)lds + so_cur + kbase;
            f32x16 a0 = zero16(), a1 = zero16(), b0 = zero16(), b1 = zero16();
#pragma unroll
            for (int d0 = 0; d0 < NDS; ++d0) { const bf16x8 k0 = *(const LAS bf16x8*)(kp + d0 * 2048), k1 = *(const LAS bf16x8*)(kp + d0 * 2048 + 512);
                a0 = MFMA32(k0, qa[d0], a0); b0 = MFMA32(k0, qb[d0], b0); a1 = MFMA32(k1, qa[d0], a1); b1 = MFMA32(k1, qb[d0], b1);
                if (d0 & 1) __builtin_amdgcn_sched_barrier(0); }
            if (64 * t + 63 > qposA0) {
                const int kpos0 = 64 * t + 4 * hi;
#pragma unroll
                for (int r = 0; r < 16; ++r) { const int kv = kpos0 + (r & 3) + 8 * (r >> 2);
                    if (kv > qposA) a0[r] = -INFINITY; if (kv + 32 > qposA) a1[r] = -INFINITY; if (kv > qposB) b0[r] = -INFINITY; if (kv + 32 > qposB) b1[r] = -INFINITY; }
            }
            { float ls = 0.f;
#pragma unroll
              for (int r = 0; r < 16; ++r) { a0[r] = __builtin_amdgcn_exp2f(a0[r]); a1[r] = __builtin_amdgcn_exp2f(a1[r]); ls += a0[r] + a1[r]; }
              la += ls; u32x4 x0, x1, x2, x3;
#pragma unroll
              for (int i = 0; i < 4; ++i) { x0[i] = pk2(a0[2 * i], a0[2 * i + 1]); x1[i] = pk2(a0[8 + 2 * i], a0[9 + 2 * i]); x2[i] = pk2(a1[2 * i], a1[2 * i + 1]); x3[i] = pk2(a1[8 + 2 * i], a1[9 + 2 * i]); }
              pa[0] = __builtin_bit_cast(bf16x8, x0); pa[1] = __builtin_bit_cast(bf16x8, x1); pa[2] = __builtin_bit_cast(bf16x8, x2); pa[3] = __builtin_bit_cast(bf16x8, x3); }
            __builtin_amdgcn_sched_barrier(0);
            { float ls = 0.f;
#pragma unroll
              for (int r = 0; r < 16; ++r) { b0[r] = __builtin_amdgcn_exp2f(b0[r]); b1[r] = __builtin_amdgcn_exp2f(b1[r]); ls += b0[r] + b1[r]; }
              lb += ls; u32x4 x0, x1, x2, x3;
#pragma unroll
              for (int i = 0; i < 4; ++i) { x0[i] = pk2(b0[2 * i], b0[2 * i + 1]); x1[i] = pk2(b0[8 + 2 * i], b0[9 + 2 * i]); x2[i] = pk2(b1[2 * i], b1[2 * i + 1]); x3[i] = pk2(b1[8 + 2 * i], b1[9 + 2 * i]); }
              pb[0] = __builtin_bit_cast(bf16x8, x0); pb[1] = __builtin_bit_cast(bf16x8, x1); pb[2] = __builtin_bit_cast(bf16x8, x2); pb[3] = __builtin_bit_cast(bf16x8, x3); }
        }
        if (grpB) { if (t + 2 < NT) AM2_WAIT_BAR(3); else AM2_WAIT_BAR(0); }
        if (act) {
            const lds_cptr vp = (lds_cptr)lds + so_cur + vbase;
#pragma unroll
            for (int ks = 0; ks < 4; ++ks)
#pragma unroll
                for (int v = 0; v < NVB; ++v) { const s16x4 lo = vtr(vp + v * 4096 + ks * 1024), hi4 = vtr(vp + v * 4096 + ks * 1024 + 512);
                    const bf16x8 vf = (bf16x8){lo[0], lo[1], lo[2], lo[3], hi4[0], hi4[1], hi4[2], hi4[3]};
                    oa[v] = MFMA32(vf, pa[ks], oa[v]); ob[v] = MFMA32(vf, pb[ks], ob[v]); }
        }
        if (!grpB) { if (t + 2 < NT) AM2_WAIT_BAR(3); else AM2_WAIT_BAR(0); }
        so_nn = (so_nn == 3 * TILEB) ? 0 : so_nn + TILEB; so_cur = (so_cur == 3 * TILEB) ? 0 : so_cur + TILEB;
    }
    __syncthreads();
#undef AM2_GLDS
#undef AM2_DMA
#undef AM2_WAIT_BAR
    const float inva = 1.0f / xhalf_sum(la), invb = 1.0f / xhalf_sum(lb);
    bf16_t* Y = (bf16_t*)(F.ws + WS_Y);
    bf16_t* ya = Y + (size_t)(b * SEQ + (qposA - NMETA)) * 1024 + h * 64 + 4 * hi; bf16_t* yb = Y + (size_t)(b * SEQ + (qposB - NMETA)) * 1024 + h * 64 + 4 * hi;
#pragma unroll
    for (int v = 0; v < NVB; ++v)
#pragma unroll
        for (int g = 0; g < 4; ++g) { store4(ya + v * 32 + 8 * g, oa[v][4 * g] * inva, oa[v][4 * g + 1] * inva, oa[v][4 * g + 2] * inva, oa[v][4 * g + 3] * inva);
                                      store4(yb + v * 32 + 8 * g, ob[v][4 * g] * invb, ob[v][4 * g + 1] * invb, ob[v][4 * g + 2] * invb, ob[v][4 * g + 3] * invb); }
}

__device__ __forceinline__ int f2key(float f) { const int b = __float_as_int(f); return b ^ ((b >> 31) & 0x7fffffff); }
__device__ __forceinline__ float key2f(int k) { return __int_as_float(k ^ ((k >> 31) & 0x7fffffff)); }
#define TOPK_INS(top, x) do { int x_ = (x); _Pragma("unroll") for (int i_ = 0; i_ < 16; ++i_) { const int hi_ = max(top[i_], x_); x_ = min(top[i_], x_); top[i_] = hi_; } } while (0)
#define CE_DESC(a, b) do { const int hi_ = max((a), (b)); const int lo_ = min((a), (b)); (a) = hi_; (b) = lo_; } while (0)
__device__ __forceinline__ void sort16_desc(int (&x)[16]) {
#pragma unroll
    for (int k = 2; k <= 16; k <<= 1)
#pragma unroll
        for (int j = k >> 1; j > 0; j >>= 1)
#pragma unroll
            for (int i = 0; i < 16; ++i) { const int l = i ^ j; if (l > i) { if ((i & k) == 0) CE_DESC(x[i], x[l]); else CE_DESC(x[l], x[i]); } }
}
__device__ __forceinline__ void merge16_desc(int (&top)[16], const int (&x)[16]) {
#pragma unroll
    for (int i = 0; i < 16; ++i) top[i] = max(top[i], x[15 - i]);
#pragma unroll
    for (int j = 8; j > 0; j >>= 1)
#pragma unroll
        for (int i = 0; i < 16; ++i) { const int l = i ^ j; if (l > i) CE_DESC(top[i], top[l]); }
}
__device__ __forceinline__ void p7_job(Frame& F, int tb, int h) {
    const int lane = F.lane, r32 = lane & 31, hi = lane >> 5;
    const bf16_t* QP = (const bf16_t*)(F.ws + WS_QP);
    const int tok = tb * 32 + r32;
    int s1[16], s2[16];
#pragma unroll 1
    for (int p = 0; p < 2; ++p) {
        bf16x8 qf[8];
#pragma unroll
        for (int s = 0; s < 8; ++s) qf[s] = ld_frag(QP + (size_t)tok * 2048 + h * 256 + p * 128 + 16 * s + 8 * hi);
        int top[16];
#pragma unroll
        for (int i = 0; i < 16; ++i) top[i] = (int)0x80000000;
#pragma unroll 1
        for (int kt = 0; kt < 4; ++kt) {
            f32x16 sc = zero16(); const lds_cptr ap = (lds_cptr)F.lds + (p * 128 + kt * 32 + r32) * 256;
#pragma unroll
            for (int s = 0; s < 8; ++s) sc = MFMA32(*(const LAS bf16x8*)(ap + (((2 * s + hi) ^ (r32 & 15)) * 16)), qf[s], sc);
            int x[16];
#pragma unroll
            for (int r = 0; r < 16; ++r) x[r] = (f2key(sc[r]) & ~127) | (kt * 32 + (r & 3) + 8 * (r >> 2) + 4 * hi);
            sort16_desc(x); merge16_desc(top, x);
        }
        int oth[16];
#pragma unroll
        for (int i = 0; i < 16; ++i) oth[i] = __shfl_xor(top[i], 32);
        merge16_desc(top, oth);
#pragma unroll
        for (int i = 0; i < 16; ++i) { if (p == 0) s1[i] = top[i]; else s2[i] = top[i]; }
    }
    float a1[16], a2[16];
#pragma unroll
    for (int i = 0; i < 16; ++i) { a1[i] = key2f(s1[i] & ~127); a2[i] = key2f(s2[i] & ~127); }
#define CAND(i, j) ((f2key(a1[i] + a2[j]) & ~255) | ((i) << 4) | (j))
    int best[16], ca[16], cb[16];
#pragma unroll
    for (int j = 0; j < 16; ++j) best[j] = CAND(0, j);
    ca[0] = CAND(1, 0); ca[1] = CAND(1, 1); ca[2] = CAND(1, 2); ca[3] = CAND(1, 3); ca[4] = CAND(1, 4); ca[5] = CAND(1, 5); ca[6] = CAND(1, 6); ca[7] = CAND(1, 7);
    ca[8] = CAND(2, 0); ca[9] = CAND(2, 1); ca[10] = CAND(2, 2); ca[11] = CAND(2, 3); ca[12] = CAND(2, 4); ca[13] = CAND(3, 0); ca[14] = CAND(3, 1); ca[15] = CAND(3, 2);
    cb[0] = CAND(3, 3); cb[1] = CAND(4, 0); cb[2] = CAND(4, 1); cb[3] = CAND(4, 2); cb[4] = CAND(5, 0); cb[5] = CAND(5, 1); cb[6] = CAND(6, 0); cb[7] = CAND(6, 1);
    cb[8] = CAND(7, 0); cb[9] = CAND(7, 1); cb[10] = CAND(8, 0); cb[11] = CAND(9, 0); cb[12] = CAND(10, 0); cb[13] = CAND(11, 0); cb[14] = CAND(12, 0); cb[15] = CAND(13, 0);
    sort16_desc(ca); merge16_desc(best, ca); sort16_desc(cb); merge16_desc(best, cb);
    TOPK_INS(best, CAND(14, 0)); TOPK_INS(best, CAND(15, 0));
#undef CAND
    LAS int* st = (LAS int*)(F.lds + 65536 + F.wave * 8192) + lane;
#pragma unroll
    for (int i = 0; i < 16; ++i) { st[i * 64] = s1[i] & 127; st[(16 + i) * 64] = s2[i] & 127; }
    float bv[8]; int ex[8];
#pragma unroll
    for (int k = 0; k < 8; ++k) { const int bk = hi ? best[8 + k] : best[k]; const int ci = (bk >> 4) & 15, cj = bk & 15;
        ex[k] = st[ci * 64] * 128 + st[(16 + cj) * 64]; bv[k] = key2f(bk & ~255); }
    float rs2;
    { const f32x4* sp = (const f32x4*)((const float*)(F.ws + WS_SSQP) + (size_t)tok * 16); const f32x4 a = sp[0], b = sp[1], c = sp[2], d = sp[3];
      const float ssq = ((a[0] + a[1]) + (a[2] + a[3])) + ((b[0] + b[1]) + (b[2] + b[3])) + ((c[0] + c[1]) + (c[2] + c[3])) + ((d[0] + d[1]) + (d[2] + d[3])); rs2 = 1.0f / sqrtf(ssq * (1.0f / 1024.0f) + EPS); }
    const float bmax = key2f(best[0] & ~255); float sum = 0.f;
#pragma unroll
    for (int k = 0; k < 8; ++k) { bv[k] = __expf((bv[k] - bmax) * rs2); sum += bv[k]; }
    sum += __shfl_xor(sum, 32);
    const float inv = 1.0f / sum;
    int* EI = (int*)(F.ws + WS_EI); float* EG = (float*)(F.ws + WS_EG);
    u32x4 i0, i1; f32x4 g0, g1;
#pragma unroll
    for (int k = 0; k < 4; ++k) { i0[k] = (unsigned)ex[k]; i1[k] = (unsigned)ex[4 + k]; g0[k] = bv[k] * inv; g1[k] = bv[4 + k] * inv; }
    int* ip = EI + (size_t)tok * 128 + h * 16 + hi * 8; float* gp = EG + (size_t)tok * 128 + h * 16 + hi * 8;
    *(u32x4*)ip = i0; *(u32x4*)(ip + 4) = i1; *(f32x4*)gp = g0; *(f32x4*)(gp + 4) = g1;
}

__device__ __forceinline__ float gelu_exact(float v) {
    const float av = fabsf(v), t = __builtin_amdgcn_rcpf(av * 0.2316418882f + 1.0f);
    float q = t * 0.5307027145f + (-0.7265760135f); q = q * t + 0.7107068705f; q = q * t + (-0.142248368f); q = q * t + 0.127414796f; q = q * t;
    const float e = __builtin_amdgcn_exp2f((v * v) * (-0.72134752044f));
    const float m = v * (q * e);
    return v < 0.f ? m : v - m;
}
__device__ __forceinline__ int wave_sum_i(int v) {
#pragma unroll
    for (int o = 1; o < 64; o <<= 1) v += __shfl_xor(v, o);
    return v;
}
constexpr int P8_SYNC_MASK = 15;
constexpr int P8_LOG_NSL = 4, P8_NSL = 1 << P8_LOG_NSL;
constexpr int P8_TS = 8, P8_NSW = (16 + P8_TS - 1) / P8_TS;
constexpr int P8_WLDS = P8_TS * 2048;
__device__ __forceinline__ int dpp_xor1(int v) { return __builtin_amdgcn_update_dpp(0, v, 0xB1, 0xF, 0xF, false); }
__device__ __forceinline__ int dpp_xor2(int v) { return __builtin_amdgcn_update_dpp(0, v, 0x4E, 0xF, 0xF, false); }
__device__ __forceinline__ int dpp_hmir(int v) { return __builtin_amdgcn_update_dpp(0, v, 0x141, 0xF, 0xF, false); }
struct P8True { static constexpr bool value = true; }; struct P8False { static constexpr bool value = false; };
template <class BarT> __device__ __forceinline__ void p8_block16(Frame& F, int tb, int sw, const BarT& bar, int sync_mask, const float* FN) {
    const int lane = F.lane, g = lane >> 3, i8 = lane & 7;
    const unsigned char* U8 = F.ws + WS_U8; const unsigned char* V8 = F.ws + WS_V8;
    const int* EI = (const int*)(F.ws + WS_EI); const float* EG = (const float*)(F.ws + WS_EG);
    const float* SU = (const float*)(F.ws + WS_SU); const float* SV = (const float*)(F.ws + WS_SV);
    const lds_ptr wl = F.lds + F.wave * P8_WLDS;
    LAS unsigned short* ids = (LAS unsigned short*)wl; LAS float* gts = (LAS float*)(wl + P8_TS * 256); LAS unsigned short* ofs = (LAS unsigned short*)(wl + P8_TS * 768);
    const lds_ptr nql = wl + P8_TS * 1024;
    const int ntk = min(P8_TS, 16 - sw * P8_TS);
    const unsigned long long ltmask = (1ull << lane) - 1ull;
    {
        const int tok0 = tb * 16 + sw * P8_TS;
#pragma unroll
        for (int ti = 0; ti < P8_TS; ++ti) if (ti < ntk) {
            const int tok = tok0 + ti;
            {
              const u32x4* hr = (const u32x4*)((const bf16_t*)(F.ws + WS_H2B) + (size_t)tok * 1024 + lane * 16); const u32x4 hA = hr[0], hB = hr[1]; f32x4 y[4];
              const f32x4* sp = (const f32x4*)((const float*)(F.ws + WS_SSQP) + (size_t)tok * 16); const f32x4 pa_ = sp[0], pb_ = sp[1], pc_ = sp[2], pd_ = sp[3];
              const float ssq = ((pa_[0] + pa_[1]) + (pa_[2] + pa_[3])) + ((pb_[0] + pb_[1]) + (pb_[2] + pb_[3])) + ((pc_[0] + pc_[1]) + (pc_[2] + pc_[3])) + ((pd_[0] + pd_[1]) + (pd_[2] + pd_[3]));
              const float rs2 = 1.0f / sqrtf(ssq * (1.0f / 1024.0f) + EPS); float am = 0.f;
#pragma unroll
              for (int i = 0; i < 4; ++i) { const unsigned w0 = (i < 2 ? hA : hB)[2 * (i & 1)], w1 = (i < 2 ? hA : hB)[2 * (i & 1) + 1];
                  const f32x4 hv = {__uint_as_float(w0 << 16), __uint_as_float(w0 & 0xffff0000u), __uint_as_float(w1 << 16), __uint_as_float(w1 & 0xffff0000u)};
                  y[i] = hv * rs2 * *(const f32x4*)(FN + lane * 16 + 4 * i);
                  am = fmaxf(fmaxf(am, fmaxf(fabsf(y[i][0]), fabsf(y[i][1]))), fmaxf(fabsf(y[i][2]), fabsf(y[i][3]))); }
#pragma unroll
              for (int o = 1; o < 64; o <<= 1) am = fmaxf(am, __shfl_xor(am, o));
              const float inv = am > 0.f ? 127.0f / am : 0.f; u32x4 qv;
#pragma unroll
              for (int i = 0; i < 4; ++i) { unsigned wv = 0u;
#pragma unroll
                  for (int k = 0; k < 4; ++k) wv |= ((unsigned)(int)__builtin_rintf(y[i][k] * inv) & 255u) << (8 * k);
                  qv[i] = wv; }
              *(LAS u32x4*)(nql + ti * 1024 + lane * 16) = qv; if (lane == 0) *(LAS float*)(wl + P8_TS * 896 + ti * 4) = am * (1.0f / 127.0f); }
            const int e0 = EI[(size_t)tok * 128 + lane], e1 = EI[(size_t)tok * 128 + 64 + lane];
            const float g0 = EG[(size_t)tok * 128 + lane], g1 = EG[(size_t)tok * 128 + 64 + lane];
            const int s0 = e0 >> (14 - P8_LOG_NSL), s1 = e1 >> (14 - P8_LOG_NSL);
            int run = 0, pos0 = 0, pos1 = 0, myoff = 0;
#pragma unroll 1
            for (int sl = 0; sl < P8_NSL; ++sl) {
                const unsigned long long m0 = __ballot(s0 == sl), m1 = __ballot(s1 == sl);
                const int c0 = __popcll(m0), c1 = __popcll(m1);
                if (s0 == sl) pos0 = run + __popcll(m0 & ltmask);
                if (s1 == sl) pos1 = run + c0 + __popcll(m1 & ltmask);
                if (lane == sl) myoff = run;
                run += c0 + c1;
            }
            if (lane == P8_NSL) myoff = 128;
            ids[ti * 128 + pos0] = (unsigned short)e0; ids[ti * 128 + pos1] = (unsigned short)e1; gts[ti * 128 + pos0] = g0; gts[ti * 128 + pos1] = g1;
            if (lane <= P8_NSL) ofs[ti * 64 + lane] = (unsigned short)myoff;
        }
        f32x2 acc[P8_TS][8];
#pragma unroll
        for (int ti = 0; ti < P8_TS; ++ti)
#pragma unroll
            for (int i = 0; i < 8; ++i) acc[ti][i] = (f32x2){0.f, 0.f};
#pragma unroll 1
        for (int sl = 0; sl < P8_NSL; ++sl) {
            if (sl && (sl & sync_mask) == 0) xcd_barrier(bar);
#pragma unroll
            for (int ti = 0; ti < P8_TS; ++ti) if (ti < ntk) {
                const int lo = __builtin_amdgcn_readfirstlane((int)ofs[ti * 64 + sl]), hi = __builtin_amdgcn_readfirstlane((int)ofs[ti * 64 + sl + 1]);
#pragma unroll 1
                for (int c0 = lo; c0 < hi; c0 += 8) {
                    const int nd = min(8, hi - c0);
                    auto step = [&](auto fullc) {
                        constexpr bool FULL = decltype(fullc)::value;
                        const int n = FULL ? 8 : nd;
                        const int idx = ti * 128 + c0 + (FULL ? g : min(g, n - 1));
                        const int id = ids[idx]; const float gate = (FULL || g < n) ? gts[idx] : 0.f;
                        const float su = SU[id], sv = SV[id];
                        const unsigned uo = (unsigned)id * 1024u + (unsigned)i8 * 16u;
                        u32x4 ur[8], vr[8];
#pragma unroll
                        for (int j = 0; j < 8; ++j) ur[j] = *(const u32x4*)(U8 + (size_t)(uo + 128u * j));
#pragma unroll
                        for (int k = 0; k < 8; ++k) if (k < n) { const unsigned e = (unsigned)__builtin_amdgcn_readlane(id, 8 * k); vr[k] = *(const u32x4*)(V8 + (size_t)(e * 1024u + (unsigned)lane * 16u)); }
                        int d = 0; unsigned nqo = (unsigned)(ti * 1024 + i8 * 16); asm volatile("" : "+v"(nqo));
#pragma unroll
                        for (int jb = 0; jb < 8; jb += 4) {
                            u32x4 q[4];
#pragma unroll
                            for (int j = 0; j < 4; ++j) q[j] = *(const LAS u32x4*)(nql + nqo + 128 * (jb + j));
                            __builtin_amdgcn_sched_barrier(0);
#pragma unroll
                            for (int j = 0; j < 4; ++j)
#pragma unroll
                                for (int i = 0; i < 4; ++i) d = __builtin_amdgcn_sdot4((int)ur[jb + j][i], (int)q[j][i], d, false);
                        }
                        d += dpp_xor1(d); d += dpp_xor2(d); d += dpp_hmir(d);
                        const float coef = gate * gelu_exact((float)d * (*(const LAS float*)(wl + P8_TS * 896 + (nqo & 0x1c00u) / 256u) * su)) * sv;
#pragma unroll
                        for (int k = 0; k < 8; ++k) if (k < n) { const float c = __builtin_bit_cast(float, __builtin_amdgcn_readlane(__builtin_bit_cast(int, coef), 8 * k)); const f32x2 c2 = {c, c};
#pragma unroll
                            for (int i = 0; i < 4; ++i) { const f32x2 lo2 = __builtin_amdgcn_cvt_pk_f32_fp8((int)vr[k][i], false), hi2 = __builtin_amdgcn_cvt_pk_f32_fp8((int)vr[k][i], true);
                                acc[ti][2 * i] = c2 * lo2 + acc[ti][2 * i]; acc[ti][2 * i + 1] = c2 * hi2 + acc[ti][2 * i + 1]; } }
                    };
                    if (nd == 8) step(P8True{}); else step(P8False{});
                }
            }
        }
#pragma unroll
        for (int ti = 0; ti < P8_TS; ++ti) if (ti < ntk) {
            int lane_f = lane; asm volatile("" : "+v"(lane_f));
            float* op = F.out + (size_t)(tok0 + ti) * 1024 + lane_f * 16;
            const u32x2* hr = (const u32x2*)((const bf16_t*)(F.ws + WS_H2B) + (size_t)(tok0 + ti) * 1024 + lane_f * 16);
#pragma unroll
            for (int i = 0; i < 4; ++i) { const u32x2 hw = hr[i]; const unsigned w0 = hw.x, w1 = hw.y;
                f32x4 hv = {__uint_as_float(w0 << 16), __uint_as_float(w0 & 0xffff0000u), __uint_as_float(w1 << 16), __uint_as_float(w1 & 0xffff0000u)};
                hv += (f32x4){acc[ti][2 * i][0], acc[ti][2 * i][1], acc[ti][2 * i + 1][0], acc[ti][2 * i + 1][1]}; *(f32x4*)(op + 4 * i) = hv; }
        }
    }
}

constexpr int N_PHASES = 8;
__global__ void __launch_bounds__(NTHREADS, 2) mega_fwd(Args args) {
    extern __shared__ __attribute__((aligned(16))) unsigned char lds_raw[];
    Frame F;
    F.lds = (lds_ptr)lds_raw; F.tid = threadIdx.x; F.lane = F.tid & 63; F.wave = __builtin_amdgcn_readfirstlane(F.tid >> 6);
    F.G = gridDim.x; F.gw = blockIdx.x * NWAVES + F.wave; F.ngw = F.G * NWAVES;
    F.out = args.out; F.ws = args.ws;
    volatile LAS unsigned* MISC = (volatile LAS unsigned*)(F.lds + MISC_OFF);
    LAS float* tab = (LAS float*)(F.lds + TAB_OFF);
    if (F.tid < 64) MISC[F.tid] = 0u;
    __syncthreads();
    const int lo = args.ph_lo, hi = args.ph_hi;
    XcdBarrier bar; bar.bar = (unsigned*)(F.ws + WS_CTL) + CW_BAR; bar.x = 0; bar.st = nullptr;
    if (hi - lo > 1) bar = xcd_barrier_post((unsigned*)(F.ws + WS_CTL) + CW_BAR, MISC + 8);
#ifndef PHASE_MASK
#define PHASE_MASK 0x0ff
#endif
#define IN(k) (((PHASE_MASK >> (k)) & 1) && lo <= (k) && (k) < hi)
#define SEAM(k) do { if (IN(k) && IN((k) + 1)) xcd_barrier(bar); } while (0)
#define REPS(k) ((((REPEAT_MASK) >> (k)) & 1) ? 2 : 1)
#define PHASE(k) if (IN(k)) _Pragma("unroll") for (int rep_ = 0; rep_ < REPS(k); ++rep_)
#define REP_BAR() do { if (rep_) xcd_barrier(bar); } while (0)

    PHASE(0) { REP_BAR(); p0_prologue(F, args); }
    SEAM(0);
    PHASE(1) { REP_BAR();
        if (F.wave == 0 && blockIdx.x < 64) p1_meta_tile(F, blockIdx.x);
        __syncthreads();
        pg8::Gemm g{(const bf16_t*)(F.ws + WS_XB), (const bf16_t*)(F.ws + WS_W1T), MTOK, 2048, 1024}; pg8::StaticOrder S; S.init(MTOK, 2048, F.G, (int)blockIdx.x);
        EpiP1 E{(bf16_t*)(F.ws + WS_P1), (const float*)(F.ws + WS_RSTD1)};
        pg8::gemm_phase<EpiP1, pg8::StaticOrder, true, true>(F.lds, g, S, E);
    }
    SEAM(1);
    if (IN(2)) {
        for (int i = F.tid; i < 320; i += NTHREADS) tab[i] = i < 96 ? args.in[I_QKNQ][i] : (i < 192 ? args.in[I_QKNK][i - 96] : (i < 256 ? args.in[I_DQN][i - 192] : args.in[I_DKN][i - 256]));
        __syncthreads();
        constexpr int NPB = MP / 32;
        constexpr int NBJ = (NPB + 7) / 8;
        for (int j = blockIdx.x; j < 2 * NBJ; j += F.G) { if (j < NBJ) { if (P2ON & 1) p2_block<false>(F, j, tab); } else { if (P2ON & 2) p2_block<true>(F, j - NBJ, tab); } }
    }
    SEAM(2);
    PHASE(3) { REP_BAR();
        for (int i = F.tid; i < 512; i += NTHREADS) { const int hh = i >> 7, n = i & 127; tab[i] = args.in[I_RELB][T5_BUCKET[n] * 4 + hh] * LOG2E; }
        if (F.tid < 4) tab[512 + F.tid] = args.in[I_RELB][31 * 4 + F.tid] * LOG2E;
        if (F.tid >= 64 && F.tid < 192) tab[520 + F.tid - 64] = args.in[I_SUBLN][F.tid - 64];
        if (F.wave == 4) { const float a = wave_sum(args.in[I_LQ1][F.lane] * args.in[I_LK1][F.lane]), c = wave_sum(args.in[I_LQ2][F.lane] * args.in[I_LK2][F.lane]);
            if (F.lane == 0) tab[516] = expf(a) - expf(c) + LAMBDA_INIT; }
        if (F.wave == 5) {
            const int l = F.lane;
            float gq = fmaxf(fabsf(args.in[I_QKNQ][l]), l < 32 ? fabsf(args.in[I_QKNQ][64 + l]) : 0.f), gk = fmaxf(fabsf(args.in[I_QKNK][l]), l < 32 ? fabsf(args.in[I_QKNK][64 + l]) : 0.f);
            float dq = fabsf(args.in[I_DQN][l]), dk = fabsf(args.in[I_DKN][l]), rb = fmaxf(fabsf(args.in[I_RELB][l]), fabsf(args.in[I_RELB][64 + l]));
#pragma unroll
            for (int o = 1; o < 64; o <<= 1) { gq = fmaxf(gq, __shfl_xor(gq, o)); gk = fmaxf(gk, __shfl_xor(gk, o)); dq = fmaxf(dq, __shfl_xor(dq, o)); dk = fmaxf(dk, __shfl_xor(dk, o)); rb = fmaxf(rb, __shfl_xor(rb, o)); }
            if (l == 0) { tab[517] = 9.79795897f * LOG2E * gq * gk * 1.02f + 0.5f; tab[518] = (8.0f * dq * dk * 1.02f + rb) * LOG2E + 0.5f; }
        }
        __syncthreads();
        quant_expert_tables(F, args);
        const float bnd_m = __builtin_bit_cast(float, __builtin_amdgcn_readfirstlane(__builtin_bit_cast(int, tab[517]))), bnd_d = __builtin_bit_cast(float, __builtin_amdgcn_readfirstlane(__builtin_bit_cast(int, tab[518]))); const bool fix_m = bnd_m <= 60.f, fix_d = bnd_d <= 60.f;
        const int x = blockIdx.x & 7, jj = blockIdx.x >> 3;
        const bool bal = (F.G == 256);
        const int nun = bal ? 4 : (1024 - (int)blockIdx.x + F.G - 1) / F.G;
        if (fix_m) {
            const int nun2 = bal ? 2 : (512 - (int)blockIdx.x + F.G - 1) / F.G;
            for (int i = 0; i < nun2; ++i) { int bb, hh, qt;
                if (bal) { const int bh = x + 8 * (jj >> 3), pr = jj & 7; bb = bh >> 3; hh = bh & 7; qt = (i & 1) ? 15 - pr : pr; }
                else { const int u = blockIdx.x + i * F.G; bb = u >> 7; hh = (u >> 4) & 7; qt = u & 15; }
                attn_unit_mla2(F, bb, hh, qt, bnd_m); }
        } else {
        for (int i = 0; i < nun; ++i) { int bb, hh, qt;
            if (bal) { const int pi = jj + 32 * (i >> 1), bh = x + 8 * (pi >> 4), pr = pi & 15; bb = bh >> 3; hh = bh & 7; qt = (i & 1) ? 31 - pr : pr; }
            else { const int u = blockIdx.x + i * F.G; bb = u >> 8; hh = (u >> 5) & 7; qt = u & 31; }
            attn_unit<false, false>(F, bb, hh, qt, tab, 0.f); }
        }
        for (int i = 0; i < nun; ++i) { int bb, hh, qt;
            if (bal) { const int bh = x + 8 * (i >> 1); bb = bh >> 2; hh = bh & 3; qt = (i & 1) ? 63 - jj : jj; }
            else { const int u = blockIdx.x + i * F.G; bb = u >> 8; hh = (u >> 6) & 3; qt = u & 63; }
            if (fix_d) attn_unit<true, true>(F, bb, hh, qt, tab, bnd_d); else attn_unit<true, false>(F, bb, hh, qt, tab, 0.f); }
    }
    SEAM(3);
    PHASE(4) { REP_BAR();
        pg8::Gemm g{(const bf16_t*)(F.ws + WS_Y), (const bf16_t*)(F.ws + WS_WOUT), MTOK, 1024, 1024}; pg8::StaticOrder S; S.init(MTOK, 1024, F.G, (int)blockIdx.x);
        EpiRes E{args.in[I_X], F.out, (bf16_t*)(F.ws + WS_H2B), (float*)(F.ws + WS_SSQP)};
        pg8::gemm_phase<EpiRes, pg8::StaticOrder, true, true>(F.lds, g, S, E);
    }
    SEAM(4);
    PHASE(5) { REP_BAR();
        pg8::Gemm g{(const bf16_t*)(F.ws + WS_H2B), (const bf16_t*)(F.ws + WS_WPQ), MTOK, 2048, 1024}; pg8::StaticOrder S; S.init(MTOK, 2048, F.G, (int)blockIdx.x);
        EpiPlain E{(bf16_t*)(F.ws + WS_QP), 2048};
        pg8::gemm_phase<EpiPlain, pg8::StaticOrder, true, true>(F.lds, g, S, E);
    }
    SEAM(5);
    PHASE(6) { REP_BAR();
        const unsigned lds0 = (unsigned)(size_t)F.lds; const bf16_t* SK = (const bf16_t*)(F.ws + WS_SK);
        int cur_h = -1;
        for (int j = blockIdx.x; j < (MTOK / 256) * 8; j += F.G) {
            const int h = j & 7;
            if (h != cur_h) {
                __syncthreads();
#pragma unroll
                for (int i = 0; i < 8; ++i) { const int pc = F.wave * 8 + i, row = 4 * pc + (F.lane >> 4);
                    glds16(SK + ((size_t)h * 256 + row) * 128 + (((F.lane & 15) ^ (row & 15)) * 8), (unsigned)__builtin_amdgcn_readfirstlane((int)(lds0 + pc * 1024))); }
                asm volatile("s_waitcnt vmcnt(0)\n\ts_barrier" ::: "memory");
                cur_h = h;
            }
            p7_job(F, (j >> 3) * 8 + F.wave, h);
        }
    }
    SEAM(6);
    if (IN(7)) {
#pragma unroll 1
        for (int sw = 0; sw < P8_NSW; ++sw) {
            if (sw > 0 && hi - lo > 1) xcd_barrier(bar);
            const int smask = (hi - lo > 1 && F.ngw * 16 == MTOK) ? P8_SYNC_MASK : -1;
            for (int tb = F.gw; tb < MTOK / 16; tb += F.ngw) p8_block16(F, tb, sw, bar, smask, args.in[I_FNORM]);
        }
    }
#undef IN
#undef SEAM
}

extern "C" void kernel_launch(void* const* d_in, const int* in_sizes, int n_in, void* d_out, int out_size, void* d_ws, size_t ws_size, hipStream_t stream) {
    static int grid = 0;
    if (grid == 0) {
        if (n_in != 24 || out_size != MTOK * DMODEL || ws_size < WS_END) { fprintf(stderr, "kernel_launch: unexpected shapes (n_in %d, out %d, ws %zu < %zu)\n", n_in, out_size, ws_size, (size_t)WS_END); grid = -1; return; }
        int dev = 0, cus = 0, per_cu = 0;
        if (hipGetDevice(&dev) != hipSuccess || hipDeviceGetAttribute(&cus, hipDeviceAttributeMultiprocessorCount, dev) != hipSuccess) { grid = -1; return; }
        if (hipFuncSetAttribute((const void*)mega_fwd, hipFuncAttributeMaxDynamicSharedMemorySize, LDS_BYTES) != hipSuccess) { fprintf(stderr, "kernel_launch: hipFuncSetAttribute failed\n"); grid = -1; return; }
        if (hipOccupancyMaxActiveBlocksPerMultiprocessor(&per_cu, (const void*)mega_fwd, NTHREADS, LDS_BYTES) != hipSuccess || per_cu < 1) fprintf(stderr, "kernel_launch: occupancy query reports %d\n", per_cu);
        (void)hipGetLastError();
        grid = cus;
    }
    if (grid < 0) return;
    (void)hipMemsetAsync((char*)d_ws + WS_CTL, 0, CTL_ZERO_BYTES, stream);
    Args a{};
    for (int i = 0; i < 24; ++i) a.in[i] = (const float*)d_in[i];
    a.out = (float*)d_out; a.ws = (unsigned char*)d_ws;
#if MK_PER_PHASE
    for (int ph = 0; ph < N_PHASES; ++ph) { a.ph_lo = ph; a.ph_hi = ph + 1; hipLaunchKernelGGL(mega_fwd, dim3(grid), dim3(NTHREADS), LDS_BYTES, stream, a); }
#else
    a.ph_lo = 0; a.ph_hi = N_PHASES; hipLaunchKernelGGL(mega_fwd, dim3(grid), dim3(NTHREADS), LDS_BYTES, stream, a);
#endif
}
```

```cpp
#include <hip/hip_runtime.h>
#include <cstdio>
#include <cstdint>

#ifndef MK_PER_PHASE
#define MK_PER_PHASE 0
#endif

#ifndef REPEAT_MASK
#define REPEAT_MASK 0
#endif
#ifndef P2ON
#define P2ON 3
#endif
#ifndef PROBE_P8
#define PROBE_P8 0
#endif
#ifndef PROBE_ZERO_MLA
#define PROBE_ZERO_MLA 0
#endif
#define GAS __attribute__((address_space(1)))
#define LAS __attribute__((address_space(3)))
typedef unsigned short bf16_t;
typedef short bf16x8 __attribute__((ext_vector_type(8)));
typedef short s16x4 __attribute__((ext_vector_type(4)));
typedef short v4i16_t __attribute__((ext_vector_type(4)));
typedef float f32x2 __attribute__((ext_vector_type(2)));
typedef float f32x4 __attribute__((ext_vector_type(4)));
typedef float f32x16 __attribute__((ext_vector_type(16)));
typedef unsigned u32x2 __attribute__((ext_vector_type(2)));
typedef unsigned u32x4 __attribute__((ext_vector_type(4)));
typedef __bf16 bf16x2_t __attribute__((ext_vector_type(2)));
typedef LAS unsigned char* lds_ptr;
typedef LAS const char* lds_cptr;

#define MFMA32(a, b, c) __builtin_amdgcn_mfma_f32_32x32x16_bf16((a), (b), (c), 0, 0, 0)
#define LDS_WAIT() asm volatile("s_waitcnt lgkmcnt(0)" ::: "memory")
#define VM_WAIT() asm volatile("s_waitcnt vmcnt(0)" ::: "memory")

constexpr int BATCH = 4, SEQ = 8192, DMODEL = 1024, MTOK = BATCH * SEQ;
constexpr int NMETA = 16, LREAL = NMETA + SEQ, LP = 8256, MP = BATCH * LP;
constexpr int P1W = 2048;
constexpr int C_CQ = 0, C_CKV = 256, C_DQ = 512, C_DK = 1024, C_DV = 1536;
constexpr int XB_ROWS = MTOK + 256;
constexpr int XB_META = MTOK, XB_ZERO = MTOK + 16;
constexpr float EPS = 1e-6f;
constexpr float LOG2E = 1.4426950408889634f;
constexpr float QS_MLA = 0.10206207261596577f * LOG2E;
constexpr float QS_DIFF = 0.125f * LOG2E;
constexpr float LAMBDA_INIT = 0.2f;
constexpr float SM_THR = 8.0f;

__device__ const double ROPE_INVF[16] = {1.0, 0.5623413251903491, 0.31622776601683794, 0.1778279410038923, 0.1, 0.05623413251903491, 0.03162277660168379, 0.01778279410038923,
    0.01, 0.005623413251903491, 0.0031622776601683794, 0.0017782794100389228, 0.001, 0.0005623413251903491, 0.00031622776601683794, 0.00017782794100389227};
__device__ const unsigned char T5_BUCKET[128] = {0, 1, 2, 3, 4, 5, 6, 7, 8, 9, 10, 11, 12, 13, 14, 15, 16, 16, 16, 17, 17, 18, 18, 18, 19, 19, 19, 20, 20, 20, 20, 21, 21, 21, 21, 22, 22, 22, 22, 22,
    23, 23, 23, 23, 23, 23, 24, 24, 24, 24, 24, 24, 25, 25, 25, 25, 25, 25, 25, 26, 26, 26, 26, 26, 26, 26, 26, 27, 27, 27, 27, 27, 27, 27, 27, 27, 27, 28, 28, 28, 28, 28, 28, 28, 28, 28, 28,
    29, 29, 29, 29, 29, 29, 29, 29, 29, 29, 29, 29, 30, 30, 30, 30, 30, 30, 30, 30, 30, 30, 30, 30, 30, 30, 31, 31, 31, 31, 31, 31, 31, 31, 31, 31, 31, 31, 31, 31, 31};

constexpr size_t al256(size_t x) { return (x + 255) & ~(size_t)255; }
constexpr size_t WS_CTL = 0, CTL_ZERO_BYTES = 1u << 20;
constexpr size_t WS_W1T = CTL_ZERO_BYTES;
constexpr size_t WS_WKR = WS_W1T + (size_t)2048 * 1024 * 2;
constexpr size_t WS_WUQ = WS_WKR + (size_t)32 * 1024 * 2;
constexpr size_t WS_WUKV = WS_WUQ + (size_t)768 * 256 * 2;
constexpr size_t WS_SK = WS_WUKV + (size_t)1024 * 256 * 2;
constexpr size_t WS_WOUT = WS_SK + (size_t)16 * 128 * 128 * 2;
constexpr size_t WS_WPQ = WS_WOUT + (size_t)1024 * 1024 * 2;
constexpr size_t WS_RSTD1 = WS_WPQ + (size_t)2048 * 1024 * 2;
constexpr size_t WS_SU = al256(WS_RSTD1 + (size_t)XB_ROWS * 4);
constexpr size_t WS_SV = WS_SU + (size_t)16384 * 4;
constexpr size_t WS_SSQP = WS_SV + (size_t)16384 * 4;
constexpr size_t WS_U8 = al256(WS_SSQP + (size_t)MTOK * 16 * 4);
constexpr size_t WS_V8 = WS_U8 + (size_t)16384 * 1024;
constexpr size_t WS_XB = al256(WS_V8 + (size_t)16384 * 1024);
constexpr size_t WS_H2B = WS_XB;
constexpr size_t WS_P1 = al256(WS_XB + (size_t)XB_ROWS * 1024 * 2);
constexpr size_t WS_QP = WS_P1;
constexpr size_t WS_QM = al256(WS_P1 + (size_t)MP * P1W * 2);
constexpr size_t WS_EI = WS_QM, WS_EG = WS_QM + (size_t)MTOK * 128 * 4;
constexpr size_t WS_KM = al256(WS_QM + (size_t)MP * 768 * 2);
constexpr size_t WS_VM = al256(WS_KM + (size_t)MP * 768 * 2);
constexpr size_t WS_Y = al256(WS_VM + (size_t)MP * 512 * 2);
constexpr size_t WS_END = al256(WS_Y + (size_t)MTOK * 1024 * 2);
static_assert(WS_EG + (size_t)MTOK * 128 * 4 <= WS_KM, "EI/EG overlay fits in QM");
static_assert((size_t)MTOK * 2048 * 2 <= (size_t)MP * P1W * 2, "QP overlay fits in P1");
constexpr int CW_BAR = 4096;

constexpr int RING_BYTES = 131072;
constexpr int TAB_OFF = RING_BYTES;
constexpr int MISC_OFF = RING_BYTES + 12288;
constexpr int LDS_BYTES = 147456;
constexpr int NWAVES = 8, NTHREADS = 512;

__device__ __forceinline__ unsigned pk2(float lo, float hi) { f32x2 v = {lo, hi}; bf16x2_t b = __builtin_convertvector(v, bf16x2_t); return __builtin_bit_cast(unsigned, b); }
__device__ __forceinline__ float bf_lo(unsigned u) { return __uint_as_float(u << 16); }
__device__ __forceinline__ float bf_hi(unsigned u) { return __uint_as_float(u & 0xffff0000u); }
__device__ __forceinline__ int crow(int r, int hi) { return (r & 3) + 8 * (r >> 2) + 4 * hi; }
__device__ __forceinline__ float wave_sum(float v) {
#pragma unroll
    for (int o = 1; o < 64; o <<= 1) v += __shfl_xor(v, o);
    return v;
}
__device__ __forceinline__ float xhalf_sum(float v) { return v + __shfl_xor(v, 32); }
__device__ __forceinline__ float xhalf_max(float v) { return fmaxf(v, __shfl_xor(v, 32)); }
__device__ __forceinline__ float ssq8(u32x4 w) {
    float s = 0.f;
#pragma unroll
    for (int i = 0; i < 4; ++i) asm volatile("v_dot2c_f32_bf16 %0, %1, %2" : "+v"(s) : "v"(w[i]), "v"(w[i]));
    return s;
}
__device__ __forceinline__ bf16x8 ld_frag(const bf16_t* p) { return __builtin_bit_cast(bf16x8, *(const u32x4*)p); }
__device__ __forceinline__ f32x16 zero16() { f32x16 z;
#pragma unroll
    for (int i = 0; i < 16; ++i) z[i] = 0.f;
    return z; }
__device__ __forceinline__ s16x4 vtr(lds_cptr p) { return __builtin_bit_cast(s16x4, __builtin_amdgcn_ds_read_tr16_b64_v4i16((LAS v4i16_t*)p)); }

namespace pg8 {
#define PG8_LAS __attribute__((address_space(3)))
constexpr int BM = 256, BK = 64, HALF = 128, HTB = HALF * BK * 2, STAGE_BYTES = 8 * HTB, NXCD = 8, WGM = 8;
__host__ __device__ __forceinline__ int lds_byte(int r, int c) { const int st = (r >> 4) * 2 + (c >> 5), rr = r & 15, cc = c & 31, ob = rr * 64 + cc * 2; return st * 1024 + (ob ^ (((ob >> 9) & 1) << 5)); }
__host__ __device__ __forceinline__ void stage_rc(int b, int& R, int& C) { const int st = b / 1024, sb = b % 1024, swz = sb ^ (((sb >> 9) & 1) << 5); R = (st >> 1) * 16 + swz / 64; C = (st & 1) * 32 + (swz % 64) / 2; }
__host__ __device__ __forceinline__ int perm32(int rho) { const int n = rho >> 4, i = rho & 15; return 8 * (i >> 2) + 4 * n + (i & 3); }
struct Unit { int pm, pn; };
struct Gemm { const bf16_t* A; const bf16_t* Bt; int M, N, K; };
struct StaticOrder {
    int nM, nN, nwg, G, c;
    __host__ __device__ void init(int M, int N, int G_, int c_) { nM = M / BM; nN = N / BM; nwg = nM * nN; G = G_; c = c_; }
    __host__ __device__ bool next(int i, Unit& u) const {
        const long L = (long)i * G + c; if (L >= nwg) return false;
        int wgid = (int)L; { const int q = nwg / NXCD, r = nwg % NXCD, xcd = wgid % NXCD, off = wgid / NXCD; wgid = (xcd < r ? xcd * (q + 1) : r * (q + 1) + (xcd - r) * q) + off; }
        const int nig = WGM * nN, gid = wgid / nig, fm = gid * WGM, gsz = (nM - fm) < WGM ? (nM - fm) : WGM;
        u.pm = fm + ((wgid % nig) % gsz); u.pn = (wgid % nig) / gsz; return true;
    }
    __device__ __forceinline__ void a_ready(const Unit&) const {}
    __device__ __forceinline__ void done(const Unit&) const {}
};
template <class Epi, class Sched, bool ALIGN_EPI = false, bool SP2 = false>
__device__ __forceinline__ void gemm_phase(PG8_LAS unsigned char* lds, const Gemm g, const Sched& S, const Epi& E) {
    const int tid = threadIdx.x, wid = __builtin_amdgcn_readfirstlane(tid >> 6), lane = tid & 63, wr = wid >> 2, wc = wid & 3, fr = lane & 15, fq = lane >> 4;
    const int K = g.K, nt = K / BK;
    unsigned voffA[2], voffB[2];
#pragma unroll
    for (int i = 0; i < 2; ++i) { int R, C; stage_rc(tid * 16 + i * 8192, R, C); const int Rb = Epi::PERM ? ((R & ~31) + perm32(R & 31)) : R;
        voffA[i] = (unsigned)(R * K + C) * 2u; voffB[i] = (unsigned)(Rb * K + C) * 2u; }
    const size_t kstep = (size_t)(BK * 2);
    const size_t hstep = (size_t)HALF * K * 2;
    const size_t tstep = 2 * hstep;
    const unsigned ldsw = (unsigned)wid * 1024u;
    const int aoff = lds_byte(wr * 64 + fr, fq * 8), boff = lds_byte(wc * 32 + fr, fq * 8);
#define PG8_SA(b, h) (((b) * 2 + (h)) * HTB)
#define PG8_SB(b, h) ((4 + (b) * 2 + (h)) * HTB)
#define PG8_STAGE(bufoff, gbase, voff) do { _Pragma("unroll") for (int _i = 0; _i < 2; ++_i) \
        __builtin_amdgcn_global_load_lds((const unsigned*)((const char*)(gbase) + (voff)[_i]), (PG8_LAS unsigned*)(lds + (bufoff) + ldsw + _i * 8192), 16, 0, 0); } while (0)
#define PG8_LDA(dst, b, h) do { _Pragma("unroll") for (int m = 0; m < 4; ++m) _Pragma("unroll") for (int k = 0; k < 2; ++k) dst[m][k] = *(const PG8_LAS bf16x8*)(lds + PG8_SA(b, h) + aoff + m * 2048 + k * 1024); } while (0)
#define PG8_LDB(dst, b, h) do { _Pragma("unroll") for (int n = 0; n < 2; ++n) _Pragma("unroll") for (int k = 0; k < 2; ++k) dst[n][k] = *(const PG8_LAS bf16x8*)(lds + PG8_SB(b, h) + boff + n * 2048 + k * 1024); } while (0)
#define PG8_MMA(ai, bj, At, Bt) do { __builtin_amdgcn_s_setprio(1); _Pragma("unroll") for (int m = 0; m < 4; ++m) _Pragma("unroll") for (int n = 0; n < 2; ++n) _Pragma("unroll") for (int k = 0; k < 2; ++k) \
        acc[ai][bj][m][n] = __builtin_amdgcn_mfma_f32_16x16x32_bf16(Bt[n][k], At[m][k], acc[ai][bj][m][n], 0, 0, 0); __builtin_amdgcn_s_setprio(0); } while (0)
#define PG8_WAIT_V(n) asm volatile("s_waitcnt vmcnt(" #n ")" ::: "memory")
#define PG8_WAIT_L(n) asm volatile("s_waitcnt lgkmcnt(" #n ")" ::: "memory")
#define PG8_BAR __builtin_amdgcn_s_barrier()
#define PG8_SCHED __builtin_amdgcn_sched_barrier(0)
    Unit cur, nxt; int ui = 0;
    if (!S.next(0, cur)) return;
    f32x4 acc[2][2][4][2];
#pragma unroll
    for (int a = 0; a < 2; ++a)
#pragma unroll
        for (int b = 0; b < 2; ++b)
#pragma unroll
            for (int m = 0; m < 4; ++m)
#pragma unroll
                for (int n = 0; n < 2; ++n) acc[a][b][m][n] = (f32x4){0.f, 0.f, 0.f, 0.f};
    bf16x8 At[4][2], B0[2][2], B1[2][2];
    const char* cA = (const char*)g.A + (size_t)cur.pm * tstep; const char* cB = (const char*)g.Bt + (size_t)cur.pn * tstep;
    S.a_ready(cur);
    if constexpr (SP2) {
        PG8_STAGE(PG8_SB(0, 0), cB, voffB); PG8_STAGE(PG8_SB(0, 1), cB + hstep, voffB); PG8_STAGE(PG8_SA(0, 0), cA, voffA); PG8_STAGE(PG8_SA(0, 1), cA + hstep, voffA);
        if (wr == 1) PG8_BAR;
        PG8_WAIT_V(2); PG8_BAR;
        PG8_STAGE(PG8_SB(1, 0), cB + kstep, voffB); PG8_STAGE(PG8_SA(1, 0), cA + kstep, voffA); PG8_STAGE(PG8_SB(1, 1), cB + hstep + kstep, voffB);
        PG8_WAIT_V(6); PG8_BAR;
    } else {
        PG8_STAGE(PG8_SB(0, 0), cB, voffB); PG8_STAGE(PG8_SA(0, 0), cA, voffA); PG8_STAGE(PG8_SB(0, 1), cB + hstep, voffB); PG8_STAGE(PG8_SA(0, 1), cA + hstep, voffA);
        if (wr == 1) PG8_BAR;
        PG8_WAIT_V(4); PG8_BAR;
        PG8_STAGE(PG8_SB(1, 0), cB + kstep, voffB); PG8_STAGE(PG8_SA(1, 0), cA + kstep, voffA); PG8_STAGE(PG8_SB(1, 1), cB + hstep + kstep, voffB);
        PG8_WAIT_V(6); PG8_BAR;
    }
    for (;;) {
        const bool has_next = S.next(ui + 1, nxt);
        const char* nA = has_next ? (const char*)g.A + (size_t)nxt.pm * tstep : cA; const char* nB = has_next ? (const char*)g.Bt + (size_t)nxt.pn * tstep : cB;
        for (int t = 0; t < nt; t += 2) {
            const bool last = (t == nt - 2);
            const char* a1 = cA + (size_t)(t + 1) * kstep;
            const char* a2 = last ? nA : cA + (size_t)(t + 2) * kstep; const char* b2 = last ? nB : cB + (size_t)(t + 2) * kstep;
            const char* a3 = a2 + kstep; const char* b3 = b2 + kstep;
            if (last && has_next) S.a_ready(nxt);
            if constexpr (SP2) {
            PG8_LDB(B0, 0, 0); PG8_LDB(B1, 0, 1); PG8_SCHED; PG8_LDA(At, 0, 0); PG8_STAGE(PG8_SA(1, 1), a1 + hstep, voffA);
            PG8_WAIT_V(8); PG8_WAIT_L(0); PG8_BAR; PG8_MMA(0, 0, At, B0); PG8_MMA(0, 1, At, B1); PG8_BAR; PG8_SCHED;
            PG8_LDA(At, 0, 1); PG8_STAGE(PG8_SB(0, 0), b2, voffB); PG8_STAGE(PG8_SB(0, 1), b2 + hstep, voffB); PG8_STAGE(PG8_SA(0, 0), a2, voffA);
            PG8_WAIT_V(8); PG8_WAIT_L(0); PG8_BAR; PG8_MMA(1, 0, At, B0); PG8_MMA(1, 1, At, B1); PG8_BAR; PG8_SCHED;
            PG8_LDB(B0, 1, 0); PG8_LDB(B1, 1, 1); PG8_SCHED; PG8_LDA(At, 1, 0); PG8_STAGE(PG8_SA(0, 1), a2 + hstep, voffA);
            PG8_WAIT_V(8); PG8_WAIT_L(0); PG8_BAR; PG8_MMA(0, 0, At, B0); PG8_MMA(0, 1, At, B1); PG8_BAR; PG8_SCHED;
            PG8_LDA(At, 1, 1); PG8_STAGE(PG8_SB(1, 0), b3, voffB); PG8_STAGE(PG8_SB(1, 1), b3 + hstep, voffB); PG8_STAGE(PG8_SA(1, 0), a3, voffA);
            PG8_WAIT_V(8); PG8_WAIT_L(0); PG8_BAR; PG8_MMA(1, 0, At, B0); PG8_MMA(1, 1, At, B1); PG8_BAR; PG8_SCHED;
            } else {
            PG8_LDB(B0, 0, 0); PG8_SCHED; PG8_LDA(At, 0, 0); PG8_STAGE(PG8_SA(1, 1), a1 + hstep, voffA);
            PG8_WAIT_L(8); PG8_BAR; PG8_WAIT_L(0); PG8_MMA(0, 0, At, B0); PG8_BAR; PG8_SCHED;
            PG8_LDB(B1, 0, 1); PG8_STAGE(PG8_SB(0, 0), b2, voffB);
            PG8_BAR; PG8_WAIT_L(0); PG8_MMA(0, 1, At, B1); PG8_BAR;
            PG8_LDA(At, 0, 1); PG8_STAGE(PG8_SA(0, 0), a2, voffA);
            PG8_BAR; PG8_WAIT_L(0); PG8_MMA(1, 0, At, B0); PG8_BAR; PG8_SCHED;
            PG8_STAGE(PG8_SB(0, 1), b2 + hstep, voffB);
            PG8_WAIT_V(6); PG8_BAR; PG8_MMA(1, 1, At, B1); PG8_BAR;
            PG8_LDB(B0, 1, 0); PG8_SCHED; PG8_LDA(At, 1, 0); PG8_STAGE(PG8_SA(0, 1), a2 + hstep, voffA);
            PG8_WAIT_L(8); PG8_BAR; PG8_WAIT_L(0); PG8_MMA(0, 0, At, B0); PG8_BAR; PG8_SCHED;
            PG8_LDB(B1, 1, 1); PG8_STAGE(PG8_SB(1, 0), b3, voffB);
            PG8_BAR; PG8_WAIT_L(0); PG8_MMA(0, 1, At, B1); PG8_BAR;
            PG8_LDA(At, 1, 1); PG8_STAGE(PG8_SA(1, 0), a3, voffA);
            PG8_BAR; PG8_WAIT_L(0); PG8_MMA(1, 0, At, B0); PG8_BAR; PG8_SCHED;
            PG8_STAGE(PG8_SB(1, 1), b3 + hstep, voffB);
            PG8_WAIT_V(6); PG8_BAR; PG8_MMA(1, 1, At, B1); PG8_BAR;
            }
        }
        if constexpr (ALIGN_EPI) { if (wr == 0) PG8_BAR; }
        E(acc, cur, wr, wc, fr, fq); S.done(cur);
        if (!has_next) break;
#pragma unroll
        for (int a = 0; a < 2; ++a)
#pragma unroll
            for (int b = 0; b < 2; ++b)
#pragma unroll
                for (int m = 0; m < 4; ++m)
#pragma unroll
                    for (int n = 0; n < 2; ++n) acc[a][b][m][n] = (f32x4){0.f, 0.f, 0.f, 0.f};
        cur = nxt; cA = nA; cB = nB; ++ui;
        if constexpr (ALIGN_EPI) { if (wr == 1) PG8_BAR; }
    }
    PG8_WAIT_V(0);
    if constexpr (!ALIGN_EPI) { if (wr == 0) PG8_BAR; }
    PG8_BAR;
#undef PG8_SA
#undef PG8_SB
#undef PG8_STAGE
#undef PG8_LDA
#undef PG8_LDB
#undef PG8_MMA
#undef PG8_WAIT_V
#undef PG8_WAIT_L
#undef PG8_BAR
#undef PG8_SCHED
}
}

struct EpiP1 {
    static constexpr bool PERM = true, AFTER_DRAIN = false;
    bf16_t* P1; const float* rstd;
    __device__ __forceinline__ void operator()(const f32x4 (&acc)[2][2][4][2], const pg8::Unit& u, int wr, int wc, int fr, int fq) const {
#pragma unroll
        for (int ai = 0; ai < 2; ++ai)
#pragma unroll
            for (int m = 0; m < 4; ++m) {
                const int row = u.pm * 256 + ai * 128 + wr * 64 + m * 16 + fr;
                const float rs = rstd[row];
                const size_t prow = (size_t)(row >> 13) * LP + NMETA + (row & (SEQ - 1));
                bf16_t* rowp = P1 + prow * P1W + u.pn * 256 + wc * 32 + 8 * fq;
#pragma unroll
                for (int bj = 0; bj < 2; ++bj) { const f32x4 v0 = acc[ai][bj][m][0] * rs, v1 = acc[ai][bj][m][1] * rs;
                    u32x4 w; w.x = pk2(v0[0], v0[1]); w.y = pk2(v0[2], v0[3]); w.z = pk2(v1[0], v1[1]); w.w = pk2(v1[2], v1[3]);
                    *(u32x4*)(rowp + bj * 128) = w; } }
    }
};
struct EpiRes {
    static constexpr bool PERM = false, AFTER_DRAIN = false;
    const float* x; float* out; bf16_t* hb; float* ssqp;
    __device__ __forceinline__ void operator()(const f32x4 (&acc)[2][2][4][2], const pg8::Unit& u, int wr, int wc, int fr, int fq) const {
#pragma unroll
        for (int ai = 0; ai < 2; ++ai)
#pragma unroll
            for (int m = 0; m < 4; ++m) {
                const int row = u.pm * 256 + ai * 128 + wr * 64 + m * 16 + fr;
                const size_t off = (size_t)row * DMODEL + u.pn * 256 + wc * 32 + 4 * fq;
                float ss = 0.f;
#pragma unroll
                for (int bj = 0; bj < 2; ++bj)
#pragma unroll
                    for (int n = 0; n < 2; ++n) { const f32x4 hv = *(const f32x4*)(x + off + bj * 128 + n * 16) + acc[ai][bj][m][n];
                        u32x2 wv; wv.x = pk2(hv[0], hv[1]); wv.y = pk2(hv[2], hv[3]); *(u32x2*)(hb + off + bj * 128 + n * 16) = wv;
                        ss = __builtin_fmaf(hv[0], hv[0], ss); ss = __builtin_fmaf(hv[1], hv[1], ss); ss = __builtin_fmaf(hv[2], hv[2], ss); ss = __builtin_fmaf(hv[3], hv[3], ss); }
                ss += __shfl_xor(ss, 16); ss += __shfl_xor(ss, 32);
                if (fq == 0) ssqp[(size_t)row * 16 + u.pn * 4 + wc] = ss;
            }
    }
};
struct EpiPlain {
    static constexpr bool PERM = true, AFTER_DRAIN = false;
    bf16_t* O; int ldc;
    __device__ __forceinline__ void operator()(const f32x4 (&acc)[2][2][4][2], const pg8::Unit& u, int wr, int wc, int fr, int fq) const {
#pragma unroll
        for (int ai = 0; ai < 2; ++ai)
#pragma unroll
            for (int m = 0; m < 4; ++m) {
                bf16_t* rowp = O + (size_t)(u.pm * 256 + ai * 128 + wr * 64 + m * 16 + fr) * ldc + u.pn * 256 + wc * 32 + 8 * fq;
#pragma unroll
                for (int bj = 0; bj < 2; ++bj) { const f32x4 v0 = acc[ai][bj][m][0], v1 = acc[ai][bj][m][1];
                    u32x4 w; w.x = pk2(v0[0], v0[1]); w.y = pk2(v0[2], v0[3]); w.z = pk2(v1[0], v1[1]); w.w = pk2(v1[2], v1[3]);
                    *(u32x4*)(rowp + bj * 128) = w; } }
    }
};

#define XB_TMO      128
#define XB_XCNT(j)  (256  + 64 * (j))
#define XB_XSUB(j)  (1280 + 64 * (j))
#define XB_XGEN(j)  (2304 + 64 * (j))
#define XB_TOP      3328
#define XB_TOPGEN   3392
#define XCD_BAR_WORDS 3456
#define XB_SPIN_CAP (1u << 18)
__device__ __forceinline__ unsigned xb_ld(unsigned* p)              { return __hip_atomic_load(p, __ATOMIC_RELAXED, __HIP_MEMORY_SCOPE_AGENT); }
__device__ __forceinline__ unsigned xb_add(unsigned* p, unsigned v) { return __hip_atomic_fetch_add(p, v, __ATOMIC_RELAXED, __HIP_MEMORY_SCOPE_AGENT); }
__device__ __forceinline__ unsigned xb_xcc_id() { return (unsigned)__builtin_amdgcn_s_getreg((3 << 11) | 20) & 0xFu; }
#define XB_SPIN(cond, bar) do { unsigned _sp = 0; while (cond) { __builtin_amdgcn_s_sleep(1); \
    if ((++_sp & 255u) == 0u) { if (xb_ld(&(bar)[XB_TMO])) break; if (_sp > XB_SPIN_CAP) { atomicAdd(&(bar)[XB_TMO], 1u); break; } } } } while (0)
struct XcdBarrier { unsigned* bar; unsigned x; volatile LAS unsigned* st; };
__device__ __forceinline__ XcdBarrier xcd_barrier_post(unsigned* bar, volatile LAS unsigned* st) {
    XcdBarrier b; b.bar = bar; b.x = xb_xcc_id(); b.st = st;
    if (threadIdx.x == 0) (void)xb_add(&bar[XB_XCNT(b.x)], 1u);
    return b;
}
__device__ __forceinline__ void xcd_barrier_complete(unsigned* bar, unsigned x, unsigned& nloc, unsigned& nx) {
    const unsigned G = gridDim.x * gridDim.y * gridDim.z;
    unsigned sum, cnt, mine, sp = 0u;
    for (;;) {
        sum = 0u; cnt = 0u; mine = 0u;
#pragma unroll
        for (unsigned j = 0; j < 16; ++j) { const unsigned c = xb_ld(&bar[XB_XCNT(j)]); sum += c; cnt += (c > 0u) ? 1u : 0u; mine = (j == x) ? c : mine; }
        if (sum == G) break;
        __builtin_amdgcn_s_sleep(1);
        if ((++sp & 255u) == 0u) { if (xb_ld(&bar[XB_TMO])) break; if (sp > XB_SPIN_CAP) { atomicAdd(&bar[XB_TMO], 1u); break; } }
    }
    nloc = mine > 0u ? mine : 1u; nx = cnt > 0u ? cnt : 1u;
}
__device__ __forceinline__ void xcd_barrier(const XcdBarrier& b) {
    asm volatile("s_waitcnt vmcnt(0)" ::: "memory");
    __syncthreads();
    if (threadIdx.x == 0) {
        unsigned* bar = b.bar;
        __builtin_amdgcn_s_waitcnt(0);
        unsigned nloc = b.st[0], nx = b.st[1];
        if (nloc == 0u) { xcd_barrier_complete(bar, b.x, nloc, nx); b.st[0] = nloc; b.st[1] = nx; }
        const unsigned old = xb_add(&bar[XB_XSUB(b.x)], 1u);
        const unsigned gen = old / nloc;
        if (old + 1u == (gen + 1u) * nloc) {
            __builtin_amdgcn_fence(__ATOMIC_RELEASE, "agent");
            asm volatile("s_waitcnt vmcnt(0)" ::: "memory");
            const unsigned og = xb_add(&bar[XB_TOP], 1u);
            const unsigned tg = og / nx;
            if (og + 1u == (tg + 1u) * nx) xb_add(&bar[XB_TOPGEN], 1u);
            else XB_SPIN(xb_ld(&bar[XB_TOPGEN]) == tg, bar);
            __builtin_amdgcn_fence(__ATOMIC_ACQUIRE, "agent");
            xb_add(&bar[XB_XGEN(b.x)], 1u);
            asm volatile("s_waitcnt vmcnt(0)" ::: "memory");
        } else {
            XB_SPIN(xb_ld(&bar[XB_XGEN(b.x)]) == gen, bar);
            __builtin_amdgcn_fence(__ATOMIC_ACQUIRE, "agent");
            asm volatile("s_waitcnt vmcnt(0)" ::: "memory");
        }
    }
    __syncthreads();
}

struct Args { const float* in[24]; float* out; unsigned char* ws; int ph_lo, ph_hi; };
struct Frame {
    lds_ptr lds; int tid, lane, wave, G, gw, ngw;
    float* out; unsigned char* ws;
};
enum { I_X = 0, I_META, I_RELB, I_ANORM, I_WIN, I_QNORM, I_WUQ, I_KVNORM, I_WUKV, I_QKNQ, I_QKNK, I_DQN, I_DKN, I_LQ1, I_LK1, I_LQ2, I_LK2, I_SUBLN, I_WOUT, I_FNORM, I_WPQ, I_SUBK, I_PU, I_PV };

__device__ __forceinline__ void transpose_item(const float* W, int ldw, int c0, int K, int N, const float* gain, bf16_t* WT, int row_off, LAS float* scr, int item, int lane) {
    const int nblk = N / 32, kb = item / nblk, nb = item % nblk, k0 = 64 * kb, n0 = 32 * nb;
#pragma unroll 8
    for (int i = 0; i < 32; ++i) { const int kk = 2 * i + (lane >> 5); float v = W[(size_t)(k0 + kk) * ldw + c0 + n0 + (lane & 31)]; if (gain) v *= gain[k0 + kk]; scr[kk * 33 + (lane & 31)] = v; }
    LDS_WAIT(); asm volatile("" ::: "memory");
    const int c = lane & 7;
#pragma unroll
    for (int j = 0; j < 4; ++j) { const int n = (lane >> 3) + 8 * j; const LAS float* s = scr + (8 * c) * 33 + n;
        u32x4 o; o.x = pk2(s[0 * 33], s[1 * 33]); o.y = pk2(s[2 * 33], s[3 * 33]); o.z = pk2(s[4 * 33], s[5 * 33]); o.w = pk2(s[6 * 33], s[7 * 33]);
        *(u32x4*)(WT + (size_t)(row_off + n0 + n) * K + k0 + 8 * c) = o; }
    LDS_WAIT(); asm volatile("" ::: "memory");
}
__device__ __forceinline__ void cvt_row_1024(const float* src, bf16_t* dst, int lane) {
    const f32x4* xr = (const f32x4*)src + lane; f32x4 v[4];
#pragma unroll
    for (int j = 0; j < 4; ++j) v[j] = xr[64 * j];
    u32x2* o8 = (u32x2*)dst + lane;
#pragma unroll
    for (int j = 0; j < 4; ++j) { u32x2 w; w.x = pk2(v[j][0], v[j][1]); w.y = pk2(v[j][2], v[j][3]); o8[64 * j] = w; }
}
__device__ __forceinline__ float cvt_row_1024_ssq(const float* src, bf16_t* dst, int lane) {
    const f32x4* xr = (const f32x4*)src + lane; f32x4 v[4]; float s = 0.f;
#pragma unroll
    for (int j = 0; j < 4; ++j) { v[j] = xr[64 * j]; s += (v[j][0] * v[j][0] + v[j][1] * v[j][1]) + (v[j][2] * v[j][2] + v[j][3] * v[j][3]); }
    u32x2* o8 = (u32x2*)dst + lane;
#pragma unroll
    for (int j = 0; j < 4; ++j) { u32x2 w; w.x = pk2(v[j][0], v[j][1]); w.y = pk2(v[j][2], v[j][3]); o8[64 * j] = w; }
    return wave_sum(s);
}
__device__ __forceinline__ float quant_f32x4x4(const f32x4 (&v)[4], unsigned* dst, int off, int lane) {
    float am = 0.f;
#pragma unroll
    for (int j = 0; j < 4; ++j) am = fmaxf(fmaxf(am, fmaxf(fabsf(v[j][0]), fabsf(v[j][1]))), fmaxf(fabsf(v[j][2]), fabsf(v[j][3])));
#pragma unroll
    for (int o = 1; o < 64; o <<= 1) am = fmaxf(am, __shfl_xor(am, o));
    const float inv = am > 0.f ? 127.0f / am : 0.f;
#pragma unroll
    for (int j = 0; j < 4; ++j) { unsigned w = 0u;
#pragma unroll
        for (int i = 0; i < 4; ++i) { const int q = (int)__builtin_rintf(v[j][i] * inv) + off; w |= ((unsigned)q & 255u) << (8 * i); }
        dst[lane + 64 * j] = w; }
    return am * (1.0f / 127.0f);
}
__device__ __forceinline__ float quant_row_1024_fp8(const float* src, unsigned* dst, int lane) {
    const f32x4* xr = (const f32x4*)src + lane; f32x4 v[4]; float am = 0.f;
#pragma unroll
    for (int j = 0; j < 4; ++j) { v[j] = xr[64 * j]; am = fmaxf(fmaxf(am, fmaxf(fabsf(v[j][0]), fabsf(v[j][1]))), fmaxf(fabsf(v[j][2]), fabsf(v[j][3]))); }
#pragma unroll
    for (int o = 1; o < 64; o <<= 1) am = fmaxf(am, __shfl_xor(am, o));
    const float inv = am > 0.f ? 440.0f / am : 0.f;
#pragma unroll
    for (int j = 0; j < 4; ++j) { int w = __builtin_amdgcn_cvt_pk_fp8_f32(v[j][0] * inv, v[j][1] * inv, 0, false); w = __builtin_amdgcn_cvt_pk_fp8_f32(v[j][2] * inv, v[j][3] * inv, w, true); dst[lane + 64 * j] = (unsigned)w; }
    return am * (1.0f / 440.0f);
}
__device__ __forceinline__ float quant_row_1024(const float* src, unsigned* dst, int off, int lane) {
    const f32x4* xr = (const f32x4*)src + lane; f32x4 v[4];
#pragma unroll
    for (int j = 0; j < 4; ++j) v[j] = xr[64 * j];
    return quant_f32x4x4(v, dst, off, lane);
}
__device__ __forceinline__ void zero_bytes_wave(unsigned char* p, int nbytes, int lane) {
    for (int o = lane * 16; o < nbytes; o += 1024) *(u32x4*)(p + o) = (u32x4){0u, 0u, 0u, 0u};
}
__device__ __forceinline__ void quant_expert_tables(Frame& F, const Args& A) {
    unsigned char* ws = F.ws; const int gw = F.gw, NGW = F.ngw, lane = F.lane;
    { signed char* U8 = (signed char*)(ws + WS_U8); unsigned char* V8 = (unsigned char*)(ws + WS_V8); float* SU = (float*)(ws + WS_SU); float* SV = (float*)(ws + WS_SV);
      for (int it = gw; it < 32768; it += NGW) { const bool isv = it >= 16384; const int e = isv ? it - 16384 : it;
          const float* src = (isv ? A.in[I_PV] : A.in[I_PU]) + (size_t)e * 1024; unsigned* dst = (unsigned*)((isv ? (unsigned char*)V8 : (unsigned char*)U8) + (size_t)e * 1024);
          const float sc = isv ? quant_row_1024_fp8(src, dst, lane) : quant_row_1024(src, dst, 0, lane); if (lane == 0) (isv ? SV : SU)[e] = sc; } }
}
__device__ __forceinline__ void p0_prologue(Frame& F, const Args& A) {
    LAS float* scr = (LAS float*)(F.lds + F.wave * 16384);
    const int gw = F.gw, NGW = F.ngw, lane = F.lane;
    unsigned char* ws = F.ws;
    bf16_t* W1T = (bf16_t*)(ws + WS_W1T); bf16_t* WKR = (bf16_t*)(ws + WS_WKR); bf16_t* WUQ = (bf16_t*)(ws + WS_WUQ); bf16_t* WUKV = (bf16_t*)(ws + WS_WUKV);
    bf16_t* WOUT = (bf16_t*)(ws + WS_WOUT); bf16_t* WPQ = (bf16_t*)(ws + WS_WPQ); bf16_t* SK = (bf16_t*)(ws + WS_SK);
    constexpr int I_A = 16 * 16, I_B = 16 * 48, I_C = 16 * 1, I_D = 4 * 24, I_E = 4 * 32, I_F = 16 * 32, I_G = 16 * 64;
    constexpr int NITEMS = I_A + I_B + I_C + I_D + I_E + I_F + I_G;
    for (int it = gw; it < NITEMS; it += NGW) {
        int r = it;
        if (r < I_A) { transpose_item(A.in[I_WIN], 2080, 0, 1024, 512, A.in[I_ANORM], W1T, 0, scr, r, lane); continue; } r -= I_A;
        if (r < I_B) { transpose_item(A.in[I_WIN], 2080, 544, 1024, 1536, A.in[I_ANORM], W1T, 512, scr, r, lane); continue; } r -= I_B;
        if (r < I_C) { transpose_item(A.in[I_WIN], 2080, 512, 1024, 32, A.in[I_ANORM], WKR, 0, scr, r, lane); continue; } r -= I_C;
        if (r < I_D) { transpose_item(A.in[I_WUQ], 768, 0, 256, 768, A.in[I_QNORM], WUQ, 0, scr, r, lane); continue; } r -= I_D;
        if (r < I_E) { transpose_item(A.in[I_WUKV], 1024, 0, 256, 1024, A.in[I_KVNORM], WUKV, 0, scr, r, lane); continue; } r -= I_E;
        if (r < I_F) { transpose_item(A.in[I_WOUT], 1024, 0, 1024, 1024, nullptr, WOUT, 0, scr, r, lane); continue; } r -= I_F;
        transpose_item(A.in[I_WPQ], 2048, 0, 1024, 2048, A.in[I_FNORM], WPQ, 0, scr, r, lane);
    }
    for (int it = gw; it < 256; it += NGW) cvt_row_1024(A.in[I_SUBK] + (size_t)it * 1024, SK + (size_t)it * 1024, lane);
    { bf16_t* XB = (bf16_t*)(ws + WS_XB); float* RS = (float*)(ws + WS_RSTD1);
      for (int it = gw; it < XB_ROWS; it += NGW) {
          if (it < XB_ZERO) { const float* src = it < MTOK ? A.in[I_X] + (size_t)it * 1024 : A.in[I_META] + (size_t)(it - MTOK) * 1024;
              const float ss = cvt_row_1024_ssq(src, XB + (size_t)it * 1024, lane); if (lane == 0) RS[it] = 1.0f / sqrtf(ss * (1.0f / 1024.0f) + EPS); }
          else { zero_bytes_wave((unsigned char*)(XB + (size_t)it * 1024), 2048, lane); if (lane == 0) RS[it] = 0.f; } } }
    { bf16_t* P1 = (bf16_t*)(ws + WS_P1); bf16_t* KM = (bf16_t*)(ws + WS_KM); bf16_t* VM = (bf16_t*)(ws + WS_VM);
      for (int it = gw; it < BATCH * (LP - LREAL); it += NGW) { const size_t prow = (size_t)(it / (LP - LREAL)) * LP + LREAL + (it % (LP - LREAL));
          zero_bytes_wave((unsigned char*)(P1 + prow * P1W), P1W * 2, lane); zero_bytes_wave((unsigned char*)(KM + prow * 768), 768 * 2, lane);
          zero_bytes_wave((unsigned char*)(VM + prow * 512), 512 * 2, lane); } }
}

__device__ __forceinline__ void p1_meta_tile(Frame& F, int c) {
    const int lane = F.lane, r32 = lane & 31, hi = lane >> 5;
    const bf16_t* W1T = (const bf16_t*)(F.ws + WS_W1T); const bf16_t* XB = (const bf16_t*)(F.ws + WS_XB); const float* RS = (const float*)(F.ws + WS_RSTD1);
    const int xrow = r32 < NMETA ? XB_META + r32 : XB_ZERO;
    const bf16_t* ap = W1T + (size_t)(32 * c + r32) * 1024 + 8 * hi; const bf16_t* bp = XB + (size_t)xrow * 1024 + 8 * hi;
    f32x16 acc = zero16();
#pragma unroll 8
    for (int s = 0; s < 64; ++s) acc = MFMA32(ld_frag(ap + 16 * s), ld_frag(bp + 16 * s), acc);
    const float rs = RS[xrow];
    bf16_t* P1 = (bf16_t*)(F.ws + WS_P1);
    if (r32 < NMETA) {
#pragma unroll
        for (int g = 0; g < 4; ++g) { u32x2 w; w.x = pk2(acc[4 * g] * rs, acc[4 * g + 1] * rs); w.y = pk2(acc[4 * g + 2] * rs, acc[4 * g + 3] * rs);
#pragma unroll
            for (int b = 0; b < BATCH; ++b) *(u32x2*)(P1 + ((size_t)b * LP + r32) * P1W + 32 * c + 8 * g + 4 * hi) = w; }
    }
}

__device__ __forceinline__ void rope_tables(int pos, int hi, float (&cs)[8], float (&sn)[8]) {
#pragma unroll
    for (int r = 0; r < 8; ++r) { const int i = (r & 3) + 8 * (r >> 2) + 4 * hi;
        const double turns = (double)pos * ROPE_INVF[i] * 0.15915494309189535; const float fr = (float)(turns - __builtin_rint(turns));
        sn[r] = __builtin_amdgcn_sinf(fr); cs[r] = __builtin_amdgcn_cosf(fr); }
}
__device__ __forceinline__ void store4(bf16_t* p, float a, float b, float c, float d) { u32x2 w; w.x = pk2(a, b); w.y = pk2(c, d); *(u32x2*)p = w; }

__device__ __forceinline__ void glds16(const void* gsrc, unsigned lds_dst) { unsigned keep;
    asm volatile("s_mov_b32 %0, m0\n\ts_mov_b32 m0, %2\n\ts_nop 0\n\tglobal_load_lds_dwordx4 %1, off\n\ts_mov_b32 m0, %0" : "=&s"(keep) : "v"(gsrc), "s"(lds_dst) : "memory"); }

template <bool KV>
__device__ __forceinline__ void p2_block(Frame& F, int bj, LAS const float* tab) {
    constexpr int NR = KV ? 128 : 96, NCH = NR * 32 / NTHREADS;
    int tid_o = F.tid; asm volatile("" : "+v"(tid_o));
    const int tid = tid_o, lane = tid & 63, r32 = lane & 31, hi = lane >> 5, w = F.wave;
    const int pb = bj * 8 + w; const bool active = (pb < MP / 32) && ((pb % (LP / 32)) != (LP / 32) - 1);
    const size_t prow0 = (size_t)(active ? pb : 0) * 32, prow = prow0 + r32; const int b = (int)(prow / LP), pos = (int)(prow % LP);
    bf16_t* P1 = (bf16_t*)(F.ws + WS_P1);
    const bf16_t* W = (const bf16_t*)(F.ws + (KV ? WS_WUKV : WS_WUQ));
    const lds_ptr lds = F.lds;
    const unsigned lds0 = (unsigned)(size_t)F.lds;
    constexpr int NDI = NR / 2 / NWAVES;
#define P2_WDMA(h, buf) do { _Pragma("unroll") for (int i_ = 0; i_ < NDI; ++i_) { const int row_ = 2 * (w * NDI + i_) + (lane >> 5); \
        glds16(W + ((size_t)(h) * NR + row_) * 256 + (((lane & 31) ^ (row_ & 31)) * 8), (unsigned)__builtin_amdgcn_readfirstlane((int)(lds0 + (buf) * 65536 + (w * NDI + i_) * 1024))); } } while (0)
#define P2_WAIT_BAR() asm volatile("s_waitcnt vmcnt(0) lgkmcnt(0)\n\ts_barrier" ::: "memory")
#define P2_AFRAG(buf, t, s) (*(const LAS bf16x8*)(lds + (buf) * 65536 + ((t) * 32 + r32o) * 512 + (((2 * (s) + hio) ^ r32o) * 16)))
    __syncthreads();
    if (KV) { const bf16_t* WKR = (const bf16_t*)(F.ws + WS_WKR);
#pragma unroll
        for (int i = 0; i < 8; ++i) { const int hr = w * 8 + i, row = hr >> 1, slot = (hr & 1) * 64 + lane;
            glds16(WKR + (size_t)row * 1024 + ((slot ^ (row & 31)) * 8), (unsigned)__builtin_amdgcn_readfirstlane((int)(lds0 + 65536 + hr * 1024))); }
    }
    P2_WDMA(0, 0);
    bf16x8 cf[16]; float ss = 0.f;
#pragma unroll
    for (int s = 0; s < 16; ++s) { const u32x4 wv = *(const u32x4*)(P1 + prow * P1W + (KV ? C_CKV : C_CQ) + 16 * s + 8 * hi); ss += ssq8(wv); cf[s] = __builtin_bit_cast(bf16x8, wv); }
    const float rstd_c = 1.0f / sqrtf(xhalf_sum(ss) * (1.0f / 256.0f) + EPS);
    float cs[8], sn[8]; rope_tables(pos, hi, cs, sn);
    f32x16 kr = zero16(); float krss = 0.f;
    if (KV) {
        const bf16_t* WKR = (const bf16_t*)(F.ws + WS_WKR); const bf16_t* XB = (const bf16_t*)(F.ws + WS_XB); const float* RS = (const float*)(F.ws + WS_RSTD1);
        P2_WAIT_BAR();
        const int xrow = pos < NMETA ? XB_META + pos : (pos < LREAL ? b * SEQ + pos - NMETA : XB_ZERO);
        const bf16_t* bp = XB + (size_t)xrow * 1024 + 8 * hi;
#pragma unroll 8
        for (int s = 0; s < 64; ++s) kr = MFMA32(*(const LAS bf16x8*)(lds + 65536 + r32 * 2048 + (((2 * s + hi) ^ r32) * 16)), ld_frag(bp + 16 * s), kr);
        const float rs1 = RS[xrow];
#pragma unroll
        for (int r = 0; r < 16; ++r) { kr[r] *= rs1; krss = __builtin_fmaf(kr[r], kr[r], krss); }
        __syncthreads();
    } else {
        P2_WAIT_BAR();
    }
    bf16_t* QM = (bf16_t*)(F.ws + WS_QM); bf16_t* KM = (bf16_t*)(F.ws + WS_KM); bf16_t* VM = (bf16_t*)(F.ws + WS_VM);
#pragma unroll 1
    for (int h = 0; h < 8; ++h) {
        const int buf = h & 1;
        int r32o = r32, hio = hi; size_t prowo = prow; asm volatile("" : "+v"(r32o), "+v"(hio), "+v"(prowo));
        if (h + 1 < 8) P2_WDMA(h + 1, buf ^ 1);
        if (active) {
            if (!KV) {
                f32x16 acc[3];
#pragma unroll
                for (int t = 0; t < 3; ++t) { acc[t] = zero16();
#pragma unroll
                    for (int s = 0; s < 16; ++s) { acc[t] = MFMA32(P2_AFRAG(buf, t, s), cf[s], acc[t]); if ((s & 3) == 3) __builtin_amdgcn_sched_barrier(0); } }
                float s2 = 0.f;
#pragma unroll
                for (int t = 0; t < 3; ++t)
#pragma unroll
                    for (int r = 0; r < 16; ++r) { acc[t][r] *= rstd_c; s2 = __builtin_fmaf(acc[t][r], acc[t][r], s2); }
                const float rn = 1.0f / sqrtf(xhalf_sum(s2) * (1.0f / 96.0f) + EPS);
#pragma unroll
                for (int t = 0; t < 3; ++t)
#pragma unroll
                    for (int g = 0; g < 4; ++g) { const f32x4 gn = *(LAS const f32x4*)(tab + t * 32 + 8 * g + 4 * hio);
#pragma unroll
                        for (int j = 0; j < 4; ++j) acc[t][4 * g + j] *= rn * gn[j]; }
#pragma unroll
                for (int r = 0; r < 8; ++r) { const float x1 = acc[2][r], x2 = acc[2][r + 8]; acc[2][r] = x1 * cs[r] - x2 * sn[r]; acc[2][r + 8] = x1 * sn[r] + x2 * cs[r]; }
                bf16_t* qp = QM + prowo * 768 + h * 96 + 4 * hio;
#pragma unroll
                for (int t = 0; t < 3; ++t)
#pragma unroll
                    for (int g = 0; g < 4; ++g) store4(qp + t * 32 + 8 * g, acc[t][4 * g] * QS_MLA, acc[t][4 * g + 1] * QS_MLA, acc[t][4 * g + 2] * QS_MLA, acc[t][4 * g + 3] * QS_MLA);
            } else {
                {
                    f32x16 acc[2];
#pragma unroll
                    for (int t = 0; t < 2; ++t) { acc[t] = zero16();
#pragma unroll
                        for (int s = 0; s < 16; ++s) { acc[t] = MFMA32(P2_AFRAG(buf, t, s), cf[s], acc[t]); if ((s & 3) == 3) __builtin_amdgcn_sched_barrier(0); } }
                    float s2 = krss;
#pragma unroll
                    for (int t = 0; t < 2; ++t)
#pragma unroll
                        for (int r = 0; r < 16; ++r) { acc[t][r] *= rstd_c; s2 = __builtin_fmaf(acc[t][r], acc[t][r], s2); }
                    const float rn = 1.0f / sqrtf(xhalf_sum(s2) * (1.0f / 96.0f) + EPS);
                    bf16_t* kp = KM + prowo * 768 + h * 96 + 4 * hio;
#pragma unroll
                    for (int t = 0; t < 2; ++t)
#pragma unroll
                        for (int g = 0; g < 4; ++g) { const f32x4 gn = *(LAS const f32x4*)(tab + 96 + t * 32 + 8 * g + 4 * hio);
                            store4(kp + t * 32 + 8 * g, acc[t][4 * g] * rn * gn[0], acc[t][4 * g + 1] * rn * gn[1], acc[t][4 * g + 2] * rn * gn[2], acc[t][4 * g + 3] * rn * gn[3]); }
                    float kn[16];
#pragma unroll
                    for (int g = 0; g < 4; ++g) { const f32x4 gn = *(LAS const f32x4*)(tab + 96 + 64 + 8 * g + 4 * hio);
#pragma unroll
                        for (int j = 0; j < 4; ++j) kn[4 * g + j] = kr[4 * g + j] * rn * gn[j]; }
#pragma unroll
                    for (int r = 0; r < 8; ++r) { const float x1 = kn[r], x2 = kn[r + 8]; kn[r] = x1 * cs[r] - x2 * sn[r]; kn[r + 8] = x1 * sn[r] + x2 * cs[r]; }
#pragma unroll
                    for (int g = 0; g < 4; ++g) store4(kp + 64 + 8 * g, kn[4 * g], kn[4 * g + 1], kn[4 * g + 2], kn[4 * g + 3]);
                }
                {
                    f32x16 acc[2];
#pragma unroll
                    for (int t = 0; t < 2; ++t) { acc[t] = zero16();
#pragma unroll
                        for (int s = 0; s < 16; ++s) { acc[t] = MFMA32(P2_AFRAG(buf, 2 + t, s), cf[s], acc[t]); if ((s & 3) == 3) __builtin_amdgcn_sched_barrier(0); } }
                    bf16_t* vp = VM + prowo * 512 + h * 64 + 4 * hio;
#pragma unroll
                    for (int t = 0; t < 2; ++t)
#pragma unroll
                        for (int g = 0; g < 4; ++g) store4(vp + t * 32 + 8 * g, acc[t][4 * g] * rstd_c, acc[t][4 * g + 1] * rstd_c, acc[t][4 * g + 2] * rstd_c, acc[t][4 * g + 3] * rstd_c);
                }
            }
        }
        P2_WAIT_BAR();
    }
#undef P2_WDMA
#undef P2_WAIT_BAR
#undef P2_AFRAG
    if (!KV && active) {
        float gq[8], gk[8];
#pragma unroll
        for (int j = 0; j < 8; ++j) { gq[j] = tab[192 + (lane & 7) * 8 + j] * QS_DIFF; gk[j] = tab[256 + (lane & 7) * 8 + j]; }
#pragma unroll 4
        for (int rr = 0; rr < 32; ++rr) {
            bf16_t* qrow = P1 + (prow0 + rr) * P1W + C_DQ + lane * 8; bf16_t* krow = P1 + (prow0 + rr) * P1W + C_DK + lane * 8;
            const u32x4 wq = *(const u32x4*)qrow, wk = *(const u32x4*)krow;
            float sq = ssq8(wq), sk = ssq8(wk);
            sq += __shfl_xor(sq, 1); sk += __shfl_xor(sk, 1); sq += __shfl_xor(sq, 2); sk += __shfl_xor(sk, 2); sq += __shfl_xor(sq, 4); sk += __shfl_xor(sk, 4);
            const float rq = 1.0f / sqrtf(sq * (1.0f / 64.0f) + EPS), rk = 1.0f / sqrtf(sk * (1.0f / 64.0f) + EPS);
            u32x4 oq, ok;
#pragma unroll
            for (int i = 0; i < 4; ++i) { oq[i] = pk2(bf_lo(wq[i]) * rq * gq[2 * i], bf_hi(wq[i]) * rq * gq[2 * i + 1]); ok[i] = pk2(bf_lo(wk[i]) * rk * gk[2 * i], bf_hi(wk[i]) * rk * gk[2 * i + 1]); }
            *(u32x4*)qrow = oq; *(u32x4*)krow = ok;
        }
    }
}

template <bool DIFF, bool FIXED>
__device__ __forceinline__ void attn_unit(Frame& F, int b, int h, int qt, LAS const float* btab, float bref) {
    constexpr int NDS = DIFF ? 4 : 6;
    constexpr int NVB = DIFF ? 4 : 2;
    constexpr int QROWS = DIFF ? 128 : 256;
    constexpr int KCH = DIFF ? 16 : 12;
    constexpr int KBYTES = KCH * 1024, VBYTES = NVB * 4096, TILEB = KBYTES + VBYTES;
    int lane_o = F.lane; asm volatile("" : "+v"(lane_o));
    const int tid = F.tid, lane = lane_o, r32 = lane & 31, hi = lane >> 5, w = F.wave;
    const int map = DIFF ? (w >> 2) : 0, wq = DIFF ? (w & 3) : w;
    const bf16_t* Qg; const bf16_t* Kg; const bf16_t* Vg; int qpitch, kpitch, vpitch;
    if (DIFF) { const bf16_t* P1 = (const bf16_t*)(F.ws + WS_P1); Qg = P1 + C_DQ + h * 128 + map * 64; Kg = P1 + C_DK + h * 128; Vg = P1 + C_DV + h * 128; qpitch = kpitch = vpitch = P1W; }
    else { Qg = (const bf16_t*)(F.ws + WS_QM) + h * 96; Kg = (const bf16_t*)(F.ws + WS_KM) + h * 96; Vg = (const bf16_t*)(F.ws + WS_VM) + h * 64; qpitch = kpitch = 768; vpitch = 512; }
    const size_t brow = (size_t)b * LP;
    const int qpos0 = NMETA + qt * QROWS + wq * 32;
    const int qpos = qpos0 + r32;
    const int NT = (NMETA + qt * QROWS + QROWS + 63) >> 6;
    const int tlast = (qpos0 + 31) >> 6;
    bf16x8 qf[NDS];
#pragma unroll
    for (int d0 = 0; d0 < NDS; ++d0) qf[d0] = ld_frag(Qg + (brow + qpos) * qpitch + 16 * d0 + 8 * hi);
    __builtin_amdgcn_s_waitcnt(0x0F70);
#pragma unroll
    for (int d0 = 0; d0 < NDS; ++d0) asm volatile("" : "+v"(qf[d0]));
    constexpr int NPW = DIFF ? 4 : 3;
    const int kc1 = DIFF ? (w + 8) : (8 + (w & 3));
    const bf16_t* ksrc0 = Kg + (brow + lane) * kpitch + w * 8;
    const bf16_t* ksrc1 = Kg + (brow + lane) * kpitch + kc1 * 8;
    const bf16_t* vsrc0 = Vg + (brow + 16 * (w & 3) + (lane >> 2)) * vpitch + (w >> 2) * 32 + (lane & 3) * 8;
    const bf16_t* vsrc1 = Vg + (brow + 16 * (w & 3) + (lane >> 2)) * vpitch + ((w + 8) >> 2) * 32 + (lane & 3) * 8;
    const lds_ptr lds = F.lds; const unsigned lds0 = (unsigned)(size_t)F.lds;
    const int kdst0 = w * 1024, kdst1 = kc1 * 1024, vdst0 = KBYTES + w * 1024, vdst1 = KBYTES + (w + 8) * 1024;
    const int kbase = (DIFF ? map * 8192 : 0) + hi * 1024 + r32 * 16;
    const int vbase = KBYTES + ((lane >> 4) & 1) * 32 + (lane & 3) * 8 + (4 * hi + ((lane & 15) >> 2)) * 64;
#define ATT_GLDS(src, dst) glds16((src), (unsigned)__builtin_amdgcn_readfirstlane((int)(lds0 + (unsigned)(dst))))
#define ATT_DMA(t, so) do { const size_t to_ = (size_t)(t) * 64; ATT_GLDS(ksrc0 + to_ * kpitch, (so) + kdst0); ATT_GLDS(ksrc1 + to_ * kpitch, (so) + kdst1); \
        ATT_GLDS(vsrc0 + to_ * vpitch, (so) + vdst0); if (DIFF) ATT_GLDS(vsrc1 + to_ * vpitch, (so) + vdst1); } while (0)
#define ATT_WAIT_BAR(n) asm volatile("s_waitcnt vmcnt(" #n ") lgkmcnt(0)\n\ts_barrier" ::: "memory")
    float m_run = FIXED ? bref : 0.f, l_run = 0.f; f32x16 o[NVB];
#pragma unroll
    for (int v = 0; v < NVB; ++v) o[v] = zero16();
    const float bfar = DIFF ? btab[512 + h] : 0.f;
    f32x16 cini;
#pragma unroll
    for (int r = 0; r < 16; ++r) cini[r] = bfar - m_run;
    const bool grpB = (w >= 4);
    __syncthreads();
    ATT_DMA(0, 0); ATT_DMA(1, TILEB);
    if (DIFF) ATT_WAIT_BAR(4); else ATT_WAIT_BAR(3);
    int so_cur = 0, so_nn = 2 * TILEB;
    for (int t = 0; t < NT; ++t) {
        if (t + 2 < NT) ATT_DMA(t + 2, so_nn);
        const bool act = (t <= tlast);
        bf16x8 pa[4]; s16x4 vlo[2][NVB], vhi[2][NVB];
        if (act) {
            const lds_cptr kp = (lds_cptr)lds + so_cur + kbase;
            f32x16 p0, p1;
            bf16x8 kf0[NDS], kf1[NDS];
#pragma unroll
            for (int d0 = 0; d0 < NDS; ++d0) { kf0[d0] = *(const LAS bf16x8*)(kp + d0 * 2048); kf1[d0] = *(const LAS bf16x8*)(kp + d0 * 2048 + 512); }
            __builtin_amdgcn_sched_barrier(0);
            const int kpos0 = 64 * t + 4 * hi;
            if (DIFF && !(qpos0 - (64 * t + 63) >= 113)) {
                LAS const float* bt = btab + h * 128;
#pragma unroll
                for (int r = 0; r < 16; ++r) { const int d0_ = qpos - (kpos0 + (r & 3) + 8 * (r >> 2)); const int d1_ = d0_ - 32;
                    p0[r] = bt[min(max(d0_, 0), 127)] - m_run; p1[r] = bt[min(max(d1_, 0), 127)] - m_run; }
            } else { p0 = cini; p1 = cini; }
#pragma unroll
            for (int d0 = 0; d0 < NDS; ++d0) { p0 = MFMA32(kf0[d0], qf[d0], p0); p1 = MFMA32(kf1[d0], qf[d0], p1); }
            if (64 * t + 63 > qpos0) {
#pragma unroll
                for (int r = 0; r < 16; ++r) { const int kv = kpos0 + (r & 3) + 8 * (r >> 2); if (kv > qpos) p0[r] = -INFINITY; if (kv + 32 > qpos) p1[r] = -INFINITY; }
            }
            if (!FIXED) {
            float mx;
            { float a_ = fmaxf(fmaxf(p0[0], p0[1]), p1[0]), b_ = fmaxf(fmaxf(p0[2], p0[3]), p1[1]); a_ = fmaxf(fmaxf(a_, p1[2]), p1[3]);
#pragma unroll
              for (int r = 4; r < 16; r += 4) { a_ = fmaxf(fmaxf(a_, p0[r]), p0[r + 1]); b_ = fmaxf(fmaxf(b_, p0[r + 2]), p0[r + 3]); a_ = fmaxf(fmaxf(a_, p1[r]), p1[r + 1]); b_ = fmaxf(fmaxf(b_, p1[r + 2]), p1[r + 3]); }
              const float m_ = fmaxf(a_, b_); auto rr = __builtin_amdgcn_permlane32_swap(__float_as_uint(m_), __float_as_uint(m_), false, false);
              mx = fmaxf(__uint_as_float(rr[0]), __uint_as_float(rr[1])); }
            if (t == 0 || __any(mx > SM_THR)) {
                const float dl = (t == 0) ? mx : fmaxf(mx, 0.f); const float al = (t == 0) ? 0.f : __builtin_amdgcn_exp2f(-dl);
                m_run += dl; l_run *= al;
#pragma unroll
                for (int v = 0; v < NVB; ++v)
#pragma unroll
                    for (int r = 0; r < 16; ++r) o[v][r] *= al;
#pragma unroll
                for (int r = 0; r < 16; ++r) { p0[r] -= dl; p1[r] -= dl; cini[r] = bfar - m_run; }
            }
            }
            { const lds_cptr vp = (lds_cptr)lds + so_cur + vbase;
#pragma unroll
              for (int v = 0; v < NVB; ++v) { vlo[0][v] = vtr(vp + v * 4096); vhi[0][v] = vtr(vp + v * 4096 + 512); } }
            __builtin_amdgcn_sched_barrier(0);
            float ls = 0.f;
#pragma unroll
            for (int r = 0; r < 16; ++r) { p0[r] = __builtin_amdgcn_exp2f(p0[r]); p1[r] = __builtin_amdgcn_exp2f(p1[r]); ls = (ls + p0[r]) + p1[r]; }
            l_run += ls;
            { u32x4 a0, a1, a2, a3;
#pragma unroll
              for (int i = 0; i < 4; ++i) { a0[i] = pk2(p0[2 * i], p0[2 * i + 1]); a1[i] = pk2(p0[8 + 2 * i], p0[9 + 2 * i]); a2[i] = pk2(p1[2 * i], p1[2 * i + 1]); a3[i] = pk2(p1[8 + 2 * i], p1[9 + 2 * i]); }
              pa[0] = __builtin_bit_cast(bf16x8, a0); pa[1] = __builtin_bit_cast(bf16x8, a1); pa[2] = __builtin_bit_cast(bf16x8, a2); pa[3] = __builtin_bit_cast(bf16x8, a3); }
        }
        if (grpB) { if (t + 2 < NT) { if (DIFF) ATT_WAIT_BAR(4); else ATT_WAIT_BAR(3); } else ATT_WAIT_BAR(0); }
        if (act) {
            const lds_cptr vp = (lds_cptr)lds + so_cur + vbase;
#pragma unroll
            for (int s = 0; s < 4; ++s) {
                if (s < 3) {
#pragma unroll
                    for (int v = 0; v < NVB; ++v) { vlo[(s + 1) & 1][v] = vtr(vp + v * 4096 + (s + 1) * 1024); vhi[(s + 1) & 1][v] = vtr(vp + v * 4096 + (s + 1) * 1024 + 512); }
                }
                __builtin_amdgcn_sched_barrier(0);
#pragma unroll
                for (int v = 0; v < NVB; ++v) { const s16x4 lo = vlo[s & 1][v], hi4 = vhi[s & 1][v];
                    const bf16x8 vf = (bf16x8){lo[0], lo[1], lo[2], lo[3], hi4[0], hi4[1], hi4[2], hi4[3]};
                    o[v] = MFMA32(vf, pa[s], o[v]); }
                __builtin_amdgcn_sched_barrier(0);
            }
        }
        if (!grpB) { if (t + 2 < NT) { if (DIFF) ATT_WAIT_BAR(4); else ATT_WAIT_BAR(3); } else ATT_WAIT_BAR(0); }
        so_nn = (so_nn == 3 * TILEB) ? 0 : so_nn + TILEB; so_cur = (so_cur == 3 * TILEB) ? 0 : so_cur + TILEB;
    }
    __syncthreads();
#undef ATT_GLDS
#undef ATT_DMA
#undef ATT_WAIT_BAR
    const float inv = 1.0f / xhalf_sum(l_run);
    const int tok = b * SEQ + (qpos - NMETA);
    bf16_t* Y = (bf16_t*)(F.ws + WS_Y);
    if (!DIFF) {
        bf16_t* yp = Y + (size_t)tok * 1024 + h * 64 + 4 * hi;
#pragma unroll
        for (int v = 0; v < NVB; ++v)
#pragma unroll
            for (int g = 0; g < 4; ++g) { const float z_ = PROBE_ZERO_MLA ? 0.f : inv; store4(yp + v * 32 + 8 * g, o[v][4 * g] * z_, o[v][4 * g + 1] * z_, o[v][4 * g + 2] * z_, o[v][4 * g + 3] * z_); }
    } else {
        LAS float* xch = (LAS float*)lds + (size_t)wq * 4096 + lane;
        if (map == 1) {
#pragma unroll
            for (int v = 0; v < NVB; ++v)
#pragma unroll
                for (int r = 0; r < 16; ++r) xch[(v * 16 + r) * 64] = o[v][r] * inv;
        }
        __syncthreads();
        if (map == 0) {
            const float lam = btab[516]; float s2 = 0.f;
#pragma unroll
            for (int v = 0; v < NVB; ++v)
#pragma unroll
                for (int r = 0; r < 16; ++r) { const float d = o[v][r] * inv - lam * xch[(v * 16 + r) * 64]; o[v][r] = d; s2 += d * d; }
            const float rn = (1.0f - LAMBDA_INIT) / sqrtf(xhalf_sum(s2) * (1.0f / 128.0f) + EPS);
            bf16_t* yp = Y + (size_t)tok * 1024 + 512 + h * 128 + 4 * hi;
#pragma unroll
            for (int v = 0; v < NVB; ++v)
#pragma unroll
                for (int g = 0; g < 4; ++g) { const f32x4 gn = *(LAS const f32x4*)(btab + 520 + v * 32 + 8 * g + 4 * hi);
                    store4(yp + v * 32 + 8 * g, o[v][4 * g] * rn * gn[0], o[v][4 * g + 1] * rn * gn[1], o[v][4 * g + 2] * rn * gn[2], o[v][4 * g + 3] * rn * gn[3]); }
        }
    }
}

__device__ __forceinline__ void attn_unit_mla2(Frame& F, int b, int h, int qt, float bref) {
    constexpr int NDS = 6, NVB = 2, QROWS = 512, KBYTES = 12 * 1024, VBYTES = NVB * 4096, TILEB = KBYTES + VBYTES;
    int lane_o = F.lane; asm volatile("" : "+v"(lane_o));
    const int lane = lane_o, r32 = lane & 31, hi = lane >> 5, w = F.wave;
    const bf16_t* Qg = (const bf16_t*)(F.ws + WS_QM) + h * 96; const bf16_t* Kg = (const bf16_t*)(F.ws + WS_KM) + h * 96; const bf16_t* Vg = (const bf16_t*)(F.ws + WS_VM) + h * 64;
    constexpr int qpitch = 768, kpitch = 768, vpitch = 512;
    const size_t brow = (size_t)b * LP;
    const int qposA0 = NMETA + qt * QROWS + w * 64, qposB0 = qposA0 + 32, qposA = qposA0 + r32, qposB = qposB0 + r32;
    const int NT = (NMETA + qt * QROWS + QROWS + 63) >> 6, tlast = (qposB0 + 31) >> 6;
    bf16x8 qa[NDS], qb[NDS];
#pragma unroll
    for (int d0 = 0; d0 < NDS; ++d0) { qa[d0] = ld_frag(Qg + (brow + qposA) * qpitch + 16 * d0 + 8 * hi); qb[d0] = ld_frag(Qg + (brow + qposB) * qpitch + 16 * d0 + 8 * hi); }
    __builtin_amdgcn_s_waitcnt(0x0F70);
#pragma unroll
    for (int d0 = 0; d0 < NDS; ++d0) asm volatile("" : "+v"(qa[d0]), "+v"(qb[d0]));
    const int kc1 = 8 + (w & 3);
    const bf16_t* ksrc0 = Kg + (brow + lane) * kpitch + w * 8;
    const bf16_t* ksrc1 = Kg + (brow + lane) * kpitch + kc1 * 8;
    const bf16_t* vsrc0 = Vg + (brow + 16 * (w & 3) + (lane >> 2)) * vpitch + (w >> 2) * 32 + (lane & 3) * 8;
    const lds_ptr lds = F.lds; const unsigned lds0 = (unsigned)(size_t)F.lds;
    const int kdst0 = w * 1024, kdst1 = kc1 * 1024, vdst0 = KBYTES + w * 1024;
    const int kbase = hi * 1024 + r32 * 16;
    const int vbase = KBYTES + ((lane >> 4) & 1) * 32 + (lane & 3) * 8 + (4 * hi + ((lane & 15) >> 2)) * 64;
#define AM2_GLDS(src, dst) glds16((src), (unsigned)__builtin_amdgcn_readfirstlane((int)(lds0 + (unsigned)(dst))))
#define AM2_DMA(t, so) do { const size_t to_ = (size_t)(t) * 64; AM2_GLDS(ksrc0 + to_ * kpitch, (so) + kdst0); AM2_GLDS(ksrc1 + to_ * kpitch, (so) + kdst1); AM2_GLDS(vsrc0 + to_ * vpitch, (so) + vdst0); } while (0)
#define AM2_WAIT_BAR(n) asm volatile("s_waitcnt vmcnt(" #n ") lgkmcnt(0)\n\ts_barrier" ::: "memory")
    float la = 0.f, lb = 0.f; f32x16 oa[NVB], ob[NVB];
    float one_o = 1.0f; asm volatile("" : "+v"(one_o));
#pragma unroll
    for (int v = 0; v < NVB; ++v) { oa[v] = zero16(); ob[v] = zero16(); }
    (void)bref;
    const bool grpB = (w >= 4);
    __syncthreads();
    AM2_DMA(0, 0); AM2_DMA(1, TILEB);
    AM2_WAIT_BAR(3);
    int so_cur = 0, so_nn = 2 * TILEB;
    for (int t = 0; t < NT; ++t) {
        if (t + 2 < NT) AM2_DMA(t + 2, so_nn);
        const bool act = (t <= tlast);
        bf16x8 pa[4], pb[4];
        if (act) {
            const lds_cptr kp = (lds_cptr)lds + so_cur + kbase;
            f32x16 a0 = zero16(), a1 = zero16(), b0 = zero16(), b1 = zero16();
#pragma unroll
            for (int d0 = 0; d0 < NDS; ++d0) { const bf16x8 k0 = *(const LAS bf16x8*)(kp + d0 * 2048), k1 = *(const LAS bf16x8*)(kp + d0 * 2048 + 512);
                a0 = MFMA32(k0, qa[d0], a0); b0 = MFMA32(k0, qb[d0], b0); a1 = MFMA32(k1, qa[d0], a1); b1 = MFMA32(k1, qb[d0], b1);
                if (d0 & 1) __builtin_amdgcn_sched_barrier(0); }
            if (64 * t + 63 > qposA0) {
                const int kpos0 = 64 * t + 4 * hi;
#pragma unroll
                for (int r = 0; r < 16; ++r) { const int kv = kpos0 + (r & 3) + 8 * (r >> 2);
                    if (kv > qposA) a0[r] = -INFINITY; if (kv + 32 > qposA) a1[r] = -INFINITY; if (kv > qposB) b0[r] = -INFINITY; if (kv + 32 > qposB) b1[r] = -INFINITY; }
            }
            { float ls = 0.f;
#pragma unroll
              for (int r = 0; r < 16; ++r) { a0[r] = __builtin_amdgcn_exp2f(a0[r]); a1[r] = __builtin_amdgcn_exp2f(a1[r]); ls = (ls + a0[r]) + a1[r]; }
              la += ls; u32x4 x0, x1, x2, x3;
#pragma unroll
              for (int i = 0; i < 4; ++i) { x0[i] = pk2(a0[2 * i], a0[2 * i + 1]); x1[i] = pk2(a0[8 + 2 * i], a0[9 + 2 * i]); x2[i] = pk2(a1[2 * i], a1[2 * i + 1]); x3[i] = pk2(a1[8 + 2 * i], a1[9 + 2 * i]); }
              pa[0] = __builtin_bit_cast(bf16x8, x0); pa[1] = __builtin_bit_cast(bf16x8, x1); pa[2] = __builtin_bit_cast(bf16x8, x2); pa[3] = __builtin_bit_cast(bf16x8, x3); }
            __builtin_amdgcn_sched_barrier(0);
            { float ls = 0.f;
#pragma unroll
              for (int r = 0; r < 16; ++r) { b0[r] = __builtin_amdgcn_exp2f(b0[r]); b1[r] = __builtin_amdgcn_exp2f(b1[r]); ls = __builtin_fmaf(b1[r], one_o, __builtin_fmaf(b0[r], one_o, ls)); }
              lb += ls; u32x4 x0, x1, x2, x3;
#pragma unroll
              for (int i = 0; i < 4; ++i) { x0[i] = pk2(b0[2 * i], b0[2 * i + 1]); x1[i] = pk2(b0[8 + 2 * i], b0[9 + 2 * i]); x2[i] = pk2(b1[2 * i], b1[2 * i + 1]); x3[i] = pk2(b1[8 + 2 * i], b1[9 + 2 * i]); }
              pb[0] = __builtin_bit_cast(bf16x8, x0); pb[1] = __builtin_bit_cast(bf16x8, x1); pb[2] = __builtin_bit_cast(bf16x8, x2); pb[3] = __builtin_bit_cast(bf16x8, x3); }
        }
        if (grpB) { if (t + 2 < NT) AM2_WAIT_BAR(3); else AM2_WAIT_BAR(0); }
        if (act) {
            const lds_cptr vp = (lds_cptr)lds + so_cur + vbase;
#pragma unroll
            for (int ks = 0; ks < 4; ++ks)
#pragma unroll
                for (int v = 0; v < NVB; ++v) { const s16x4 lo = vtr(vp + v * 4096 + ks * 1024), hi4 = vtr(vp + v * 4096 + ks * 1024 + 512);
                    const bf16x8 vf = (bf16x8){lo[0], lo[1], lo[2], lo[3], hi4[0], hi4[1], hi4[2], hi4[3]};
                    oa[v] = MFMA32(vf, pa[ks], oa[v]); ob[v] = MFMA32(vf, pb[ks], ob[v]); }
        }
        if (!grpB) { if (t + 2 < NT) AM2_WAIT_BAR(3); else AM2_WAIT_BAR(0); }
        so_nn = (so_nn == 3 * TILEB) ? 0 : so_nn + TILEB; so_cur = (so_cur == 3 * TILEB) ? 0 : so_cur + TILEB;
    }
    __syncthreads();
#undef AM2_GLDS
#undef AM2_DMA
#undef AM2_WAIT_BAR
    const float inva = 1.0f / xhalf_sum(la), invb = 1.0f / xhalf_sum(lb);
    bf16_t* Y = (bf16_t*)(F.ws + WS_Y);
    bf16_t* ya = Y + (size_t)(b * SEQ + (qposA - NMETA)) * 1024 + h * 64 + 4 * hi; bf16_t* yb = Y + (size_t)(b * SEQ + (qposB - NMETA)) * 1024 + h * 64 + 4 * hi;
#pragma unroll
    for (int v = 0; v < NVB; ++v)
#pragma unroll
        for (int g = 0; g < 4; ++g) { store4(ya + v * 32 + 8 * g, oa[v][4 * g] * inva, oa[v][4 * g + 1] * inva, oa[v][4 * g + 2] * inva, oa[v][4 * g + 3] * inva);
                                      store4(yb + v * 32 + 8 * g, ob[v][4 * g] * invb, ob[v][4 * g + 1] * invb, ob[v][4 * g + 2] * invb, ob[v][4 * g + 3] * invb); }
}

__device__ __forceinline__ int f2key(float f) { const int b = __float_as_int(f); return b ^ ((b >> 31) & 0x7fffffff); }
__device__ __forceinline__ float key2f(int k) { return __int_as_float(k ^ ((k >> 31) & 0x7fffffff)); }
#define TOPK_INS(top, x) do { int x_ = (x); _Pragma("unroll") for (int i_ = 0; i_ < 16; ++i_) { const int hi_ = max(top[i_], x_); x_ = min(top[i_], x_); top[i_] = hi_; } } while (0)
#define CE_DESC(a, b) do { const int hi_ = max((a), (b)); const int lo_ = min((a), (b)); (a) = hi_; (b) = lo_; } while (0)
__device__ __forceinline__ void sort16_desc(int (&x)[16]) {
#pragma unroll
    for (int k = 2; k <= 16; k <<= 1)
#pragma unroll
        for (int j = k >> 1; j > 0; j >>= 1)
#pragma unroll
            for (int i = 0; i < 16; ++i) { const int l = i ^ j; if (l > i) { if ((i & k) == 0) CE_DESC(x[i], x[l]); else CE_DESC(x[l], x[i]); } }
}
__device__ __forceinline__ void merge16_desc(int (&top)[16], const int (&x)[16]) {
#pragma unroll
    for (int i = 0; i < 16; ++i) top[i] = max(top[i], x[15 - i]);
#pragma unroll
    for (int j = 8; j > 0; j >>= 1)
#pragma unroll
        for (int i = 0; i < 16; ++i) { const int l = i ^ j; if (l > i) CE_DESC(top[i], top[l]); }
}
__device__ __forceinline__ void p7_job(Frame& F, int tb, int h) {
    const int lane = F.lane, r32 = lane & 31, hi = lane >> 5;
    const bf16_t* QP = (const bf16_t*)(F.ws + WS_QP);
    const int tok = tb * 32 + r32;
    int s1[16], s2[16];
#pragma unroll 1
    for (int p = 0; p < 2; ++p) {
        bf16x8 qf[8];
#pragma unroll
        for (int s = 0; s < 8; ++s) qf[s] = ld_frag(QP + (size_t)tok * 2048 + h * 256 + p * 128 + 16 * s + 8 * hi);
        int top[16];
#pragma unroll
        for (int i = 0; i < 16; ++i) top[i] = (int)0x80000000;
#pragma unroll 1
        for (int kt = 0; kt < 4; ++kt) {
            f32x16 sc = zero16(); const lds_cptr ap = (lds_cptr)F.lds + (p * 128 + kt * 32 + r32) * 256;
#pragma unroll
            for (int s = 0; s < 8; ++s) sc = MFMA32(*(const LAS bf16x8*)(ap + (((2 * s + hi) ^ (r32 & 15)) * 16)), qf[s], sc);
            int x[16];
#pragma unroll
            for (int r = 0; r < 16; ++r) x[r] = (f2key(sc[r]) & ~127) | (kt * 32 + (r & 3) + 8 * (r >> 2) + 4 * hi);
            sort16_desc(x); merge16_desc(top, x);
        }
        int oth[16];
#pragma unroll
        for (int i = 0; i < 16; ++i) oth[i] = __shfl_xor(top[i], 32);
        merge16_desc(top, oth);
#pragma unroll
        for (int i = 0; i < 16; ++i) { if (p == 0) s1[i] = top[i]; else s2[i] = top[i]; }
    }
    float a1[16], a2[16];
#pragma unroll
    for (int i = 0; i < 16; ++i) { a1[i] = key2f(s1[i] & ~127); a2[i] = key2f(s2[i] & ~127); }
#define CAND(i, j) ((f2key(a1[i] + a2[j]) & ~255) | ((i) << 4) | (j))
    int best[16], ca[16], cb[16];
#pragma unroll
    for (int j = 0; j < 16; ++j) best[j] = CAND(0, j);
    ca[0] = CAND(1, 0); ca[1] = CAND(1, 1); ca[2] = CAND(1, 2); ca[3] = CAND(1, 3); ca[4] = CAND(1, 4); ca[5] = CAND(1, 5); ca[6] = CAND(1, 6); ca[7] = CAND(1, 7);
    ca[8] = CAND(2, 0); ca[9] = CAND(2, 1); ca[10] = CAND(2, 2); ca[11] = CAND(2, 3); ca[12] = CAND(2, 4); ca[13] = CAND(3, 0); ca[14] = CAND(3, 1); ca[15] = CAND(3, 2);
    cb[0] = CAND(3, 3); cb[1] = CAND(4, 0); cb[2] = CAND(4, 1); cb[3] = CAND(4, 2); cb[4] = CAND(5, 0); cb[5] = CAND(5, 1); cb[6] = CAND(6, 0); cb[7] = CAND(6, 1);
    cb[8] = CAND(7, 0); cb[9] = CAND(7, 1); cb[10] = CAND(8, 0); cb[11] = CAND(9, 0); cb[12] = CAND(10, 0); cb[13] = CAND(11, 0); cb[14] = CAND(12, 0); cb[15] = CAND(13, 0);
    sort16_desc(ca); merge16_desc(best, ca); sort16_desc(cb); merge16_desc(best, cb);
    TOPK_INS(best, CAND(14, 0)); TOPK_INS(best, CAND(15, 0));
#undef CAND
    LAS int* st = (LAS int*)(F.lds + 65536 + F.wave * 8192) + lane;
#pragma unroll
    for (int i = 0; i < 16; ++i) { st[i * 64] = s1[i] & 127; st[(16 + i) * 64] = s2[i] & 127; }
    float bv[8]; int ex[8];
#pragma unroll
    for (int k = 0; k < 8; ++k) { const int bk = hi ? best[8 + k] : best[k]; const int ci = (bk >> 4) & 15, cj = bk & 15;
        ex[k] = st[ci * 64] * 128 + st[(16 + cj) * 64]; bv[k] = key2f(bk & ~255); }
    float rs2;
    { const f32x4* sp = (const f32x4*)((const float*)(F.ws + WS_SSQP) + (size_t)tok * 16); const f32x4 a = sp[0], b = sp[1], c = sp[2], d = sp[3];
      const float ssq = ((a[0] + a[1]) + (a[2] + a[3])) + ((b[0] + b[1]) + (b[2] + b[3])) + ((c[0] + c[1]) + (c[2] + c[3])) + ((d[0] + d[1]) + (d[2] + d[3])); rs2 = 1.0f / sqrtf(ssq * (1.0f / 1024.0f) + EPS); }
    const float bmax = key2f(best[0] & ~255); float sum = 0.f;
#pragma unroll
    for (int k = 0; k < 8; ++k) { bv[k] = __expf((bv[k] - bmax) * rs2); sum += bv[k]; }
    sum += __shfl_xor(sum, 32);
    const float inv = 1.0f / sum;
    int* EI = (int*)(F.ws + WS_EI); float* EG = (float*)(F.ws + WS_EG);
    u32x4 i0, i1; f32x4 g0, g1;
#pragma unroll
    for (int k = 0; k < 4; ++k) { i0[k] = (unsigned)ex[k]; i1[k] = (unsigned)ex[4 + k]; g0[k] = bv[k] * inv; g1[k] = bv[4 + k] * inv; }
    int* ip = EI + (size_t)tok * 128 + h * 16 + hi * 8; float* gp = EG + (size_t)tok * 128 + h * 16 + hi * 8;
    *(u32x4*)ip = i0; *(u32x4*)(ip + 4) = i1; *(f32x4*)gp = g0; *(f32x4*)(gp + 4) = g1;
}

__device__ __forceinline__ float gelu_exact(float v) {
    const float av = fabsf(v), t = __builtin_amdgcn_rcpf(av * 0.2316418882f + 1.0f);
    float q = t * 0.5307027145f + (-0.7265760135f); q = q * t + 0.7107068705f; q = q * t + (-0.142248368f); q = q * t + 0.127414796f; q = q * t;
    const float e = __builtin_amdgcn_exp2f((v * v) * (-0.72134752044f));
    const float m = v * (q * e);
    return v < 0.f ? m : v - m;
}
__device__ __forceinline__ int wave_sum_i(int v) {
#pragma unroll
    for (int o = 1; o < 64; o <<= 1) v += __shfl_xor(v, o);
    return v;
}
constexpr int P8_SYNC_MASK = 15;
constexpr int P8_LOG_NSL = 4, P8_NSL = 1 << P8_LOG_NSL;
constexpr int P8_TS = 8, P8_NSW = (16 + P8_TS - 1) / P8_TS;
constexpr int P8_WLDS = P8_TS * 2048;
__device__ __forceinline__ int dpp_xor1(int v) { return __builtin_amdgcn_update_dpp(0, v, 0xB1, 0xF, 0xF, false); }
__device__ __forceinline__ int dpp_xor2(int v) { return __builtin_amdgcn_update_dpp(0, v, 0x4E, 0xF, 0xF, false); }
__device__ __forceinline__ int dpp_hmir(int v) { return __builtin_amdgcn_update_dpp(0, v, 0x141, 0xF, 0xF, false); }
struct P8True { static constexpr bool value = true; }; struct P8False { static constexpr bool value = false; };
template <class BarT> __device__ __forceinline__ void p8_block16(Frame& F, int tb, int sw, const BarT& bar, int sync_mask, const float* FN) {
    const int lane = F.lane, g = lane >> 3, i8 = lane & 7;
    const unsigned char* U8 = F.ws + WS_U8; const unsigned char* V8 = F.ws + WS_V8;
    const int* EI = (const int*)(F.ws + WS_EI); const float* EG = (const float*)(F.ws + WS_EG);
    const float* SU = (const float*)(F.ws + WS_SU); const float* SV = (const float*)(F.ws + WS_SV);
    const lds_ptr wl = F.lds + F.wave * P8_WLDS;
    LAS unsigned short* ids = (LAS unsigned short*)wl; LAS float* gts = (LAS float*)(wl + P8_TS * 256); LAS unsigned short* ofs = (LAS unsigned short*)(wl + P8_TS * 768);
    const lds_ptr nql = wl + P8_TS * 1024;
    const int ntk = min(P8_TS, 16 - sw * P8_TS);
    const unsigned long long ltmask = (1ull << lane) - 1ull;
    {
        const int tok0 = tb * 16 + sw * P8_TS;
#pragma unroll
        for (int ti = 0; ti < P8_TS; ++ti) if (ti < ntk) {
            const int tok = tok0 + ti;
            {
              const u32x4* hr = (const u32x4*)((const bf16_t*)(F.ws + WS_H2B) + (size_t)tok * 1024 + lane * 16); const u32x4 hA = hr[0], hB = hr[1]; f32x4 y[4];
              const f32x4* sp = (const f32x4*)((const float*)(F.ws + WS_SSQP) + (size_t)tok * 16); const f32x4 pa_ = sp[0], pb_ = sp[1], pc_ = sp[2], pd_ = sp[3];
              const float ssq = ((pa_[0] + pa_[1]) + (pa_[2] + pa_[3])) + ((pb_[0] + pb_[1]) + (pb_[2] + pb_[3])) + ((pc_[0] + pc_[1]) + (pc_[2] + pc_[3])) + ((pd_[0] + pd_[1]) + (pd_[2] + pd_[3]));
              const float rs2 = 1.0f / sqrtf(ssq * (1.0f / 1024.0f) + EPS); float am = 0.f;
#pragma unroll
              for (int i = 0; i < 4; ++i) { const unsigned w0 = (i < 2 ? hA : hB)[2 * (i & 1)], w1 = (i < 2 ? hA : hB)[2 * (i & 1) + 1];
                  const f32x4 hv = {__uint_as_float(w0 << 16), __uint_as_float(w0 & 0xffff0000u), __uint_as_float(w1 << 16), __uint_as_float(w1 & 0xffff0000u)};
                  y[i] = hv * rs2 * *(const f32x4*)(FN + lane * 16 + 4 * i);
                  am = fmaxf(fmaxf(am, fmaxf(fabsf(y[i][0]), fabsf(y[i][1]))), fmaxf(fabsf(y[i][2]), fabsf(y[i][3]))); }
#pragma unroll
              for (int o = 1; o < 64; o <<= 1) am = fmaxf(am, __shfl_xor(am, o));
              const float inv = am > 0.f ? 127.0f / am : 0.f; u32x4 qv;
#pragma unroll
              for (int i = 0; i < 4; ++i) { unsigned wv = 0u;
#pragma unroll
                  for (int k = 0; k < 4; ++k) wv |= ((unsigned)(int)__builtin_rintf(y[i][k] * inv) & 255u) << (8 * k);
                  qv[i] = wv; }
              *(LAS u32x4*)(nql + ti * 1024 + lane * 16) = qv; if (lane == 0) *(LAS float*)(wl + P8_TS * 896 + ti * 4) = am * (1.0f / 127.0f); }
            const int e0 = EI[(size_t)tok * 128 + lane], e1 = EI[(size_t)tok * 128 + 64 + lane];
            const float g0 = EG[(size_t)tok * 128 + lane], g1 = EG[(size_t)tok * 128 + 64 + lane];
            const int s0 = e0 >> (14 - P8_LOG_NSL), s1 = e1 >> (14 - P8_LOG_NSL);
            int run = 0, pos0 = 0, pos1 = 0, myoff = 0;
#pragma unroll 1
            for (int sl = 0; sl < P8_NSL; ++sl) {
                const unsigned long long m0 = __ballot(s0 == sl), m1 = __ballot(s1 == sl);
                const int c0 = __popcll(m0), c1 = __popcll(m1);
                if (s0 == sl) pos0 = run + __popcll(m0 & ltmask);
                if (s1 == sl) pos1 = run + c0 + __popcll(m1 & ltmask);
                if (lane == sl) myoff = run;
                run += c0 + c1;
            }
            if (lane == P8_NSL) myoff = 128;
            ids[ti * 128 + pos0] = (unsigned short)e0; ids[ti * 128 + pos1] = (unsigned short)e1; gts[ti * 128 + pos0] = g0; gts[ti * 128 + pos1] = g1;
            if (lane <= P8_NSL) ofs[ti * 64 + lane] = (unsigned short)myoff;
        }
        f32x2 acc[P8_TS][8];
#pragma unroll
        for (int ti = 0; ti < P8_TS; ++ti)
#pragma unroll
            for (int i = 0; i < 8; ++i) acc[ti][i] = (f32x2){0.f, 0.f};
#pragma unroll 1
        for (int sl = 0; sl < P8_NSL; ++sl) {
            if (sl && (sl & sync_mask) == 0) xcd_barrier(bar);
#pragma unroll
            for (int ti = 0; ti < P8_TS; ++ti) if (ti < ntk) {
                const int lo = __builtin_amdgcn_readfirstlane((int)ofs[ti * 64 + sl]), hi = __builtin_amdgcn_readfirstlane((int)ofs[ti * 64 + sl + 1]);
#pragma unroll 1
                for (int c0 = lo; c0 < hi; c0 += 8) {
                    const int nd = min(8, hi - c0);
                    auto step = [&](auto fullc) {
                        constexpr bool FULL = decltype(fullc)::value;
                        const int n = FULL ? 8 : nd;
                        const int idx = ti * 128 + c0 + (FULL ? g : min(g, n - 1));
                        const int id = ids[idx]; const float gate = (FULL || g < n) ? gts[idx] : 0.f;
                        const float su = SU[id], sv = SV[id];
                        const unsigned uo = (unsigned)id * 1024u + (unsigned)i8 * 16u;
                        u32x4 ur[8], vr[8];
#pragma unroll
                        for (int j = 0; j < 8; ++j) ur[j] = *(const u32x4*)(U8 + (size_t)(uo + 128u * j));
#pragma unroll
                        for (int k = 0; k < 8; ++k) if (k < n) { const unsigned e = (unsigned)__builtin_amdgcn_readlane(id, 8 * k); vr[k] = *(const u32x4*)(V8 + (size_t)(e * 1024u + (unsigned)lane * 16u)); }
                        int d = 0; unsigned nqo = (unsigned)(ti * 1024 + i8 * 16); asm volatile("" : "+v"(nqo));
#pragma unroll
                        for (int jb = 0; jb < 8; jb += 4) {
                            u32x4 q[4];
#pragma unroll
                            for (int j = 0; j < 4; ++j) q[j] = *(const LAS u32x4*)(nql + nqo + 128 * (jb + j));
                            __builtin_amdgcn_sched_barrier(0);
#pragma unroll
                            for (int j = 0; j < 4; ++j)
#pragma unroll
                                for (int i = 0; i < 4; ++i) d = __builtin_amdgcn_sdot4((int)ur[jb + j][i], (int)q[j][i], d, false);
                        }
                        d += dpp_xor1(d); d += dpp_xor2(d); d += dpp_hmir(d);
                        const float coef = gate * gelu_exact((float)d * (*(const LAS float*)(wl + P8_TS * 896 + (nqo & 0x1c00u) / 256u) * su)) * sv;
#pragma unroll
                        for (int k = 0; k < 8; ++k) if (k < n) { const float c = __builtin_bit_cast(float, __builtin_amdgcn_readlane(__builtin_bit_cast(int, coef), 8 * k)); const f32x2 c2 = {c, c};
#pragma unroll
                            for (int i = 0; i < 4; ++i) { const f32x2 lo2 = __builtin_amdgcn_cvt_pk_f32_fp8((int)vr[k][i], false), hi2 = __builtin_amdgcn_cvt_pk_f32_fp8((int)vr[k][i], true);
                                acc[ti][2 * i] = c2 * lo2 + acc[ti][2 * i]; acc[ti][2 * i + 1] = c2 * hi2 + acc[ti][2 * i + 1]; } }
                    };
                    if (nd == 8) step(P8True{}); else step(P8False{});
                }
            }
        }
#pragma unroll
        for (int ti = 0; ti < P8_TS; ++ti) if (ti < ntk) {
            int lane_f = lane; asm volatile("" : "+v"(lane_f));
            float* op = F.out + (size_t)(tok0 + ti) * 1024 + lane_f * 16;
            const u32x2* hr = (const u32x2*)((const bf16_t*)(F.ws + WS_H2B) + (size_t)(tok0 + ti) * 1024 + lane_f * 16);
#pragma unroll
            for (int i = 0; i < 4; ++i) { const u32x2 hw = hr[i]; const unsigned w0 = hw.x, w1 = hw.y;
                f32x4 hv = {__uint_as_float(w0 << 16), __uint_as_float(w0 & 0xffff0000u), __uint_as_float(w1 << 16), __uint_as_float(w1 & 0xffff0000u)};
                hv += (f32x4){acc[ti][2 * i][0], acc[ti][2 * i][1], acc[ti][2 * i + 1][0], acc[ti][2 * i + 1][1]}; *(f32x4*)(op + 4 * i) = hv; }
        }
    }
}

constexpr int N_PHASES = 8;
__global__ void __launch_bounds__(NTHREADS, 2) mega_fwd(Args args) {
    extern __shared__ __attribute__((aligned(16))) unsigned char lds_raw[];
    Frame F;
    F.lds = (lds_ptr)lds_raw; F.tid = threadIdx.x; F.lane = F.tid & 63; F.wave = __builtin_amdgcn_readfirstlane(F.tid >> 6);
    F.G = gridDim.x; F.gw = blockIdx.x * NWAVES + F.wave; F.ngw = F.G * NWAVES;
    F.out = args.out; F.ws = args.ws;
    volatile LAS unsigned* MISC = (volatile LAS unsigned*)(F.lds + MISC_OFF);
    LAS float* tab = (LAS float*)(F.lds + TAB_OFF);
    if (F.tid < 64) MISC[F.tid] = 0u;
    __syncthreads();
    const int lo = args.ph_lo, hi = args.ph_hi;
    XcdBarrier bar; bar.bar = (unsigned*)(F.ws + WS_CTL) + CW_BAR; bar.x = 0; bar.st = nullptr;
    if (hi - lo > 1) bar = xcd_barrier_post((unsigned*)(F.ws + WS_CTL) + CW_BAR, MISC + 8);
#ifndef PHASE_MASK
#define PHASE_MASK 0x0ff
#endif
#define IN(k) (((PHASE_MASK >> (k)) & 1) && lo <= (k) && (k) < hi)
#define SEAM(k) do { if (IN(k) && IN((k) + 1)) xcd_barrier(bar); } while (0)
#define REPS(k) ((((REPEAT_MASK) >> (k)) & 1) ? 2 : 1)
#define PHASE(k) if (IN(k)) _Pragma("unroll") for (int rep_ = 0; rep_ < REPS(k); ++rep_)
#define REP_BAR() do { if (rep_) xcd_barrier(bar); } while (0)

    PHASE(0) { REP_BAR(); p0_prologue(F, args); }
    SEAM(0);
    PHASE(1) { REP_BAR();
        if (F.wave == 0 && blockIdx.x < 64) p1_meta_tile(F, blockIdx.x);
        __syncthreads();
        pg8::Gemm g{(const bf16_t*)(F.ws + WS_XB), (const bf16_t*)(F.ws + WS_W1T), MTOK, 2048, 1024}; pg8::StaticOrder S; S.init(MTOK, 2048, F.G, (int)blockIdx.x);
        EpiP1 E{(bf16_t*)(F.ws + WS_P1), (const float*)(F.ws + WS_RSTD1)};
        pg8::gemm_phase<EpiP1, pg8::StaticOrder, true, true>(F.lds, g, S, E);
    }
    SEAM(1);
    if (IN(2)) {
        for (int i = F.tid; i < 320; i += NTHREADS) tab[i] = i < 96 ? args.in[I_QKNQ][i] : (i < 192 ? args.in[I_QKNK][i - 96] : (i < 256 ? args.in[I_DQN][i - 192] : args.in[I_DKN][i - 256]));
        __syncthreads();
        constexpr int NPB = MP / 32;
        constexpr int NBJ = (NPB + 7) / 8;
        for (int j = blockIdx.x; j < 2 * NBJ; j += F.G) { if (j < NBJ) { if (P2ON & 1) p2_block<false>(F, j, tab); } else { if (P2ON & 2) p2_block<true>(F, j - NBJ, tab); } }
    }
    SEAM(2);
    PHASE(3) { REP_BAR();
        for (int i = F.tid; i < 512; i += NTHREADS) { const int hh = i >> 7, n = i & 127; tab[i] = args.in[I_RELB][T5_BUCKET[n] * 4 + hh] * LOG2E; }
        if (F.tid < 4) tab[512 + F.tid] = args.in[I_RELB][31 * 4 + F.tid] * LOG2E;
        if (F.tid >= 64 && F.tid < 192) tab[520 + F.tid - 64] = args.in[I_SUBLN][F.tid - 64];
        if (F.wave == 4) { const float a = wave_sum(args.in[I_LQ1][F.lane] * args.in[I_LK1][F.lane]), c = wave_sum(args.in[I_LQ2][F.lane] * args.in[I_LK2][F.lane]);
            if (F.lane == 0) tab[516] = expf(a) - expf(c) + LAMBDA_INIT; }
        if (F.wave == 5) {
            const int l = F.lane;
            float gq = fmaxf(fabsf(args.in[I_QKNQ][l]), l < 32 ? fabsf(args.in[I_QKNQ][64 + l]) : 0.f), gk = fmaxf(fabsf(args.in[I_QKNK][l]), l < 32 ? fabsf(args.in[I_QKNK][64 + l]) : 0.f);
            float dq = fabsf(args.in[I_DQN][l]), dk = fabsf(args.in[I_DKN][l]), rb = fmaxf(fabsf(args.in[I_RELB][l]), fabsf(args.in[I_RELB][64 + l]));
#pragma unroll
            for (int o = 1; o < 64; o <<= 1) { gq = fmaxf(gq, __shfl_xor(gq, o)); gk = fmaxf(gk, __shfl_xor(gk, o)); dq = fmaxf(dq, __shfl_xor(dq, o)); dk = fmaxf(dk, __shfl_xor(dk, o)); rb = fmaxf(rb, __shfl_xor(rb, o)); }
            if (l == 0) { tab[517] = 9.79795897f * LOG2E * gq * gk * 1.02f + 0.5f; tab[518] = (8.0f * dq * dk * 1.02f + rb) * LOG2E + 0.5f; }
        }
        __syncthreads();
        quant_expert_tables(F, args);
        const float bnd_m = __builtin_bit_cast(float, __builtin_amdgcn_readfirstlane(__builtin_bit_cast(int, tab[517]))), bnd_d = __builtin_bit_cast(float, __builtin_amdgcn_readfirstlane(__builtin_bit_cast(int, tab[518]))); const bool fix_m = bnd_m <= 60.f, fix_d = bnd_d <= 60.f;
        const int x = blockIdx.x & 7, jj = blockIdx.x >> 3;
        const bool bal = (F.G == 256);
        const int nun = bal ? 4 : (1024 - (int)blockIdx.x + F.G - 1) / F.G;
        if (fix_m) {
            const int nun2 = bal ? 2 : (512 - (int)blockIdx.x + F.G - 1) / F.G;
            for (int i = 0; i < nun2; ++i) { int bb, hh, qt;
                if (bal) { const int bh = x + 8 * (jj >> 3), pr = jj & 7; bb = bh >> 3; hh = bh & 7; qt = (i & 1) ? 15 - pr : pr; }
                else { const int u = blockIdx.x + i * F.G; bb = u >> 7; hh = (u >> 4) & 7; qt = u & 15; }
                attn_unit_mla2(F, bb, hh, qt, bnd_m); }
        } else {
        for (int i = 0; i < nun; ++i) { int bb, hh, qt;
            if (bal) { const int pi = jj + 32 * (i >> 1), bh = x + 8 * (pi >> 4), pr = pi & 15; bb = bh >> 3; hh = bh & 7; qt = (i & 1) ? 31 - pr : pr; }
            else { const int u = blockIdx.x + i * F.G; bb = u >> 8; hh = (u >> 5) & 7; qt = u & 31; }
            attn_unit<false, false>(F, bb, hh, qt, tab, 0.f); }
        }
        for (int i = 0; i < nun; ++i) { int bb, hh, qt;
            if (bal) { const int bh = x + 8 * (i >> 1); bb = bh >> 2; hh = bh & 3; qt = (i & 1) ? 63 - jj : jj; }
            else { const int u = blockIdx.x + i * F.G; bb = u >> 8; hh = (u >> 6) & 3; qt = u & 63; }
            if (fix_d) attn_unit<true, true>(F, bb, hh, qt, tab, bnd_d); else attn_unit<true, false>(F, bb, hh, qt, tab, 0.f); }
    }
    SEAM(3);
    PHASE(4) { REP_BAR();
        pg8::Gemm g{(const bf16_t*)(F.ws + WS_Y), (const bf16_t*)(F.ws + WS_WOUT), MTOK, 1024, 1024}; pg8::StaticOrder S; S.init(MTOK, 1024, F.G, (int)blockIdx.x);
        EpiRes E{args.in[I_X], F.out, (bf16_t*)(F.ws + WS_H2B), (float*)(F.ws + WS_SSQP)};
        pg8::gemm_phase<EpiRes, pg8::StaticOrder, true, true>(F.lds, g, S, E);
    }
    SEAM(4);
    PHASE(5) { REP_BAR();
        pg8::Gemm g{(const bf16_t*)(F.ws + WS_H2B), (const bf16_t*)(F.ws + WS_WPQ), MTOK, 2048, 1024}; pg8::StaticOrder S; S.init(MTOK, 2048, F.G, (int)blockIdx.x);
        EpiPlain E{(bf16_t*)(F.ws + WS_QP), 2048};
        pg8::gemm_phase<EpiPlain, pg8::StaticOrder, true, true>(F.lds, g, S, E);
    }
    SEAM(5);
    PHASE(6) { REP_BAR();
        const unsigned lds0 = (unsigned)(size_t)F.lds; const bf16_t* SK = (const bf16_t*)(F.ws + WS_SK);
        int cur_h = -1;
        for (int j = blockIdx.x; j < (MTOK / 256) * 8; j += F.G) {
            const int h = j & 7;
            if (h != cur_h) {
                __syncthreads();
#pragma unroll
                for (int i = 0; i < 8; ++i) { const int pc = F.wave * 8 + i, row = 4 * pc + (F.lane >> 4);
                    glds16(SK + ((size_t)h * 256 + row) * 128 + (((F.lane & 15) ^ (row & 15)) * 8), (unsigned)__builtin_amdgcn_readfirstlane((int)(lds0 + pc * 1024))); }
                asm volatile("s_waitcnt vmcnt(0)\n\ts_barrier" ::: "memory");
                cur_h = h;
            }
            p7_job(F, (j >> 3) * 8 + F.wave, h);
        }
    }
    SEAM(6);
    if (IN(7)) {
#pragma unroll 1
        for (int sw = 0; sw < P8_NSW; ++sw) {
            if (sw > 0 && hi - lo > 1) xcd_barrier(bar);
            const int smask = (hi - lo > 1 && F.ngw * 16 == MTOK) ? P8_SYNC_MASK : -1;
            for (int tb = F.gw; tb < MTOK / 16; tb += F.ngw) p8_block16(F, tb, sw, bar, smask, args.in[I_FNORM]);
        }
    }
#undef IN
#undef SEAM
}

extern "C" void kernel_launch(void* const* d_in, const int* in_sizes, int n_in, void* d_out, int out_size, void* d_ws, size_t ws_size, hipStream_t stream) {
    static int grid = 0;
    if (grid == 0) {
        if (n_in != 24 || out_size != MTOK * DMODEL || ws_size < WS_END) { fprintf(stderr, "kernel_launch: unexpected shapes (n_in %d, out %d, ws %zu < %zu)\n", n_in, out_size, ws_size, (size_t)WS_END); grid = -1; return; }
        int dev = 0, cus = 0, per_cu = 0;
        if (hipGetDevice(&dev) != hipSuccess || hipDeviceGetAttribute(&cus, hipDeviceAttributeMultiprocessorCount, dev) != hipSuccess) { grid = -1; return; }
        if (hipFuncSetAttribute((const void*)mega_fwd, hipFuncAttributeMaxDynamicSharedMemorySize, LDS_BYTES) != hipSuccess) { fprintf(stderr, "kernel_launch: hipFuncSetAttribute failed\n"); grid = -1; return; }
        if (hipOccupancyMaxActiveBlocksPerMultiprocessor(&per_cu, (const void*)mega_fwd, NTHREADS, LDS_BYTES) != hipSuccess || per_cu < 1) fprintf(stderr, "kernel_launch: occupancy query reports %d\n", per_cu);
        (void)hipGetLastError();
        grid = cus;
    }
    if (grid < 0) return;
    (void)hipMemsetAsync((char*)d_ws + WS_CTL, 0, CTL_ZERO_BYTES, stream);
    Args a{};
    for (int i = 0; i < 24; ++i) a.in[i] = (const float*)d_in[i];
    a.out = (float*)d_out; a.ws = (unsigned char*)d_ws;
#if MK_PER_PHASE
    for (int ph = 0; ph < N_PHASES; ++ph) { a.ph_lo = ph; a.ph_hi = ph + 1; hipLaunchKernelGGL(mega_fwd, dim3(grid), dim3(NTHREADS), LDS_BYTES, stream, a); }
#else
    a.ph_lo = 0; a.ph_hi = N_PHASES; hipLaunchKernelGGL(mega_fwd, dim3(grid), dim3(NTHREADS), LDS_BYTES, stream, a);
#endif
}
```
